# Optimizing an MI355X kernel written in HIP

```python
import math
import jax, jax.numpy as jnp
from jax import lax
import numpy as np

D_MODEL = 1024
BATCH = 4
SEQ = 8192
DEPTH = 1

D_MIX = D_MODEL
EPS = 1e-6
ROPE_THETA = 10000.0

MLA_HEADS = 8
MLA_QK_NOPE = 64
MLA_QK_ROPE = 32
MLA_QK_DIM = MLA_QK_NOPE + MLA_QK_ROPE
MLA_V_DIM = 64
MLA_Q_RANK = 256
MLA_KV_RANK = 128
MLA_WIDTH = MLA_HEADS * MLA_V_DIM
ATTN_BLOCK = 128

RET_HEADS = 8
RET_HEAD_DIM = 64
RET_WIDTH = RET_HEADS * RET_HEAD_DIM
RET_CHUNK = 128

IN_SPLITS = (
    MLA_Q_RANK,
    MLA_KV_RANK,
    MLA_QK_ROPE,
    RET_WIDTH, RET_WIDTH, RET_WIDTH, RET_WIDTH,
)
IN_COLS = sum(IN_SPLITS)

PEER_HEADS = 8
PEER_N_KEYS = 128
PEER_N_EXPERTS = PEER_N_KEYS * PEER_N_KEYS
PEER_KEY_DIM = 256
PEER_HALF = PEER_KEY_DIM // 2
PEER_TOPK = 16
PEER_TOKEN_BLOCK = 128

kernel_name = "hymba_mla_retnet_peer_adaln"


def rms_norm(x, g):
    xf = x.astype(jnp.float32)
    y = xf * lax.rsqrt(jnp.mean(xf * xf, axis=-1, keepdims=True) + EPS)
    return (y * g.astype(jnp.float32)).astype(x.dtype)


def rope(x, positions):
    d = x.shape[-1]
    inv = ROPE_THETA ** (-jnp.arange(0, d, 2, dtype=jnp.float32) / d)
    ang = positions.astype(jnp.float32)[:, :, None, None] * inv
    cos, sin = jnp.cos(ang), jnp.sin(ang)
    x1, x2 = jnp.split(x.astype(jnp.float32), 2, axis=-1)
    out = jnp.concatenate([x1 * cos - x2 * sin, x1 * sin + x2 * cos], axis=-1)
    return out.astype(x.dtype)


def mla_group(q_lat, kv_lat, k_rope, positions, g_q_norm, w_uq, g_kv_norm, w_ukv):
    B, S, _ = q_lat.shape
    q = (rms_norm(q_lat, g_q_norm) @ w_uq).reshape(B, S, MLA_HEADS, MLA_QK_DIM)
    q_nope, q_rope = q[..., :MLA_QK_NOPE], q[..., MLA_QK_NOPE:]
    q_rope = rope(q_rope, positions)
    kv = (rms_norm(kv_lat, g_kv_norm) @ w_ukv).reshape(B, S, MLA_HEADS, MLA_QK_NOPE + MLA_V_DIM)
    k_nope, v = kv[..., :MLA_QK_NOPE], kv[..., MLA_QK_NOPE:]
    k_r = rope(k_rope[:, :, None, :], positions)
    k = jnp.concatenate([k_nope, jnp.broadcast_to(k_r, (B, S, MLA_HEADS, MLA_QK_ROPE))], axis=-1)
    qh = jnp.concatenate([q_nope, q_rope], axis=-1) * (MLA_QK_DIM ** -0.5)

    nb = S // ATTN_BLOCK
    q_blocks = qh.reshape(B, nb, ATTN_BLOCK, MLA_HEADS, MLA_QK_DIM).transpose(1, 0, 2, 3, 4)
    key_pos = jnp.arange(S)

    def one_block(args):
        qb, bi = args
        s = jnp.einsum('bqhd,bkhd->bhqk', qb, k).astype(jnp.float32)
        q_pos = bi * ATTN_BLOCK + jnp.arange(ATTN_BLOCK)
        mask = key_pos[None, :] <= q_pos[:, None]
        s = jnp.where(mask[None, None], s, -jnp.inf)
        p = jax.nn.softmax(s, axis=-1).astype(v.dtype)
        return jnp.einsum('bhqk,bkhd->bqhd', p, v)

    out = lax.map(one_block, (q_blocks, jnp.arange(nb)))
    return out.transpose(1, 0, 2, 3, 4).reshape(B, S, MLA_WIDTH)


def retention_group(q, k, v, gate, positions, g_ret_norm):
    B, S, _ = q.shape
    H, d, C = RET_HEADS, RET_HEAD_DIM, RET_CHUNK
    nc = S // C
    q = rope(q.reshape(B, S, H, d), positions)
    k = rope(k.reshape(B, S, H, d), positions) * (d ** -0.5)
    v = v.reshape(B, S, H, d)

    gamma = 1.0 - 2.0 ** (-5.0 - jnp.arange(H, dtype=jnp.float32))
    log_g = jnp.log(gamma)
    idx = jnp.arange(C, dtype=jnp.float32)
    diff = idx[:, None] - idx[None, :]
    dmask = jnp.where(diff >= 0, jnp.exp(log_g[:, None, None] * jnp.maximum(diff, 0.0)), 0.0)

    qc = q.reshape(B, nc, C, H, d).astype(jnp.float32)
    kc = k.reshape(B, nc, C, H, d).astype(jnp.float32)
    vc = v.reshape(B, nc, C, H, d).astype(jnp.float32)

    scores = jnp.einsum('bnihd,bnjhd->bnhij', qc, kc) * dmask
    y_inner = jnp.einsum('bnhij,bnjhd->bnihd', scores, vc)

    zeta = jnp.exp(log_g[:, None] * (C - 1.0 - idx))
    kv_chunk = jnp.einsum('bnjhk,hj,bnjhv->bnhkv', kc, zeta, vc)
    chunk_decay = jnp.exp(log_g * C)

    def step(state, kv_n):
        return state * chunk_decay[None, :, None, None] + kv_n, state

    _, prev = lax.scan(step, jnp.zeros((B, H, d, d), jnp.float32), kv_chunk.transpose(1, 0, 2, 3, 4))
    prev = prev.transpose(1, 0, 2, 3, 4)
    xi = jnp.exp(log_g[:, None] * (idx + 1.0))
    y_cross = jnp.einsum('bnihk,bnhkv,hi->bnihv', qc, prev, xi)

    y = (y_inner + y_cross).reshape(B, S, H, d)
    mu = jnp.mean(y, axis=-1, keepdims=True)
    var = jnp.mean(jnp.square(y - mu), axis=-1, keepdims=True)
    yn = ((y - mu) * lax.rsqrt(var + EPS)).reshape(B, S, RET_WIDTH) * g_ret_norm.astype(jnp.float32)
    return (jax.nn.silu(gate.astype(jnp.float32)) * yn).astype(gate.dtype)


def peer(h, w_query, sub_keys, expert_u, expert_v):
    B, S, D = h.shape
    T = B * S
    K = PEER_TOPK
    xt = h.reshape(T, D)
    q = (xt @ w_query).reshape(T, PEER_HEADS, 2, PEER_HALF)
    s = jnp.einsum('thpd,pkd->thpk', q, sub_keys).astype(jnp.float32)
    s_top, i_top = lax.top_k(s, K)
    cand = (s_top[:, :, 0, :, None] + s_top[:, :, 1, None, :]).reshape(T, PEER_HEADS, K * K)
    cand_idx = (i_top[:, :, 0, :, None] * PEER_N_KEYS + i_top[:, :, 1, None, :]).reshape(T, PEER_HEADS, K * K)
    best, pos = lax.top_k(cand, K)
    eidx = jnp.take_along_axis(cand_idx, pos, axis=-1)
    g = jax.nn.softmax(best, axis=-1)

    nb = T // PEER_TOKEN_BLOCK

    def one_block(args):
        xb, ib, gb = args
        u = expert_u[ib]
        a = jax.nn.gelu(jnp.einsum('thkd,td->thk', u, xb).astype(jnp.float32), approximate=False)
        w = (gb * a).astype(expert_v.dtype)
        return jnp.einsum('thk,thkd->td', w, expert_v[ib])

    out = lax.map(one_block, (xt.reshape(nb, PEER_TOKEN_BLOCK, D),
                              eidx.reshape(nb, PEER_TOKEN_BLOCK, PEER_HEADS, K),
                              g.reshape(nb, PEER_TOKEN_BLOCK, PEER_HEADS, K)))
    return out.reshape(B, S, D)


def setup_inputs(seed: int = 0) -> dict:
    key = jax.random.key(seed)
    ks = jax.random.split(key, 20)
    L, D = DEPTH, D_MODEL
    nrm = lambda k, shape, scale: jax.random.normal(k, shape, jnp.float32) * scale
    gain = lambda k, shape: 1.0 + 0.02 * jax.random.normal(k, shape, jnp.float32)
    return {
        "x": nrm(ks[0], (BATCH, SEQ, D), 1.0),
        "c": nrm(ks[1], (BATCH, D), 1.0),
        "positions": jnp.broadcast_to(jnp.arange(SEQ, dtype=jnp.int32), (BATCH, SEQ)),
        "w_ada": nrm(ks[2], (L, D, 6 * D), D ** -0.5),
        "b_ada": nrm(ks[3], (L, 6 * D), 0.01),
        "g_norm1": gain(ks[4], (L, D)),
        "w_in": nrm(ks[5], (L, D, IN_COLS), D ** -0.5),
        "g_q_norm": gain(ks[6], (L, MLA_Q_RANK)),
        "w_uq": nrm(ks[7], (L, MLA_Q_RANK, MLA_HEADS * MLA_QK_DIM), MLA_Q_RANK ** -0.5),
        "g_kv_norm": gain(ks[8], (L, MLA_KV_RANK)),
        "w_ukv": nrm(ks[9], (L, MLA_KV_RANK, MLA_HEADS * (MLA_QK_NOPE + MLA_V_DIM)), MLA_KV_RANK ** -0.5),
        "g_ret_norm": gain(ks[10], (L, RET_WIDTH)),
        "w_out": nrm(ks[11], (L, MLA_WIDTH + RET_WIDTH, D), (MLA_WIDTH + RET_WIDTH) ** -0.5),
        "g_norm2": gain(ks[12], (L, D)),
        "w_query": nrm(ks[13], (L, D, PEER_HEADS * PEER_KEY_DIM), D ** -0.5),
        "sub_keys": nrm(ks[14], (L, 2, PEER_N_KEYS, PEER_HALF), PEER_HALF ** -0.5),
        "expert_u": nrm(ks[15], (L, PEER_N_EXPERTS, D), D ** -0.5),
        "expert_v": nrm(ks[16], (L, PEER_N_EXPERTS, D), 0.5),
        "g_final": gain(ks[17], (D,)),
    }


def reference(x, c, positions, w_ada, b_ada, g_norm1, w_in, g_q_norm, w_uq, g_kv_norm, w_ukv,
              g_ret_norm, w_out, g_norm2, w_query, sub_keys, expert_u, expert_v, g_final):
    offs = np.cumsum(IN_SPLITS)[:-1].tolist()
    for l in range(DEPTH):
        mod = jax.nn.silu(c) @ w_ada[l] + b_ada[l]
        sh1, sc1, gt1, sh2, sc2, gt2 = [m[:, None, :] for m in jnp.split(mod, 6, axis=-1)]

        h = rms_norm(x, g_norm1[l]) * (1.0 + sc1) + sh1
        proj = h @ w_in[l]
        q_lat, kv_lat, k_rope, rq, rk, rv, rg = jnp.split(proj, offs, axis=-1)
        y_mla = mla_group(q_lat, kv_lat, k_rope, positions, g_q_norm[l], w_uq[l], g_kv_norm[l], w_ukv[l])
        y_ret = retention_group(rq, rk, rv, rg, positions, g_ret_norm[l])
        mixed = jnp.concatenate([y_mla.astype(x.dtype), y_ret.astype(x.dtype)], axis=-1) @ w_out[l]
        x = x + gt1 * mixed

        h2 = rms_norm(x, g_norm2[l]) * (1.0 + sc2) + sh2
        x = x + gt2 * peer(h2, w_query[l], sub_keys[l], expert_u[l], expert_v[l]).astype(x.dtype)
    return rms_norm(x, g_final)
```

```cpp
#include <hip/hip_runtime.h>
#include <cstdint>
#include <cstdio>

typedef unsigned short bf16_t;
typedef float f32x4 __attribute__((ext_vector_type(4)));
typedef unsigned u32x4 __attribute__((ext_vector_type(4)));
typedef unsigned u32x2 __attribute__((ext_vector_type(2)));

constexpr int NB = 4, SEQ = 8192, T = NB * SEQ, D = 1024;
constexpr int IN_COLS = 2464;
constexpr int NH = 8;
constexpr int QK = 96, NOPE = 64, ROPE = 32, DV = 64;
constexpr int QR = 256, KVR = 128;
constexpr int NEXP = 16384, PK = 16, NKEYS = 128;
constexpr float EPS = 1e-6f;
constexpr float LOG2E = 1.4426950408889634f;
constexpr float QSCALE = 0.10206207261596575f * LOG2E;

constexpr size_t MiB = 1u << 20;
constexpr size_t WS_CTL = 0;
constexpr size_t WS_MODP = 1 * MiB;
constexpr size_t WS_MOD = 3 * MiB - 128 * 1024;
constexpr size_t WS_SSQ = 3 * MiB;
constexpr size_t WS_W1T = 4 * MiB;
constexpr size_t WS_W1TT = 8 * MiB;
constexpr size_t WS_WUQ = 10 * MiB;
constexpr size_t WS_WK = 10 * MiB + 512 * 1024;
constexpr size_t WS_WV = 10 * MiB + 768 * 1024;
constexpr size_t WS_WOUT = 11 * MiB;
constexpr size_t WS_WQ = 13 * MiB;
constexpr size_t WS_SK = 17 * MiB;
constexpr size_t WS_EU = 18 * MiB;
constexpr size_t WS_EV = 50 * MiB;
constexpr size_t WS_XN = 82 * MiB;
constexpr size_t WS_PROJ = 146 * MiB;
constexpr size_t WS_PROJT = 274 * MiB;
constexpr size_t WS_Q = 338 * MiB;
constexpr size_t WS_KN = 386 * MiB;
constexpr size_t WS_KR = 418 * MiB;
constexpr size_t WS_VT = 420 * MiB;
constexpr size_t WS_KVC = 452 * MiB;
constexpr size_t WS_END = 484 * MiB;
constexpr size_t WS_EIDX = WS_PROJT;
constexpr size_t WS_GATE = WS_PROJT + 16 * MiB;

constexpr int PC_QL = 0, PC_KVL = 256, PC_KR = 384, PC_RQ = 512, PC_RK = 1024, PC_RG = 1536, PLD = 2048;
constexpr int PT_RK = 0, PT_RV = 512;

__constant__ float INV64[32] = {1.0f, 0.749894261f, 0.562341332f, 0.421696514f, 0.316227764f, 0.237137377f, 0.177827939f, 0.133352131f, 0.100000001f, 0.0749894157f, 0.0562341325f, 0.0421696529f, 0.0316227749f, 0.0237137377f, 0.0177827943f, 0.0133352149f, 0.00999999978f, 0.00749894185f, 0.00562341325f, 0.00421696482f, 0.00316227763f, 0.00237137359f, 0.00177827943f, 0.00133352145f, 0.00100000005f, 0.000749894243f, 0.000562341302f, 0.000421696517f, 0.000316227757f, 0.00023713737f, 0.00017782794f, 0.00013335215f};

struct Params {
    const float *x, *c; const int* positions; const float *w_ada, *b_ada, *g_norm1, *w_in, *g_q_norm, *w_uq, *g_kv_norm, *w_ukv, *g_ret_norm, *w_out, *g_norm2, *w_query, *sub_keys, *expert_u, *expert_v, *g_final;
    float* out; unsigned char* ws;
};

__device__ __forceinline__ unsigned f2bf(float f) { unsigned u = __builtin_bit_cast(unsigned, f); return (u + 0x7fffu + ((u >> 16) & 1u)) >> 16; }
__device__ __forceinline__ unsigned pk2(float lo, float hi) { return f2bf(lo) | (f2bf(hi) << 16); }
__device__ __forceinline__ float bf2f(unsigned short b) { return __builtin_bit_cast(float, (unsigned)b << 16); }
__device__ __forceinline__ float bflo(unsigned w) { return __builtin_bit_cast(float, w << 16); }
__device__ __forceinline__ float bfhi(unsigned w) { return __builtin_bit_cast(float, w & 0xffff0000u); }
__device__ __forceinline__ float wave_sum(float v) {
#pragma unroll
    for (int o = 1; o < 64; o <<= 1) v += __shfl_xor(v, o);
    return v;
}
__device__ __forceinline__ float silu_f(float v) { return v / (1.f + __expf(-v)); }
__device__ __forceinline__ void sincos_rad(float ang, float& s, float& c) {
    const float CH = 0.15915494f, CL = 3.0918913e-09f;
    const float rh = ang * CH, rl = __builtin_fmaf(ang, CH, -rh) + ang * CL;
    const float fr = (rh - __builtin_floorf(rh)) + rl;
    s = __builtin_amdgcn_sinf(fr); c = __builtin_amdgcn_cosf(fr);
}
__device__ __forceinline__ float gelu_exact(float v) { return 0.5f * v * (1.f + erff(v * 0.70710678118654752f)); }

__device__ __forceinline__ void p0_mod_item(const Params& P, int item, int lane) {
    const int kc = item / 24, nc = item % 24, n = nc * 256 + lane * 4;
    f32x4 acc[4] = {};
    for (int kk = 0; kk < 64; ++kk) {
        const int k = kc * 64 + kk;
        const f32x4 w = *(const f32x4*)(P.w_ada + (size_t)k * 6144 + n);
#pragma unroll
        for (int b = 0; b < 4; ++b) { const float s = silu_f(P.c[b * D + k]); acc[b] += w * s; }
    }
    float* modp = (float*)(P.ws + WS_MODP);
#pragma unroll
    for (int b = 0; b < 4; ++b) *(f32x4*)(modp + (size_t)(kc * 4 + b) * 6144 + n) = acc[b];
}
__device__ __forceinline__ void p0_transpose_block(const float* W, int ldw, int k0, int n0, bf16_t* dst, int row0, int ldd, const float* kscale, float scale, float* scr, int lane) {
#pragma unroll 8
    for (int i = 0; i < 32; ++i) { const int kk = 2 * i + (lane >> 5); const float ks = kscale ? kscale[k0 + kk] * scale : scale;
        scr[kk * 33 + (lane & 31)] = W[(size_t)(k0 + kk) * ldw + n0 + (lane & 31)] * ks; }
    asm volatile("s_waitcnt vmcnt(0) lgkmcnt(0)" ::: "memory");
    const int c = lane & 7;
#pragma unroll
    for (int j = 0; j < 4; ++j) { const int n = (lane >> 3) + 8 * j; const float* s = scr + (8 * c) * 33 + n;
        u32x4 o; o.x = pk2(s[0 * 33], s[1 * 33]); o.y = pk2(s[2 * 33], s[3 * 33]); o.z = pk2(s[4 * 33], s[5 * 33]); o.w = pk2(s[6 * 33], s[7 * 33]);
        *(u32x4*)(dst + (size_t)(row0 + n) * ldd + k0 + 8 * c) = o; }
    asm volatile("s_waitcnt vmcnt(0) lgkmcnt(0)" ::: "memory");
}
__device__ __forceinline__ void cvt8(const float* src, bf16_t* dst, size_t n8, size_t gt, size_t nt) {
    for (size_t i = gt; i < n8; i += nt) { const f32x4 a = *(const f32x4*)(src + i * 8), b = *(const f32x4*)(src + i * 8 + 4);
        u32x4 o; o.x = pk2(a.x, a.y); o.y = pk2(a.z, a.w); o.z = pk2(b.x, b.y); o.w = pk2(b.z, b.w); *(u32x4*)(dst + i * 8) = o; }
}
constexpr int IT_MOD = 384, IT_WIN = 16 * 77, IT_WUQ = 4 * 24, IT_WUKV = 2 * 32, IT_WOUT = 16 * 32, IT_WQ = 16 * 64;
constexpr int IT_TOTAL = IT_MOD + IT_WIN + IT_WUQ + IT_WUKV + IT_WOUT + IT_WQ;
__device__ __forceinline__ void p0_prologue(const Params& P, int gw, int nw, int lane, float* scr) {
    unsigned char* ws = P.ws;
    for (int it = gw; it < IT_TOTAL; it += nw) {
        int r = it;
        if (r < IT_MOD) { p0_mod_item(P, r, lane); continue; } r -= IT_MOD;
        if (r < IT_WIN) { const int kb = r / 77, nb = r % 77, n0 = nb * 32, k0 = kb * 64;
            bf16_t* w1t = (bf16_t*)(ws + WS_W1T); bf16_t* w1tt = (bf16_t*)(ws + WS_W1TT);
            if (n0 < 416) p0_transpose_block(P.w_in, IN_COLS, k0, n0, w1t, n0, D, nullptr, 1.f, scr, lane);
            else if (n0 < 928) p0_transpose_block(P.w_in, IN_COLS, k0, n0, w1t, PC_RQ + (n0 - 416), D, nullptr, 1.f, scr, lane);
            else if (n0 < 1440) { p0_transpose_block(P.w_in, IN_COLS, k0, n0, w1t, PC_RK + (n0 - 928), D, nullptr, 1.f, scr, lane);
                                  p0_transpose_block(P.w_in, IN_COLS, k0, n0, w1tt, PT_RK + (n0 - 928), D, nullptr, 1.f, scr, lane); }
            else if (n0 < 1952) p0_transpose_block(P.w_in, IN_COLS, k0, n0, w1tt, PT_RV + (n0 - 1440), D, nullptr, 1.f, scr, lane);
            else p0_transpose_block(P.w_in, IN_COLS, k0, n0, w1t, PC_RG + (n0 - 1952), D, nullptr, 1.f, scr, lane);
            continue; } r -= IT_WIN;
        if (r < IT_WUQ) { const int kb = r / 24, nb = r % 24; p0_transpose_block(P.w_uq, 768, kb * 64, nb * 32, (bf16_t*)(ws + WS_WUQ), nb * 32, 256, P.g_q_norm, QSCALE, scr, lane); continue; } r -= IT_WUQ;
        if (r < IT_WUKV) { const int kb = r / 32, nb = r % 32, n0 = nb * 32, h = n0 >> 7, rr = n0 & 127;
            if (rr < 64) p0_transpose_block(P.w_ukv, 1024, kb * 64, n0, (bf16_t*)(ws + WS_WK), h * 64 + rr, 256, P.g_kv_norm, 1.f, scr, lane);
            else p0_transpose_block(P.w_ukv, 1024, kb * 64, n0, (bf16_t*)(ws + WS_WV), h * 64 + rr - 64, 256, P.g_kv_norm, 1.f, scr, lane);
            continue; } r -= IT_WUKV;
        if (r < IT_WOUT) { const int kb = r / 32, nb = r % 32; p0_transpose_block(P.w_out, 1024, kb * 64, nb * 32, (bf16_t*)(ws + WS_WOUT), nb * 32, 1024, nullptr, 1.f, scr, lane); continue; } r -= IT_WOUT;
        { const int kb = r / 64, nb = r % 64; p0_transpose_block(P.w_query, 2048, kb * 64, nb * 32, (bf16_t*)(ws + WS_WQ), nb * 32, 1024, nullptr, 1.f, scr, lane); }
    }
    const size_t gt = (size_t)gw * 64 + lane, nt = (size_t)nw * 64;
    { u32x4 z = {0u, 0u, 0u, 0u};
      for (size_t i = gt; i < 96 * 1024 / 8; i += nt) *(u32x4*)((bf16_t*)(ws + WS_W1T) + (size_t)416 * 1024 + i * 8) = z;
      for (size_t i = gt; i < 2 * 512 * 16; i += nt) { const size_t m = i / (512 * 16), rr = (i / 16) % 512, cc = i % 16; *(u32x4*)((bf16_t*)(ws + (m ? WS_WV : WS_WK)) + rr * 256 + 128 + cc * 8) = z; }
      for (size_t i = gt; i < (size_t)T * 2 / 4; i += nt) *(u32x4*)((float*)(ws + WS_SSQ) + i * 4) = z; }
    cvt8(P.sub_keys, (bf16_t*)(ws + WS_SK), 2 * 128 * 128 / 8, gt, nt);
    cvt8(P.expert_u, (bf16_t*)(ws + WS_EU), (size_t)NEXP * D / 8, gt, nt);
    cvt8(P.expert_v, (bf16_t*)(ws + WS_EV), (size_t)NEXP * D / 8, gt, nt);
}

template <bool FROM_PART> __device__ __forceinline__ void rownorm_pass(const Params& P, const float* src, const float* g, int seg_sh, int seg_sc, bf16_t* dst, int gw, int nw, int lane) {
    const float* modp = (const float*)(P.ws + WS_MODP); const float* mod = (const float*)(P.ws + WS_MOD);
    for (int r0 = gw * 16; r0 < T; r0 += nw * 16) {
        const int b = r0 / SEQ;
        f32x4 mul[4], add[4];
#pragma unroll
        for (int j = 0; j < 4; ++j) {
            const int col = lane * 4 + 256 * j;
            f32x4 sc, sh;
            if (FROM_PART) {
                sc = *(const f32x4*)(P.b_ada + seg_sc * D + col); sh = *(const f32x4*)(P.b_ada + seg_sh * D + col);
                for (int kc = 0; kc < 16; ++kc) { sc += *(const f32x4*)(modp + (size_t)(kc * 4 + b) * 6144 + seg_sc * D + col); sh += *(const f32x4*)(modp + (size_t)(kc * 4 + b) * 6144 + seg_sh * D + col); }
            } else { sc = *(const f32x4*)(mod + (size_t)b * 6144 + seg_sc * D + col); sh = *(const f32x4*)(mod + (size_t)b * 6144 + seg_sh * D + col); }
            const f32x4 gg = *(const f32x4*)(g + col);
            mul[j] = gg * (sc + 1.0f); add[j] = sh;
        }
        for (int rr = 0; rr < 16; ++rr) {
            const int row = r0 + rr;
            const f32x4* xr = (const f32x4*)(src + (size_t)row * D) + lane;
            f32x4 v[4]; float s = 0.f;
#pragma unroll
            for (int j = 0; j < 4; ++j) { v[j] = xr[64 * j]; s += (v[j].x * v[j].x + v[j].y * v[j].y) + (v[j].z * v[j].z + v[j].w * v[j].w); }
            const float rstd = 1.0f / sqrtf(wave_sum(s) * (1.f / D) + EPS);
            u32x2* o = (u32x2*)(dst + (size_t)row * D) + lane;
#pragma unroll
            for (int j = 0; j < 4; ++j) { const f32x4 y = v[j] * rstd * mul[j] + add[j]; u32x2 w; w.x = pk2(y.x, y.y); w.y = pk2(y.z, y.w); o[64 * j] = w; }
        }
    }
}
__device__ __forceinline__ void mod_final(const Params& P, size_t gt, size_t nt) {
    const float* modp = (const float*)(P.ws + WS_MODP); float* mod = (float*)(P.ws + WS_MOD);
    for (size_t i = gt; i < 4 * 6144; i += nt) { float s = P.b_ada[i % 6144]; for (int kc = 0; kc < 16; ++kc) s += modp[(size_t)kc * 4 * 6144 + i]; mod[i] = s; }
}

__device__ __forceinline__ void kr_pass(const Params& P, size_t gt, size_t nt) {
    const bf16_t* proj = (const bf16_t*)(P.ws + WS_PROJ); bf16_t* kr = (bf16_t*)(P.ws + WS_KR);
    for (size_t i = gt; i < (size_t)T * 16; i += nt) {
        const int t = (int)(i >> 4), f = (int)(i & 15);
        const float x1 = bf2f(proj[(size_t)t * PLD + PC_KR + f]), x2 = bf2f(proj[(size_t)t * PLD + PC_KR + 16 + f]);
        float s, c; sincos_rad((float)P.positions[t] * INV64[2 * f], s, c);
        kr[(size_t)t * 32 + f] = (bf16_t)f2bf(x1 * c - x2 * s); kr[(size_t)t * 32 + 16 + f] = (bf16_t)f2bf(x1 * s + x2 * c);
    }
}

__global__ void __launch_bounds__(512) k_p0(Params P) {
    __shared__ float scr[8][64 * 33];
    const int lane = threadIdx.x & 63, w = threadIdx.x >> 6;
    p0_prologue(P, blockIdx.x * 8 + w, gridDim.x * 8, lane, scr[w]);
}
__global__ void __launch_bounds__(512) k_p1(Params P) {
    const int lane = threadIdx.x & 63, w = threadIdx.x >> 6;
    mod_final(P, (size_t)blockIdx.x * 512 + threadIdx.x, (size_t)gridDim.x * 512);
    rownorm_pass<true>(P, P.x, P.g_norm1, 0, 1, (bf16_t*)(P.ws + WS_XN), blockIdx.x * 8 + w, gridDim.x * 8, lane);
}
__global__ void __launch_bounds__(512) k_p7(Params P) {
    const int lane = threadIdx.x & 63, w = threadIdx.x >> 6;
    rownorm_pass<false>(P, P.out, P.g_norm2, 3, 4, (bf16_t*)(P.ws + WS_XN), blockIdx.x * 8 + w, gridDim.x * 8, lane);
}
__global__ void __launch_bounds__(256) k_kr(Params P) { kr_pass(P, (size_t)blockIdx.x * 256 + threadIdx.x, (size_t)gridDim.x * 256); }

struct GemmArgs { const bf16_t* A; const bf16_t* Bt; int lda, ldb, K, pad; };
struct EpiProj { bf16_t* proj; float* ssq;
    __device__ void operator()(int r, int c, float v) const { proj[(size_t)r * PLD + c] = (bf16_t)f2bf(v);
        if (c < 256) atomicAdd(ssq + 2 * r, v * v); else if (c < 384) atomicAdd(ssq + 2 * r + 1, v * v); } };
struct EpiPlain { bf16_t* o; int ldc, pad;
    __device__ void operator()(int r, int c, float v) const { o[(size_t)r * ldc + c] = (bf16_t)f2bf(v); } };
struct EpiRowScale { bf16_t* o; const float* ssq; int ldc, which; float inv_n; int pad;
    __device__ void operator()(int r, int c, float v) const { o[(size_t)r * ldc + c] = (bf16_t)f2bf(v * (1.0f / sqrtf(ssq[2 * r + which] * inv_n + EPS))); } };
struct EpiColScale { bf16_t* o; const float* ssq; int ldc, which; float inv_n; int pad;
    __device__ void operator()(int r, int c, float v) const { o[(size_t)r * ldc + c] = (bf16_t)f2bf(v * (1.0f / sqrtf(ssq[2 * c + which] * inv_n + EPS))); } };
struct EpiResid { const float* x; const float* mod; float* out;
    __device__ void operator()(int r, int c, float v) const { const int b = r / SEQ; out[(size_t)r * D + c] = x[(size_t)r * D + c] + mod[(size_t)b * 6144 + 2 * D + c] * v; } };

template <class Epi> __global__ void __launch_bounds__(256) k_ngemm(GemmArgs g, Epi epi) {
    const bf16_t* A = g.A; const bf16_t* Bt = g.Bt; const int lda = g.lda, ldb = g.ldb, K = g.K;
    __shared__ float As[16][65], Bs[16][65];
    const int tx = threadIdx.x & 15, ty = threadIdx.x >> 4;
    const int m0 = blockIdx.y * 64, n0 = blockIdx.x * 64;
    float acc[4][4] = {};
    for (int k0 = 0; k0 < K; k0 += 16) {
#pragma unroll
        for (int i = 0; i < 4; ++i) { const int e = threadIdx.x + 256 * i, r = e >> 4, kk = e & 15;
            As[kk][r] = bf2f(A[(size_t)(m0 + r) * lda + k0 + kk]); Bs[kk][r] = bf2f(Bt[(size_t)(n0 + r) * ldb + k0 + kk]); }
        __syncthreads();
#pragma unroll
        for (int kk = 0; kk < 16; ++kk) {
            float a[4], b[4];
#pragma unroll
            for (int i = 0; i < 4; ++i) { a[i] = As[kk][ty * 4 + i]; b[i] = Bs[kk][tx * 4 + i]; }
#pragma unroll
            for (int i = 0; i < 4; ++i)
#pragma unroll
                for (int j = 0; j < 4; ++j) acc[i][j] += a[i] * b[j];
        }
        __syncthreads();
    }
#pragma unroll
    for (int i = 0; i < 4; ++i)
#pragma unroll
        for (int j = 0; j < 4; ++j) epi(m0 + ty * 4 + i, n0 + tx * 4 + j, acc[i][j]);
}

__global__ void __launch_bounds__(64) k_nattn(Params P) {
    __shared__ float Ks[32][97], Vs[32][65];
    const bf16_t* Q = (const bf16_t*)(P.ws + WS_Q); const bf16_t* KN = (const bf16_t*)(P.ws + WS_KN); const bf16_t* KR = (const bf16_t*)(P.ws + WS_KR);
    const bf16_t* VT = (const bf16_t*)(P.ws + WS_VT); bf16_t* Y = (bf16_t*)(P.ws + WS_XN);
    const int qb = blockIdx.x, h = blockIdx.y, b = blockIdx.z, tid = threadIdx.x;
    const int qi = qb * 64 + tid; const size_t tq = (size_t)b * SEQ + qi;
    float q[96];
#pragma unroll
    for (int d = 0; d < 64; ++d) q[d] = bf2f(Q[tq * 768 + h * 96 + d]);
    { const float pos = (float)P.positions[tq];
#pragma unroll
      for (int f = 0; f < 16; ++f) { const float x1 = bf2f(Q[tq * 768 + h * 96 + 64 + f]), x2 = bf2f(Q[tq * 768 + h * 96 + 80 + f]); float s, c; sincos_rad(pos * INV64[2 * f], s, c);
          q[64 + f] = x1 * c - x2 * s; q[80 + f] = x1 * s + x2 * c; } }
    float o[64];
#pragma unroll
    for (int d = 0; d < 64; ++d) o[d] = 0.f;
    float m = -INFINITY, l = 0.f;
    const int nkt = (qb * 64 + 64) / 32;
    for (int kt = 0; kt < nkt; ++kt) {
        const int j0 = kt * 32;
        __syncthreads();
        for (int e = tid; e < 32 * 96; e += 64) { const int j = e / 96, d = e % 96; const size_t tk = (size_t)b * SEQ + j0 + j;
            Ks[j][d] = d < 64 ? bf2f(KN[tk * 512 + h * 64 + d]) : bf2f(KR[tk * 32 + d - 64]); }
        for (int e = tid; e < 32 * 64; e += 64) { const int d = e / 32, j = e % 32; Vs[j][d] = bf2f(VT[(size_t)(h * 64 + d) * T + (size_t)b * SEQ + j0 + j]); }
        __syncthreads();
        for (int j = 0; j < 32; ++j) {
            if (j0 + j > qi) break;
            float s = 0.f;
#pragma unroll
            for (int d = 0; d < 96; ++d) s += q[d] * Ks[j][d];
            const float mn = fmaxf(m, s), sc = exp2f(m - mn), p = exp2f(s - mn);
            l = l * sc + p; m = mn;
#pragma unroll
            for (int d = 0; d < 64; ++d) o[d] = o[d] * sc + p * Vs[j][d];
        }
    }
    const float il = 1.f / l;
#pragma unroll
    for (int d = 0; d < 64; ++d) Y[tq * D + h * 64 + d] = (bf16_t)f2bf(o[d] * il);
}

__global__ void __launch_bounds__(64) k_nret(Params P) {
    __shared__ float qs[64], ks[64];
    const bf16_t* proj = (const bf16_t*)(P.ws + WS_PROJ); const bf16_t* projt = (const bf16_t*)(P.ws + WS_PROJT); bf16_t* Y = (bf16_t*)(P.ws + WS_XN);
    const int h = blockIdx.x, b = blockIdx.y, dv = threadIdx.x;
    const float gamma = 1.0f - exp2f(-5.0f - (float)h);
    float S[64];
#pragma unroll
    for (int i = 0; i < 64; ++i) S[i] = 0.f;
    const float gr = P.g_ret_norm[h * 64 + dv];
    const int f = dv & 31; const float inv = INV64[f];
    for (int t = 0; t < SEQ; ++t) {
        const size_t tt = (size_t)b * SEQ + t;
        const float qa = bf2f(proj[tt * PLD + PC_RQ + h * 64 + f]), qb2 = bf2f(proj[tt * PLD + PC_RQ + h * 64 + 32 + f]);
        const float ka = bf2f(proj[tt * PLD + PC_RK + h * 64 + f]), kb2 = bf2f(proj[tt * PLD + PC_RK + h * 64 + 32 + f]);
        float s, c; sincos_rad((float)P.positions[tt] * inv, s, c);
        const float qv = dv < 32 ? qa * c - qb2 * s : qa * s + qb2 * c;
        const float kv = (dv < 32 ? ka * c - kb2 * s : ka * s + kb2 * c) * 0.125f;
        __syncthreads();
        qs[dv] = qv; ks[dv] = kv;
        __syncthreads();
        const float v = bf2f(projt[(size_t)(PT_RV + h * 64 + dv) * T + tt]);
        float y = 0.f;
#pragma unroll
        for (int i = 0; i < 64; ++i) { S[i] = S[i] * gamma + ks[i] * v; y += qs[i] * S[i]; }
        const float mu = wave_sum(y) * (1.f / 64.f); const float dlt = y - mu; const float var = wave_sum(dlt * dlt) * (1.f / 64.f);
        const float yn = dlt * (1.0f / sqrtf(var + EPS)) * gr;
        const float gate = bf2f(proj[tt * PLD + PC_RG + h * 64 + dv]);
        Y[tt * D + 512 + h * 64 + dv] = (bf16_t)f2bf(silu_f(gate) * yn);
    }
}

constexpr int NROUTE_LDS = (2 * 128 * 64 + 2 * 16 * 64 * 2) * 4;
__global__ void __launch_bounds__(64) k_nroute(Params P) {
    extern __shared__ float sm[];
    float* sc = sm; float* tv = sm + 2 * 128 * 64; int* ti = (int*)(tv + 2 * 16 * 64);
    const bf16_t* QP = (const bf16_t*)(P.ws + WS_PROJ); const bf16_t* SK = (const bf16_t*)(P.ws + WS_SK);
    int* eidx = (int*)(P.ws + WS_EIDX); float* gate = (float*)(P.ws + WS_GATE);
    const int tid = threadIdx.x; const size_t pair = (size_t)blockIdx.x * 64 + tid; const size_t t = pair >> 3; const int h = (int)(pair & 7);
    for (int p = 0; p < 2; ++p) {
        float q[128];
#pragma unroll
        for (int d = 0; d < 128; ++d) q[d] = bf2f(QP[t * 2048 + h * 256 + p * 128 + d]);
        for (int k = 0; k < 128; ++k) { float s = 0.f;
#pragma unroll
            for (int d = 0; d < 128; ++d) s += q[d] * bf2f(SK[(p * 128 + k) * 128 + d]);
            sc[(p * 128 + k) * 64 + tid] = s; }
    }
    for (int p = 0; p < 2; ++p) { float lastv = INFINITY; int lasti = -1;
        for (int r = 0; r < 16; ++r) { float bv = -INFINITY; int bi = -1;
            for (int k = 0; k < 128; ++k) { const float v = sc[(p * 128 + k) * 64 + tid];
                const bool ok = (v < lastv) || (v == lastv && k > lasti);
                if (ok && (v > bv)) { bv = v; bi = k; } }
            tv[(p * 16 + r) * 64 + tid] = bv; ti[(p * 16 + r) * 64 + tid] = bi; lastv = bv; lasti = bi; } }
    float best[16]; int bidx[16];
    { float lastv = INFINITY; int lastc = -1;
#pragma unroll
      for (int r = 0; r < 16; ++r) { float bv = -INFINITY; int bc = -1;
          for (int cnd = 0; cnd < 256; ++cnd) { const float v = tv[(cnd >> 4) * 64 + tid] + tv[(16 + (cnd & 15)) * 64 + tid];
              const bool ok = (v < lastv) || (v == lastv && cnd > lastc);
              if (ok && (v > bv)) { bv = v; bc = cnd; } }
          best[r] = bv; bidx[r] = ti[(bc >> 4) * 64 + tid] * 128 + ti[(16 + (bc & 15)) * 64 + tid]; lastv = bv; lastc = bc; } }
    float ssum = 0.f; float e[16];
#pragma unroll
    for (int r = 0; r < 16; ++r) { e[r] = __expf(best[r] - best[0]); ssum += e[r]; }
    const float inv = 1.f / ssum;
#pragma unroll
    for (int r = 0; r < 16; ++r) { eidx[t * 128 + h * 16 + r] = bidx[r]; gate[t * 128 + h * 16 + r] = e[r] * inv; }
}

__global__ void __launch_bounds__(256) k_ngather(Params P) {
    __shared__ float wsm[128]; __shared__ float red[4];
    const bf16_t* H2 = (const bf16_t*)(P.ws + WS_XN); const bf16_t* EU = (const bf16_t*)(P.ws + WS_EU); const bf16_t* EV = (const bf16_t*)(P.ws + WS_EV);
    const int* eidx = (const int*)(P.ws + WS_EIDX); const float* gate = (const float*)(P.ws + WS_GATE); const float* mod = (const float*)(P.ws + WS_MOD);
    const size_t t = blockIdx.x; const int tid = threadIdx.x, lane = tid & 63, w = tid >> 6; const int b = (int)(t / SEQ);
    float hv[16];
#pragma unroll
    for (int i = 0; i < 16; ++i) hv[i] = bf2f(H2[t * D + lane * 16 + i]);
    for (int s = w * 32; s < w * 32 + 32; ++s) { const int e = eidx[t * 128 + s]; float a = 0.f;
#pragma unroll
        for (int i = 0; i < 16; ++i) a += hv[i] * bf2f(EU[(size_t)e * D + lane * 16 + i]);
        a = wave_sum(a); if (lane == 0) wsm[s] = gate[t * 128 + s] * gelu_exact(a); }
    __syncthreads();
    f32x4 acc = {0.f, 0.f, 0.f, 0.f};
    for (int s = 0; s < 128; ++s) { const int e = eidx[t * 128 + s]; const float ww = wsm[s];
        const u32x2 v = *(const u32x2*)(EV + (size_t)e * D + tid * 4);
        acc.x += ww * bflo(v.x); acc.y += ww * bfhi(v.x); acc.z += ww * bflo(v.y); acc.w += ww * bfhi(v.y); }
    const f32x4 x2 = *(const f32x4*)(P.out + t * D + tid * 4); const f32x4 g2 = *(const f32x4*)(mod + (size_t)b * 6144 + 5 * D + tid * 4);
    const f32x4 x3 = x2 + g2 * acc;
    float s = (x3.x * x3.x + x3.y * x3.y) + (x3.z * x3.z + x3.w * x3.w); s = wave_sum(s);
    if (lane == 0) red[w] = s;
    __syncthreads();
    const float rstd = 1.0f / sqrtf((red[0] + red[1] + red[2] + red[3]) * (1.f / D) + EPS);
    const f32x4 gf = *(const f32x4*)(P.g_final + tid * 4);
    *(f32x4*)(P.out + t * D + tid * 4) = x3 * rstd * gf;
}

extern "C" void kernel_launch(void* const* d_in, const int* in_sizes, int n_in, void* d_out, int out_size, void* d_ws, size_t ws_size, hipStream_t stream) {
    if (n_in != 19 || out_size != T * D || ws_size < WS_END) { fprintf(stderr, "kernel_launch: unexpected shapes (n_in %d out %d ws %zu)\n", n_in, out_size, ws_size); return; }
    Params P{};
    P.x = (const float*)d_in[0]; P.c = (const float*)d_in[1]; P.positions = (const int*)d_in[2]; P.w_ada = (const float*)d_in[3]; P.b_ada = (const float*)d_in[4];
    P.g_norm1 = (const float*)d_in[5]; P.w_in = (const float*)d_in[6]; P.g_q_norm = (const float*)d_in[7]; P.w_uq = (const float*)d_in[8]; P.g_kv_norm = (const float*)d_in[9];
    P.w_ukv = (const float*)d_in[10]; P.g_ret_norm = (const float*)d_in[11]; P.w_out = (const float*)d_in[12]; P.g_norm2 = (const float*)d_in[13]; P.w_query = (const float*)d_in[14];
    P.sub_keys = (const float*)d_in[15]; P.expert_u = (const float*)d_in[16]; P.expert_v = (const float*)d_in[17]; P.g_final = (const float*)d_in[18];
    P.out = (float*)d_out; P.ws = (unsigned char*)d_ws;
    unsigned char* ws = P.ws;
    bf16_t* XN = (bf16_t*)(ws + WS_XN); bf16_t* PROJ = (bf16_t*)(ws + WS_PROJ); bf16_t* PROJT = (bf16_t*)(ws + WS_PROJT); float* SSQ = (float*)(ws + WS_SSQ);
    static bool attr_done = false;
    if (!attr_done) { (void)hipFuncSetAttribute((const void*)k_nroute, hipFuncAttributeMaxDynamicSharedMemorySize, NROUTE_LDS); attr_done = true; }
    const bf16_t* W1T = (const bf16_t*)(ws + WS_W1T); const bf16_t* W1TT = (const bf16_t*)(ws + WS_W1TT);
    k_p0<<<256, 512, 0, stream>>>(P);
    k_p1<<<256, 512, 0, stream>>>(P);
    k_ngemm<EpiProj><<<dim3(2048 / 64, T / 64), 256, 0, stream>>>(GemmArgs{XN, W1T, D, D, D, 0}, EpiProj{PROJ, SSQ});
    k_ngemm<EpiPlain><<<dim3(T / 64, 1024 / 64), 256, 0, stream>>>(GemmArgs{W1TT, XN, D, D, D, 0}, EpiPlain{PROJT, T, 0});
    k_ngemm<EpiRowScale><<<dim3(768 / 64, T / 64), 256, 0, stream>>>(GemmArgs{PROJ + PC_QL, (const bf16_t*)(ws + WS_WUQ), PLD, 256, 256, 0}, EpiRowScale{(bf16_t*)(ws + WS_Q), SSQ, 768, 0, 1.f / 256.f, 0});
    k_ngemm<EpiRowScale><<<dim3(512 / 64, T / 64), 256, 0, stream>>>(GemmArgs{PROJ + PC_KVL, (const bf16_t*)(ws + WS_WK), PLD, 256, 256, 0}, EpiRowScale{(bf16_t*)(ws + WS_KN), SSQ, 512, 1, 1.f / 128.f, 0});
    k_ngemm<EpiColScale><<<dim3(T / 64, 512 / 64), 256, 0, stream>>>(GemmArgs{(const bf16_t*)(ws + WS_WV), PROJ + PC_KVL, 256, PLD, 256, 0}, EpiColScale{(bf16_t*)(ws + WS_VT), SSQ, T, 1, 1.f / 128.f, 0});
    k_kr<<<1024, 256, 0, stream>>>(P);
    k_nattn<<<dim3(SEQ / 64, NH, NB), 64, 0, stream>>>(P);
    k_nret<<<dim3(NH, NB), 64, 0, stream>>>(P);
    k_ngemm<EpiResid><<<dim3(1024 / 64, T / 64), 256, 0, stream>>>(GemmArgs{XN, (const bf16_t*)(ws + WS_WOUT), D, D, D, 0}, EpiResid{P.x, (const float*)(ws + WS_MOD), P.out});
    k_p7<<<256, 512, 0, stream>>>(P);
    k_ngemm<EpiPlain><<<dim3(2048 / 64, T / 64), 256, 0, stream>>>(GemmArgs{XN, (const bf16_t*)(ws + WS_WQ), D, D, D, 0}, EpiPlain{PROJ, 2048, 0});
    k_nroute<<<T * 8 / 64, 64, NROUTE_LDS, stream>>>(P);
    k_ngather<<<T, 256, 0, stream>>>(P);
}
```

```cpp
#include <hip/hip_runtime.h>
#include <hip/hip_cooperative_groups.h>
#include <cstdint>
#include <cstdio>

typedef unsigned short bf16_t;
typedef float f32x4 __attribute__((ext_vector_type(4)));
typedef unsigned u32x4 __attribute__((ext_vector_type(4)));
typedef unsigned u32x2 __attribute__((ext_vector_type(2)));

constexpr int NB = 4, SEQ = 8192, T = NB * SEQ, D = 1024;
constexpr int IN_COLS = 2464;
constexpr int NH = 8;
constexpr int QK = 96, NOPE = 64, ROPE = 32, DV = 64;
constexpr int QR = 256, KVR = 128;
constexpr int NEXP = 16384, PK = 16, NKEYS = 128;
constexpr float EPS = 1e-6f;
constexpr float LOG2E = 1.4426950408889634f;
constexpr float QSCALE = 0.10206207261596575f * LOG2E;

constexpr size_t MiB = 1u << 20;
constexpr size_t WS_CTL = 0;
constexpr size_t WS_MODP = 1 * MiB;
constexpr size_t WS_MOD = 3 * MiB - 128 * 1024;
constexpr size_t WS_SSQ = 3 * MiB;
constexpr size_t WS_W1T = 4 * MiB;
constexpr size_t WS_W1TT = 8 * MiB;
constexpr size_t WS_WUQ = 10 * MiB;
constexpr size_t WS_WK = 10 * MiB + 512 * 1024;
constexpr size_t WS_WV = 10 * MiB + 768 * 1024;
constexpr size_t WS_WOUT = 11 * MiB;
constexpr size_t WS_WQ = 13 * MiB;
constexpr size_t WS_SK = 17 * MiB;
constexpr size_t WS_EU = 18 * MiB;
constexpr size_t WS_EV = 50 * MiB;
constexpr size_t WS_XN = 82 * MiB;
constexpr size_t WS_PROJ = 146 * MiB;
constexpr size_t WS_PROJT = 274 * MiB;
constexpr size_t WS_Q = 338 * MiB;
constexpr size_t WS_KN = 386 * MiB;
constexpr size_t WS_KR = 418 * MiB;
constexpr size_t WS_VT = 420 * MiB;
constexpr size_t WS_KVC = 452 * MiB;
constexpr size_t WS_END = 484 * MiB;
constexpr size_t WS_EIDX = WS_PROJT;
constexpr size_t WS_GATE = WS_PROJT + 16 * MiB;

constexpr int PC_QL = 0, PC_KVL = 256, PC_KR = 384, PC_RQ = 512, PC_RK = 1024, PC_RG = 1536, PLD = 2048;
constexpr int PT_RK = 0, PT_RV = 512;

__constant__ float INV64[32] = {1.0f, 0.749894261f, 0.562341332f, 0.421696514f, 0.316227764f, 0.237137377f, 0.177827939f, 0.133352131f, 0.100000001f, 0.0749894157f, 0.0562341325f, 0.0421696529f, 0.0316227749f, 0.0237137377f, 0.0177827943f, 0.0133352149f, 0.00999999978f, 0.00749894185f, 0.00562341325f, 0.00421696482f, 0.00316227763f, 0.00237137359f, 0.00177827943f, 0.00133352145f, 0.00100000005f, 0.000749894243f, 0.000562341302f, 0.000421696517f, 0.000316227757f, 0.00023713737f, 0.00017782794f, 0.00013335215f};

struct Params {
    const float *x, *c; const int* positions; const float *w_ada, *b_ada, *g_norm1, *w_in, *g_q_norm, *w_uq, *g_kv_norm, *w_ukv, *g_ret_norm, *w_out, *g_norm2, *w_query, *sub_keys, *expert_u, *expert_v, *g_final;
    float* out; unsigned char* ws;
};

__device__ __forceinline__ unsigned f2bf(float f) { unsigned u = __builtin_bit_cast(unsigned, f); return (u + 0x7fffu + ((u >> 16) & 1u)) >> 16; }
__device__ __forceinline__ unsigned pk2(float lo, float hi) { return f2bf(lo) | (f2bf(hi) << 16); }
__device__ __forceinline__ float bf2f(unsigned short b) { return __builtin_bit_cast(float, (unsigned)b << 16); }
__device__ __forceinline__ float bflo(unsigned w) { return __builtin_bit_cast(float, w << 16); }
__device__ __forceinline__ float bfhi(unsigned w) { return __builtin_bit_cast(float, w & 0xffff0000u); }
__device__ __forceinline__ float wave_sum(float v) {
#pragma unroll
    for (int o = 1; o < 64; o <<= 1) v += __shfl_xor(v, o);
    return v;
}
__device__ __forceinline__ float silu_f(float v) { return v / (1.f + __expf(-v)); }
__device__ __forceinline__ void sincos_rad(float ang, float& s, float& c) {
    const float CH = 0.15915494f, CL = 3.0918913e-09f;
    const float rh = ang * CH, rl = __builtin_fmaf(ang, CH, -rh) + ang * CL;
    const float fr = (rh - __builtin_floorf(rh)) + rl;
    s = __builtin_amdgcn_sinf(fr); c = __builtin_amdgcn_cosf(fr);
}
__device__ __forceinline__ float gelu_exact(float v) { return 0.5f * v * (1.f + erff(v * 0.70710678118654752f)); }

__device__ __forceinline__ void p0_mod_item(const Params& P, int item, int lane) {
    const int kc = item / 24, nc = item % 24, n = nc * 256 + lane * 4;
    f32x4 acc[4] = {};
    for (int kk = 0; kk < 64; ++kk) {
        const int k = kc * 64 + kk;
        const f32x4 w = *(const f32x4*)(P.w_ada + (size_t)k * 6144 + n);
#pragma unroll
        for (int b = 0; b < 4; ++b) { const float s = silu_f(P.c[b * D + k]); acc[b] += w * s; }
    }
    float* modp = (float*)(P.ws + WS_MODP);
#pragma unroll
    for (int b = 0; b < 4; ++b) *(f32x4*)(modp + (size_t)(kc * 4 + b) * 6144 + n) = acc[b];
}
__device__ __forceinline__ void p0_transpose_block(const float* W, int ldw, int k0, int n0, bf16_t* dst, int row0, int ldd, const float* kscale, float scale, float* scr, int lane) {
#pragma unroll 8
    for (int i = 0; i < 32; ++i) { const int kk = 2 * i + (lane >> 5); const float ks = kscale ? kscale[k0 + kk] * scale : scale;
        scr[kk * 33 + (lane & 31)] = W[(size_t)(k0 + kk) * ldw + n0 + (lane & 31)] * ks; }
    asm volatile("s_waitcnt vmcnt(0) lgkmcnt(0)" ::: "memory");
    const int c = lane & 7;
#pragma unroll
    for (int j = 0; j < 4; ++j) { const int n = (lane >> 3) + 8 * j; const float* s = scr + (8 * c) * 33 + n;
        u32x4 o; o.x = pk2(s[0 * 33], s[1 * 33]); o.y = pk2(s[2 * 33], s[3 * 33]); o.z = pk2(s[4 * 33], s[5 * 33]); o.w = pk2(s[6 * 33], s[7 * 33]);
        *(u32x4*)(dst + (size_t)(row0 + n) * ldd + k0 + 8 * c) = o; }
    asm volatile("s_waitcnt vmcnt(0) lgkmcnt(0)" ::: "memory");
}
__device__ __forceinline__ void cvt8(const float* src, bf16_t* dst, size_t n8, size_t gt, size_t nt) {
    for (size_t i = gt; i < n8; i += nt) { const f32x4 a = *(const f32x4*)(src + i * 8), b = *(const f32x4*)(src + i * 8 + 4);
        u32x4 o; o.x = pk2(a.x, a.y); o.y = pk2(a.z, a.w); o.z = pk2(b.x, b.y); o.w = pk2(b.z, b.w); *(u32x4*)(dst + i * 8) = o; }
}
constexpr int IT_MOD = 384, IT_WIN = 16 * 77, IT_WUQ = 4 * 24, IT_WUKV = 2 * 32, IT_WOUT = 16 * 32, IT_WQ = 16 * 64;
constexpr int IT_TOTAL = IT_MOD + IT_WIN + IT_WUQ + IT_WUKV + IT_WOUT + IT_WQ;
__device__ __forceinline__ void p0_prologue(const Params& P, int gw, int nw, int lane, float* scr) {
    unsigned char* ws = P.ws;
    for (int it = gw; it < IT_TOTAL; it += nw) {
        int r = it;
        if (r < IT_MOD) { p0_mod_item(P, r, lane); continue; } r -= IT_MOD;
        if (r < IT_WIN) { const int kb = r / 77, nb = r % 77, n0 = nb * 32, k0 = kb * 64;
            bf16_t* w1t = (bf16_t*)(ws + WS_W1T); bf16_t* w1tt = (bf16_t*)(ws + WS_W1TT);
            if (n0 < 416) p0_transpose_block(P.w_in, IN_COLS, k0, n0, w1t, n0, D, nullptr, 1.f, scr, lane);
            else if (n0 < 928) p0_transpose_block(P.w_in, IN_COLS, k0, n0, w1t, PC_RQ + (n0 - 416), D, nullptr, 1.f, scr, lane);
            else if (n0 < 1440) { p0_transpose_block(P.w_in, IN_COLS, k0, n0, w1t, PC_RK + (n0 - 928), D, nullptr, 1.f, scr, lane);
                                  p0_transpose_block(P.w_in, IN_COLS, k0, n0, w1tt, PT_RK + (n0 - 928), D, nullptr, 1.f, scr, lane); }
            else if (n0 < 1952) p0_transpose_block(P.w_in, IN_COLS, k0, n0, w1tt, PT_RV + (n0 - 1440), D, nullptr, 1.f, scr, lane);
            else p0_transpose_block(P.w_in, IN_COLS, k0, n0, w1t, PC_RG + (n0 - 1952), D, nullptr, 1.f, scr, lane);
            continue; } r -= IT_WIN;
        if (r < IT_WUQ) { const int kb = r / 24, nb = r % 24; p0_transpose_block(P.w_uq, 768, kb * 64, nb * 32, (bf16_t*)(ws + WS_WUQ), nb * 32, 256, P.g_q_norm, QSCALE, scr, lane); continue; } r -= IT_WUQ;
        if (r < IT_WUKV) { const int kb = r / 32, nb = r % 32, n0 = nb * 32, h = n0 >> 7, rr = n0 & 127;
            if (rr < 64) p0_transpose_block(P.w_ukv, 1024, kb * 64, n0, (bf16_t*)(ws + WS_WK), h * 64 + rr, 256, P.g_kv_norm, 1.f, scr, lane);
            else p0_transpose_block(P.w_ukv, 1024, kb * 64, n0, (bf16_t*)(ws + WS_WV), h * 64 + rr - 64, 256, P.g_kv_norm, 1.f, scr, lane);
            continue; } r -= IT_WUKV;
        if (r < IT_WOUT) { const int kb = r / 32, nb = r % 32; p0_transpose_block(P.w_out, 1024, kb * 64, nb * 32, (bf16_t*)(ws + WS_WOUT), nb * 32, 1024, nullptr, 1.f, scr, lane); continue; } r -= IT_WOUT;
        { const int kb = r / 64, nb = r % 64; p0_transpose_block(P.w_query, 2048, kb * 64, nb * 32, (bf16_t*)(ws + WS_WQ), nb * 32, 1024, nullptr, 1.f, scr, lane); }
    }
    const size_t gt = (size_t)gw * 64 + lane, nt = (size_t)nw * 64;
    { u32x4 z = {0u, 0u, 0u, 0u};
      for (size_t i = gt; i < 96 * 1024 / 8; i += nt) *(u32x4*)((bf16_t*)(ws + WS_W1T) + (size_t)416 * 1024 + i * 8) = z;
      for (size_t i = gt; i < 2 * 512 * 16; i += nt) { const size_t m = i / (512 * 16), rr = (i / 16) % 512, cc = i % 16; *(u32x4*)((bf16_t*)(ws + (m ? WS_WV : WS_WK)) + rr * 256 + 128 + cc * 8) = z; }
      for (size_t i = gt; i < (size_t)T * 2 / 4; i += nt) *(u32x4*)((float*)(ws + WS_SSQ) + i * 4) = z; }
    cvt8(P.sub_keys, (bf16_t*)(ws + WS_SK), 2 * 128 * 128 / 8, gt, nt);
    cvt8(P.expert_u, (bf16_t*)(ws + WS_EU), (size_t)NEXP * D / 8, gt, nt);
    cvt8(P.expert_v, (bf16_t*)(ws + WS_EV), (size_t)NEXP * D / 8, gt, nt);
}

template <bool FROM_PART> __device__ __forceinline__ void rownorm_pass(const Params& P, const float* src, const float* g, int seg_sh, int seg_sc, bf16_t* dst, int gw, int nw, int lane) {
    const float* modp = (const float*)(P.ws + WS_MODP); const float* mod = (const float*)(P.ws + WS_MOD);
    for (int r0 = gw * 16; r0 < T; r0 += nw * 16) {
        const int b = r0 / SEQ;
        f32x4 mul[4], add[4];
#pragma unroll
        for (int j = 0; j < 4; ++j) {
            const int col = lane * 4 + 256 * j;
            f32x4 sc, sh;
            if (FROM_PART) {
                sc = *(const f32x4*)(P.b_ada + seg_sc * D + col); sh = *(const f32x4*)(P.b_ada + seg_sh * D + col);
                for (int kc = 0; kc < 16; ++kc) { sc += *(const f32x4*)(modp + (size_t)(kc * 4 + b) * 6144 + seg_sc * D + col); sh += *(const f32x4*)(modp + (size_t)(kc * 4 + b) * 6144 + seg_sh * D + col); }
            } else { sc = *(const f32x4*)(mod + (size_t)b * 6144 + seg_sc * D + col); sh = *(const f32x4*)(mod + (size_t)b * 6144 + seg_sh * D + col); }
            const f32x4 gg = *(const f32x4*)(g + col);
            mul[j] = gg * (sc + 1.0f); add[j] = sh;
        }
        for (int rr = 0; rr < 16; ++rr) {
            const int row = r0 + rr;
            const f32x4* xr = (const f32x4*)(src + (size_t)row * D) + lane;
            f32x4 v[4]; float s = 0.f;
#pragma unroll
            for (int j = 0; j < 4; ++j) { v[j] = xr[64 * j]; s += (v[j].x * v[j].x + v[j].y * v[j].y) + (v[j].z * v[j].z + v[j].w * v[j].w); }
            const float rstd = 1.0f / sqrtf(wave_sum(s) * (1.f / D) + EPS);
            u32x2* o = (u32x2*)(dst + (size_t)row * D) + lane;
#pragma unroll
            for (int j = 0; j < 4; ++j) { const f32x4 y = v[j] * rstd * mul[j] + add[j]; u32x2 w; w.x = pk2(y.x, y.y); w.y = pk2(y.z, y.w); o[64 * j] = w; }
        }
    }
}
__device__ __forceinline__ void mod_final(const Params& P, size_t gt, size_t nt) {
    const float* modp = (const float*)(P.ws + WS_MODP); float* mod = (float*)(P.ws + WS_MOD);
    for (size_t i = gt; i < 4 * 6144; i += nt) { float s = P.b_ada[i % 6144]; for (int kc = 0; kc < 16; ++kc) s += modp[(size_t)kc * 4 * 6144 + i]; mod[i] = s; }
}

__device__ __forceinline__ void kr_pass(const Params& P, size_t gt, size_t nt) {
    const bf16_t* proj = (const bf16_t*)(P.ws + WS_PROJ); bf16_t* kr = (bf16_t*)(P.ws + WS_KR);
    for (size_t i = gt; i < (size_t)T * 16; i += nt) {
        const int t = (int)(i >> 4), f = (int)(i & 15);
        const float x1 = bf2f(proj[(size_t)t * PLD + PC_KR + f]), x2 = bf2f(proj[(size_t)t * PLD + PC_KR + 16 + f]);
        float s, c; sincos_rad((float)P.positions[t] * INV64[2 * f], s, c);
        kr[(size_t)t * 32 + f] = (bf16_t)f2bf(x1 * c - x2 * s); kr[(size_t)t * 32 + 16 + f] = (bf16_t)f2bf(x1 * s + x2 * c);
    }
}

namespace pg8 {
#define PG8_LAS __attribute__((address_space(3)))
typedef unsigned short bf16_t;
typedef short bf16x8 __attribute__((ext_vector_type(8)));
typedef float f32x4 __attribute__((ext_vector_type(4)));
typedef unsigned u32x4 __attribute__((ext_vector_type(4)));
constexpr int BM = 256, BK = 64, HALF = 128, HTB = HALF * BK * 2  , STAGE_BYTES = 8 * HTB, NXCD = 8, WGM = 8;

__host__ __device__ __forceinline__ int lds_byte(int r, int c) { const int st = (r >> 4) * 2 + (c >> 5), rr = r & 15, cc = c & 31, ob = rr * 64 + cc * 2; return st * 1024 + (ob ^ (((ob >> 9) & 1) << 5)); }
__host__ __device__ __forceinline__ void stage_rc(int b, int& R, int& C) { const int st = b / 1024, sb = b % 1024, swz = sb ^ (((sb >> 9) & 1) << 5); R = (st >> 1) * 16 + swz / 64; C = (st & 1) * 32 + (swz % 64) / 2; }
__host__ __device__ __forceinline__ int perm32(int rho) { const int n = rho >> 4, i = rho & 15; return 8 * (i >> 2) + 4 * n + (i & 3); }

struct Unit { int pm, pn; };
struct Gemm { const bf16_t* A; const bf16_t* Bt; int M, N, K, lda, ldb; };

struct StaticOrder {
    int nM, nN, nwg, G, c;
    __host__ __device__ void init(int M, int N, int G_, int c_) { nM = M / BM; nN = N / BM; nwg = nM * nN; G = G_; c = c_; }
    __host__ __device__ bool next(int i, Unit& u) const {
        const long L = (long)i * G + c; if (L >= nwg) return false;
        int wgid = (int)L; { const int q = nwg / NXCD, r = nwg % NXCD, xcd = wgid % NXCD, off = wgid / NXCD; wgid = (xcd < r ? xcd * (q + 1) : r * (q + 1) + (xcd - r) * q) + off; }
        const int nig = WGM * nN, gid = wgid / nig, fm = gid * WGM, gsz = (nM - fm) < WGM ? (nM - fm) : WGM;
        u.pm = fm + ((wgid % nig) % gsz); u.pn = (wgid % nig) / gsz; return true;
    }
    __device__ __forceinline__ void a_ready(const Unit&) const {}
    __device__ __forceinline__ void done(const Unit&) const {}
};


template <class Epi, class Sched, bool ALIGN_EPI = false, bool SP2 = false>
__device__ __forceinline__ void gemm_phase(PG8_LAS unsigned char* lds, const Gemm g, const Sched& S, const Epi& E) {
    int tid = threadIdx.x; asm volatile("" : "+v"(tid));
    const int wid = __builtin_amdgcn_readfirstlane(tid >> 6), lane = tid & 63, wr = wid >> 2, wc = wid & 3, fr = lane & 15, fq = lane >> 4;
    const int K = g.K, nt = K / BK;
    unsigned voffA[2], voffB[2];
#pragma unroll
    for (int i = 0; i < 2; ++i) { int R, C; stage_rc(tid * 16 + i * 8192, R, C); const int Rb = Epi::PERM ? ((R & ~31) + perm32(R & 31)) : R;
        voffA[i] = (unsigned)(R * g.lda + C) * 2u; voffB[i] = (unsigned)(Rb * g.ldb + C) * 2u; }
    const size_t kstep = (size_t)(BK * 2);
    const size_t hstepA = (size_t)HALF * g.lda * 2, hstepB = (size_t)HALF * g.ldb * 2;
    const size_t tstepA = 2 * hstepA, tstepB = 2 * hstepB;
    const unsigned ldsw = (unsigned)wid * 1024u;
    const int aoff = lds_byte(wr * 64 + fr, fq * 8), boff = lds_byte(wc * 32 + fr, fq * 8);
#define PG8_SA(b, h) (((b) * 2 + (h)) * HTB)
#define PG8_SB(b, h) ((4 + (b) * 2 + (h)) * HTB)
#define PG8_STAGE(bufoff, gbase, voff) do { _Pragma("unroll") for (int _i = 0; _i < 2; ++_i) \
        __builtin_amdgcn_global_load_lds((const unsigned*)((const char*)(gbase) + (voff)[_i]), (PG8_LAS unsigned*)(lds + (bufoff) + ldsw + _i * 8192), 16, 0, 0); } while (0)
#define PG8_LDA(dst, b, h) do { _Pragma("unroll") for (int m = 0; m < 4; ++m) _Pragma("unroll") for (int k = 0; k < 2; ++k) dst[m][k] = *(const PG8_LAS bf16x8*)(lds + PG8_SA(b, h) + aoff + m * 2048 + k * 1024); } while (0)
#define PG8_LDB(dst, b, h) do { _Pragma("unroll") for (int n = 0; n < 2; ++n) _Pragma("unroll") for (int k = 0; k < 2; ++k) dst[n][k] = *(const PG8_LAS bf16x8*)(lds + PG8_SB(b, h) + boff + n * 2048 + k * 1024); } while (0)
#define PG8_MMA(ai, bj, At, Bt) do { __builtin_amdgcn_s_setprio(1); _Pragma("unroll") for (int m = 0; m < 4; ++m) _Pragma("unroll") for (int n = 0; n < 2; ++n) _Pragma("unroll") for (int k = 0; k < 2; ++k) \
        acc[ai][bj][m][n] = __builtin_amdgcn_mfma_f32_16x16x32_bf16(Bt[n][k], At[m][k], acc[ai][bj][m][n], 0, 0, 0); __builtin_amdgcn_s_setprio(0); } while (0)
#define PG8_WAIT_V(n) asm volatile("s_waitcnt vmcnt(" #n ")" ::: "memory")
#define PG8_WAIT_L(n) asm volatile("s_waitcnt lgkmcnt(" #n ")" ::: "memory")
#define PG8_BAR __builtin_amdgcn_s_barrier()
#define PG8_SCHED __builtin_amdgcn_sched_barrier(0)
    Unit cur, nxt; int ui = 0;
    if (!S.next(0, cur)) return;
    f32x4 acc[2][2][4][2];
#pragma unroll
    for (int a = 0; a < 2; ++a)
#pragma unroll
        for (int b = 0; b < 2; ++b)
#pragma unroll
            for (int m = 0; m < 4; ++m)
#pragma unroll
                for (int n = 0; n < 2; ++n) acc[a][b][m][n] = (f32x4){0.f, 0.f, 0.f, 0.f};
    bf16x8 At[4][2], B0[2][2], B1[2][2];
    const char* cA = (const char*)g.A + (size_t)cur.pm * tstepA; const char* cB = (const char*)g.Bt + (size_t)cur.pn * tstepB;
    S.a_ready(cur);
    if constexpr (SP2) {
        PG8_STAGE(PG8_SB(0, 0), cB, voffB); PG8_STAGE(PG8_SB(0, 1), cB + hstepB, voffB); PG8_STAGE(PG8_SA(0, 0), cA, voffA); PG8_STAGE(PG8_SA(0, 1), cA + hstepA, voffA);
        if (wr == 1) PG8_BAR;
        PG8_WAIT_V(2); PG8_BAR;
        PG8_STAGE(PG8_SB(1, 0), cB + kstep, voffB); PG8_STAGE(PG8_SA(1, 0), cA + kstep, voffA); PG8_STAGE(PG8_SB(1, 1), cB + hstepB + kstep, voffB);
        PG8_WAIT_V(6); PG8_BAR;
    } else {
        PG8_STAGE(PG8_SB(0, 0), cB, voffB); PG8_STAGE(PG8_SA(0, 0), cA, voffA); PG8_STAGE(PG8_SB(0, 1), cB + hstepB, voffB); PG8_STAGE(PG8_SA(0, 1), cA + hstepA, voffA);
        if (wr == 1) PG8_BAR;
        PG8_WAIT_V(4); PG8_BAR;
        PG8_STAGE(PG8_SB(1, 0), cB + kstep, voffB); PG8_STAGE(PG8_SA(1, 0), cA + kstep, voffA); PG8_STAGE(PG8_SB(1, 1), cB + hstepB + kstep, voffB);
        PG8_WAIT_V(6); PG8_BAR;
    }
    for (;;) {
        const bool has_next = S.next(ui + 1, nxt);
        const char* nA = has_next ? (const char*)g.A + (size_t)nxt.pm * tstepA : cA; const char* nB = has_next ? (const char*)g.Bt + (size_t)nxt.pn * tstepB : cB;
        for (int t = 0; t < nt; t += 2) {
            const bool last = (t == nt - 2);
            const char* a1 = cA + (size_t)(t + 1) * kstep;
            const char* a2 = last ? nA : cA + (size_t)(t + 2) * kstep; const char* b2 = last ? nB : cB + (size_t)(t + 2) * kstep;
            const char* a3 = a2 + kstep; const char* b3 = b2 + kstep;
            if (last && has_next) S.a_ready(nxt);
            if constexpr (SP2) {
            PG8_LDB(B0, 0, 0); PG8_LDB(B1, 0, 1); PG8_SCHED; PG8_LDA(At, 0, 0); PG8_STAGE(PG8_SA(1, 1), a1 + hstepA, voffA);
            PG8_WAIT_V(8); PG8_WAIT_L(0); PG8_BAR; PG8_MMA(0, 0, At, B0); PG8_MMA(0, 1, At, B1); PG8_BAR; PG8_SCHED;
            PG8_LDA(At, 0, 1); PG8_STAGE(PG8_SB(0, 0), b2, voffB); PG8_STAGE(PG8_SB(0, 1), b2 + hstepB, voffB); PG8_STAGE(PG8_SA(0, 0), a2, voffA);
            PG8_WAIT_V(8); PG8_WAIT_L(0); PG8_BAR; PG8_MMA(1, 0, At, B0); PG8_MMA(1, 1, At, B1); PG8_BAR; PG8_SCHED;
            PG8_LDB(B0, 1, 0); PG8_LDB(B1, 1, 1); PG8_SCHED; PG8_LDA(At, 1, 0); PG8_STAGE(PG8_SA(0, 1), a2 + hstepA, voffA);
            PG8_WAIT_V(8); PG8_WAIT_L(0); PG8_BAR; PG8_MMA(0, 0, At, B0); PG8_MMA(0, 1, At, B1); PG8_BAR; PG8_SCHED;
            PG8_LDA(At, 1, 1); PG8_STAGE(PG8_SB(1, 0), b3, voffB); PG8_STAGE(PG8_SB(1, 1), b3 + hstepB, voffB); PG8_STAGE(PG8_SA(1, 0), a3, voffA);
            PG8_WAIT_V(8); PG8_WAIT_L(0); PG8_BAR; PG8_MMA(1, 0, At, B0); PG8_MMA(1, 1, At, B1); PG8_BAR; PG8_SCHED;
            } else {
            PG8_LDB(B0, 0, 0); PG8_SCHED; PG8_LDA(At, 0, 0); PG8_STAGE(PG8_SA(1, 1), a1 + hstepA, voffA);
            PG8_WAIT_L(8); PG8_BAR; PG8_WAIT_L(0); PG8_MMA(0, 0, At, B0); PG8_BAR; PG8_SCHED;
            PG8_LDB(B1, 0, 1); PG8_STAGE(PG8_SB(0, 0), b2, voffB);
            PG8_BAR; PG8_WAIT_L(0); PG8_MMA(0, 1, At, B1); PG8_BAR;
            PG8_LDA(At, 0, 1); PG8_STAGE(PG8_SA(0, 0), a2, voffA);
            PG8_BAR; PG8_WAIT_L(0); PG8_MMA(1, 0, At, B0); PG8_BAR; PG8_SCHED;
            PG8_STAGE(PG8_SB(0, 1), b2 + hstepB, voffB);
            PG8_WAIT_V(6); PG8_BAR; PG8_MMA(1, 1, At, B1); PG8_BAR;
            PG8_LDB(B0, 1, 0); PG8_SCHED; PG8_LDA(At, 1, 0); PG8_STAGE(PG8_SA(0, 1), a2 + hstepA, voffA);
            PG8_WAIT_L(8); PG8_BAR; PG8_WAIT_L(0); PG8_MMA(0, 0, At, B0); PG8_BAR; PG8_SCHED;
            PG8_LDB(B1, 1, 1); PG8_STAGE(PG8_SB(1, 0), b3, voffB);
            PG8_BAR; PG8_WAIT_L(0); PG8_MMA(0, 1, At, B1); PG8_BAR;
            PG8_LDA(At, 1, 1); PG8_STAGE(PG8_SA(1, 0), a3, voffA);
            PG8_BAR; PG8_WAIT_L(0); PG8_MMA(1, 0, At, B0); PG8_BAR; PG8_SCHED;
            PG8_STAGE(PG8_SB(1, 1), b3 + hstepB, voffB);
            PG8_WAIT_V(6); PG8_BAR; PG8_MMA(1, 1, At, B1); PG8_BAR;
            }
        }
        if constexpr (ALIGN_EPI) { if (wr == 0) PG8_BAR; }
        if constexpr (!Epi::AFTER_DRAIN) { E(acc, cur, wr, wc, fr, fq); S.done(cur); }
        if (!has_next) break;
#pragma unroll
        for (int a = 0; a < 2; ++a)
#pragma unroll
            for (int b = 0; b < 2; ++b)
#pragma unroll
                for (int m = 0; m < 4; ++m)
#pragma unroll
                    for (int n = 0; n < 2; ++n) acc[a][b][m][n] = (f32x4){0.f, 0.f, 0.f, 0.f};
        cur = nxt; cA = nA; cB = nB; ++ui;
        if constexpr (ALIGN_EPI) { if (wr == 1) PG8_BAR; }
    }
    PG8_WAIT_V(0);
    if constexpr (!ALIGN_EPI) { if (wr == 0) PG8_BAR; }
    PG8_BAR;
    if constexpr (Epi::AFTER_DRAIN) { E.fused(acc, cur, wr, wc, fr, fq, lds, wid, lane); S.done(cur); }
#undef PG8_SA
#undef PG8_SB
#undef PG8_STAGE
#undef PG8_LDA
#undef PG8_LDB
#undef PG8_MMA
#undef PG8_WAIT_V
#undef PG8_WAIT_L
#undef PG8_BAR
#undef PG8_SCHED
}
}

namespace epi {
using pg8::f32x4; using pg8::u32x4; using pg8::Unit; using pg8::HALF; using pg8::BM;
__device__ __forceinline__ unsigned cvt_pk_bf16(float lo, float hi) { unsigned r; asm volatile("v_cvt_pk_bf16_f32 %0, %1, %2" : "=v"(r) : "v"(lo), "v"(hi)); return r; }
template <int MODE> struct EpiStore {
    static constexpr bool PERM = true, AFTER_DRAIN = false;
    bf16_t* O; int ldc; float* ssq; int which; float inv_n;
    __device__ __forceinline__ void operator()(const f32x4 (&acc)[2][2][4][2], const Unit& u, int wr, int wc, int fr, int fq) const {
        int row0 = u.pm * BM + wr * 64 + fr, col0 = u.pn * BM + wc * 32 + 8 * fq;
        if (MODE == 2) {
#pragma unroll
            for (int bj = 0; bj < 2; ++bj) { float cs[8];
#pragma unroll
                for (int i = 0; i < 8; ++i) cs[i] = __builtin_amdgcn_rsqf(ssq[2 * (col0 + bj * HALF + i) + which] * inv_n + EPS);
#pragma unroll
                for (int ai = 0; ai < 2; ++ai)
#pragma unroll
                    for (int m = 0; m < 4; ++m) { bf16_t* rowp = O + (size_t)(row0 + ai * HALF + m * 16) * ldc + col0 + bj * HALF; const f32x4 v0 = acc[ai][bj][m][0], v1 = acc[ai][bj][m][1];
                        u32x4 w; w.x = cvt_pk_bf16(v0[0] * cs[0], v0[1] * cs[1]); w.y = cvt_pk_bf16(v0[2] * cs[2], v0[3] * cs[3]); w.z = cvt_pk_bf16(v1[0] * cs[4], v1[1] * cs[5]); w.w = cvt_pk_bf16(v1[2] * cs[6], v1[3] * cs[7]);
                        *(u32x4*)rowp = w; } }
            return;
        }
#pragma unroll
        for (int ai = 0; ai < 2; ++ai)
#pragma unroll
            for (int m = 0; m < 4; ++m) { const int row = row0 + ai * HALF + m * 16; bf16_t* rowp = O + (size_t)row * ldc + col0;
                float rs = 1.f; if (MODE == 1) rs = __builtin_amdgcn_rsqf(ssq[2 * row + which] * inv_n + EPS);
                float sq = 0.f;
#pragma unroll
                for (int bj = 0; bj < 2; ++bj) { f32x4 v0 = acc[ai][bj][m][0], v1 = acc[ai][bj][m][1];
                    if (MODE == 1) { v0 = v0 * rs; v1 = v1 * rs; }
                    if (MODE == 3 && (u.pn == 0 || (u.pn == 1 && bj == 0))) sq += (v0.x * v0.x + v0.y * v0.y) + (v0.z * v0.z + v0.w * v0.w) + (v1.x * v1.x + v1.y * v1.y) + (v1.z * v1.z + v1.w * v1.w);
                    u32x4 w; w.x = cvt_pk_bf16(v0[0], v0[1]); w.y = cvt_pk_bf16(v0[2], v0[3]); w.z = cvt_pk_bf16(v1[0], v1[1]); w.w = cvt_pk_bf16(v1[2], v1[3]);
                    *(u32x4*)(rowp + bj * HALF) = w; }
                if (MODE == 3 && u.pn < 2) { sq += __shfl_xor(sq, 16); sq += __shfl_xor(sq, 32); if (fq == 0) atomicAdd(ssq + 2 * row + u.pn, sq); }
            }
    }
};
struct EpiResid {
    static constexpr bool PERM = false, AFTER_DRAIN = false;
    const float* x; const float* mod; float* out;
    __device__ __forceinline__ void operator()(const f32x4 (&acc)[2][2][4][2], const Unit& u, int wr, int wc, int fr, int fq) const {
        int row0 = u.pm * BM + wr * 64 + fr, col0 = u.pn * BM + wc * 32 + 4 * fq; const int b = (u.pm * BM) / SEQ;
        f32x4 gv[2][2];
#pragma unroll
        for (int bj = 0; bj < 2; ++bj)
#pragma unroll
            for (int n = 0; n < 2; ++n) gv[bj][n] = *(const f32x4*)(mod + (size_t)b * 6144 + 2 * D + col0 + bj * HALF + n * 16);
#pragma unroll
        for (int ai = 0; ai < 2; ++ai)
#pragma unroll
            for (int m = 0; m < 4; ++m) { const size_t off = (size_t)(row0 + ai * HALF + m * 16) * D + col0;
#pragma unroll
                for (int bj = 0; bj < 2; ++bj)
#pragma unroll
                    for (int n = 0; n < 2; ++n) { const f32x4 xv = *(const f32x4*)(x + off + bj * HALF + n * 16); *(f32x4*)(out + off + bj * HALF + n * 16) = xv + gv[bj][n] * acc[ai][bj][m][n]; } }
    }
};
}

#define LAS __attribute__((address_space(3)))
#define LDSW() asm volatile("s_waitcnt lgkmcnt(0)" ::: "memory")
constexpr int ATT_WLDS = (16 * 97 + 16 * 65) * 4;
__device__ __forceinline__ void attn_wave(const Params& P, int idx, int lane, LAS float* wl) {
    LAS float* Ks = wl; LAS float* Vs = wl + 16 * 97;
    const bf16_t* Q = (const bf16_t*)(P.ws + WS_Q); const bf16_t* KN = (const bf16_t*)(P.ws + WS_KN); const bf16_t* KR = (const bf16_t*)(P.ws + WS_KR);
    const bf16_t* VT = (const bf16_t*)(P.ws + WS_VT); bf16_t* Y = (bf16_t*)(P.ws + WS_XN);
    const int qb = 127 - (idx >> 5), bh = idx & 31, b = bh >> 3, h = bh & 7;
    const int qi = qb * 64 + lane; const size_t tq = (size_t)b * SEQ + qi;
    float q[96];
#pragma unroll
    for (int d = 0; d < 64; ++d) q[d] = bf2f(Q[tq * 768 + h * 96 + d]);
    { const float pos = (float)P.positions[tq];
#pragma unroll
      for (int f = 0; f < 16; ++f) { const float x1 = bf2f(Q[tq * 768 + h * 96 + 64 + f]), x2 = bf2f(Q[tq * 768 + h * 96 + 80 + f]); float s, c; sincos_rad(pos * INV64[2 * f], s, c);
          q[64 + f] = x1 * c - x2 * s; q[80 + f] = x1 * s + x2 * c; } }
    float o[64];
#pragma unroll
    for (int d = 0; d < 64; ++d) o[d] = 0.f;
    float m = -INFINITY, l = 0.f;
    const int nkt = (qb * 64 + 64) / 16;
    for (int kt = 0; kt < nkt; ++kt) {
        const int j0 = kt * 16;
        LDSW();
        for (int e = lane; e < 16 * 96; e += 64) { const int j = e / 96, d = e % 96; const size_t tk = (size_t)b * SEQ + j0 + j;
            Ks[j * 97 + d] = d < 64 ? bf2f(KN[tk * 512 + h * 64 + d]) : bf2f(KR[tk * 32 + d - 64]); }
        for (int e = lane; e < 16 * 64; e += 64) { const int d = e / 16, j = e % 16; Vs[j * 65 + d] = bf2f(VT[(size_t)(h * 64 + d) * T + (size_t)b * SEQ + j0 + j]); }
        LDSW();
        for (int j = 0; j < 16; ++j) {
            float s = 0.f;
#pragma unroll
            for (int d = 0; d < 96; ++d) s += q[d] * Ks[j * 97 + d];
            if (j0 + j > qi) s = -INFINITY;
            const float mn = fmaxf(m, s), sc = exp2f(m - mn), p = exp2f(s - mn);
            l = l * sc + p; m = mn;
#pragma unroll
            for (int d = 0; d < 64; ++d) o[d] = o[d] * sc + p * Vs[j * 65 + d];
        }
    }
    const float il = 1.f / l;
#pragma unroll
    for (int d = 0; d < 64; d += 8) { u32x4 w; w.x = pk2(o[d] * il, o[d + 1] * il); w.y = pk2(o[d + 2] * il, o[d + 3] * il); w.z = pk2(o[d + 4] * il, o[d + 5] * il); w.w = pk2(o[d + 6] * il, o[d + 7] * il);
        *(u32x4*)(Y + tq * D + h * 64 + d) = w; }
}
__device__ __forceinline__ void ret_wave(const Params& P, int bh, int lane, LAS float* wl) {
    LAS float* qs = wl; LAS float* ks = wl + 64;
    const bf16_t* proj = (const bf16_t*)(P.ws + WS_PROJ); const bf16_t* projt = (const bf16_t*)(P.ws + WS_PROJT); bf16_t* Y = (bf16_t*)(P.ws + WS_XN);
    const int h = bh & 7, b = bh >> 3, dv = lane;
    const float gamma = 1.0f - exp2f(-5.0f - (float)h);
    float S[64];
#pragma unroll
    for (int i = 0; i < 64; ++i) S[i] = 0.f;
    const float gr = P.g_ret_norm[h * 64 + dv];
    const int f = dv & 31; const float inv = INV64[f];
    for (int t = 0; t < SEQ; ++t) {
        const size_t tt = (size_t)b * SEQ + t;
        const float qa = bf2f(proj[tt * PLD + PC_RQ + h * 64 + f]), qb2 = bf2f(proj[tt * PLD + PC_RQ + h * 64 + 32 + f]);
        const float ka = bf2f(proj[tt * PLD + PC_RK + h * 64 + f]), kb2 = bf2f(proj[tt * PLD + PC_RK + h * 64 + 32 + f]);
        float s, c; sincos_rad((float)P.positions[tt] * inv, s, c);
        const float qv = dv < 32 ? qa * c - qb2 * s : qa * s + qb2 * c;
        const float kv = (dv < 32 ? ka * c - kb2 * s : ka * s + kb2 * c) * 0.125f;
        LDSW();
        qs[dv] = qv; ks[dv] = kv;
        LDSW();
        const float v = bf2f(projt[(size_t)(PT_RV + h * 64 + dv) * T + tt]);
        float y = 0.f;
#pragma unroll
        for (int i = 0; i < 64; ++i) { S[i] = S[i] * gamma + ks[i] * v; y += qs[i] * S[i]; }
        const float mu = wave_sum(y) * (1.f / 64.f); const float dlt = y - mu; const float var = wave_sum(dlt * dlt) * (1.f / 64.f);
        const float yn = dlt * (1.0f / sqrtf(var + EPS)) * gr;
        const float gate = bf2f(proj[tt * PLD + PC_RG + h * 64 + dv]);
        Y[tt * D + 512 + h * 64 + dv] = (bf16_t)f2bf(silu_f(gate) * yn);
    }
}
#define TOPK_INS(LV, LI, val, id) do { float cv_ = (val); int ci_ = (id); _Pragma("unroll") for (int i_ = 0; i_ < 16; ++i_) { const bool c_ = cv_ > LV[i_]; const float tv_ = c_ ? LV[i_] : cv_; const int ti_ = c_ ? LI[i_] : ci_; \
    LV[i_] = c_ ? cv_ : LV[i_]; LI[i_] = c_ ? ci_ : LI[i_]; cv_ = tv_; ci_ = ti_; } } while (0)
__device__ __forceinline__ void route_wave(const Params& P, int item, int lane) {
    const bf16_t* QP = (const bf16_t*)(P.ws + WS_PROJ); const bf16_t* SK = (const bf16_t*)(P.ws + WS_SK);
    int* eidx = (int*)(P.ws + WS_EIDX); float* gate = (float*)(P.ws + WS_GATE);
    const size_t pair = (size_t)item * 64 + lane; const size_t t = pair >> 3; const int h = (int)(pair & 7);
    float tv[2][16]; int ti[2][16];
#pragma unroll
    for (int p = 0; p < 2; ++p) {
#pragma unroll
        for (int i = 0; i < 16; ++i) { tv[p][i] = -INFINITY; ti[p][i] = 0; }
        float q[128];
#pragma unroll
        for (int d = 0; d < 128; d += 8) { const u32x4 w = *(const u32x4*)(QP + t * 2048 + h * 256 + p * 128 + d);
            q[d] = bflo(w.x); q[d + 1] = bfhi(w.x); q[d + 2] = bflo(w.y); q[d + 3] = bfhi(w.y); q[d + 4] = bflo(w.z); q[d + 5] = bfhi(w.z); q[d + 6] = bflo(w.w); q[d + 7] = bfhi(w.w); }
        for (int k = 0; k < 128; ++k) { float s = 0.f; const unsigned* skr = (const unsigned*)(SK + (size_t)(p * 128 + k) * 128);
#pragma unroll
            for (int d = 0; d < 64; ++d) { const unsigned w = skr[d]; s += q[2 * d] * bflo(w); s += q[2 * d + 1] * bfhi(w); }
            TOPK_INS(tv[p], ti[p], s, k); }
    }
    float best[16]; int bidx[16];
#pragma unroll
    for (int i = 0; i < 16; ++i) { best[i] = -INFINITY; bidx[i] = 0; }
#pragma unroll
    for (int i = 0; i < 16; ++i)
#pragma unroll
        for (int j = 0; j < 16; ++j) if ((i + 1) * (j + 1) <= 16) TOPK_INS(best, bidx, tv[0][i] + tv[1][j], ti[0][i] * 128 + ti[1][j]);
    float ssum = 0.f; float e[16];
#pragma unroll
    for (int r = 0; r < 16; ++r) { e[r] = __expf(best[r] - best[0]); ssum += e[r]; }
    const float inv = 1.f / ssum;
#pragma unroll
    for (int r = 0; r < 16; r += 4) { *(u32x4*)(eidx + t * 128 + h * 16 + r) = (u32x4){(unsigned)bidx[r], (unsigned)bidx[r + 1], (unsigned)bidx[r + 2], (unsigned)bidx[r + 3]};
        *(f32x4*)(gate + t * 128 + h * 16 + r) = (f32x4){e[r] * inv, e[r + 1] * inv, e[r + 2] * inv, e[r + 3] * inv}; }
}
__device__ __forceinline__ void gather_wave(const Params& P, size_t t, int lane) {
    const bf16_t* H2 = (const bf16_t*)(P.ws + WS_XN); const bf16_t* EU = (const bf16_t*)(P.ws + WS_EU); const bf16_t* EV = (const bf16_t*)(P.ws + WS_EV);
    const int* eidx = (const int*)(P.ws + WS_EIDX); const float* gate = (const float*)(P.ws + WS_GATE); const float* mod = (const float*)(P.ws + WS_MOD);
    const int b = (int)(t / SEQ);
    float hv[16];
    { const u32x4 a = *(const u32x4*)(H2 + t * D + lane * 16), c = *(const u32x4*)(H2 + t * D + lane * 16 + 8);
      hv[0] = bflo(a.x); hv[1] = bfhi(a.x); hv[2] = bflo(a.y); hv[3] = bfhi(a.y); hv[4] = bflo(a.z); hv[5] = bfhi(a.z); hv[6] = bflo(a.w); hv[7] = bfhi(a.w);
      hv[8] = bflo(c.x); hv[9] = bfhi(c.x); hv[10] = bflo(c.y); hv[11] = bfhi(c.y); hv[12] = bflo(c.z); hv[13] = bfhi(c.z); hv[14] = bflo(c.w); hv[15] = bfhi(c.w); }
    const int my_e0 = eidx[t * 128 + lane], my_e1 = eidx[t * 128 + 64 + lane];
    const float my_g0 = gate[t * 128 + lane], my_g1 = gate[t * 128 + 64 + lane];
    float w0 = 0.f, w1 = 0.f;
#pragma unroll 4
    for (int s = 0; s < 128; ++s) {
        const int e = __builtin_amdgcn_readlane(s < 64 ? my_e0 : my_e1, s & 63);
        const u32x4 a = *(const u32x4*)(EU + (size_t)e * D + lane * 16), c = *(const u32x4*)(EU + (size_t)e * D + lane * 16 + 8);
        float d = hv[0] * bflo(a.x) + hv[1] * bfhi(a.x); d += hv[2] * bflo(a.y) + hv[3] * bfhi(a.y); d += hv[4] * bflo(a.z) + hv[5] * bfhi(a.z); d += hv[6] * bflo(a.w) + hv[7] * bfhi(a.w);
        d += hv[8] * bflo(c.x) + hv[9] * bfhi(c.x); d += hv[10] * bflo(c.y) + hv[11] * bfhi(c.y); d += hv[12] * bflo(c.z) + hv[13] * bfhi(c.z); d += hv[14] * bflo(c.w) + hv[15] * bfhi(c.w);
        d = wave_sum(d);
        if (lane == (s & 63)) { if (s < 64) w0 = d; else w1 = d; }
    }
    w0 = my_g0 * gelu_exact(w0); w1 = my_g1 * gelu_exact(w1);
    float acc[16];
#pragma unroll
    for (int i = 0; i < 16; ++i) acc[i] = 0.f;
#pragma unroll 4
    for (int s = 0; s < 128; ++s) {
        const int e = __builtin_amdgcn_readlane(s < 64 ? my_e0 : my_e1, s & 63);
        const float ww = __builtin_bit_cast(float, __builtin_amdgcn_readlane(__builtin_bit_cast(int, s < 64 ? w0 : w1), s & 63));
        const u32x4 a = *(const u32x4*)(EV + (size_t)e * D + lane * 8), c = *(const u32x4*)(EV + (size_t)e * D + 512 + lane * 8);
        acc[0] += ww * bflo(a.x); acc[1] += ww * bfhi(a.x); acc[2] += ww * bflo(a.y); acc[3] += ww * bfhi(a.y); acc[4] += ww * bflo(a.z); acc[5] += ww * bfhi(a.z); acc[6] += ww * bflo(a.w); acc[7] += ww * bfhi(a.w);
        acc[8] += ww * bflo(c.x); acc[9] += ww * bfhi(c.x); acc[10] += ww * bflo(c.y); acc[11] += ww * bfhi(c.y); acc[12] += ww * bflo(c.z); acc[13] += ww * bfhi(c.z); acc[14] += ww * bflo(c.w); acc[15] += ww * bfhi(c.w);
    }
    float x3[16]; float ss = 0.f;
#pragma unroll
    for (int q = 0; q < 4; ++q) { const int col = (q >> 1) * 512 + lane * 8 + (q & 1) * 4;
        const f32x4 xv = *(const f32x4*)(P.out + t * D + col), gv = *(const f32x4*)(mod + (size_t)b * 6144 + 5 * D + col);
#pragma unroll
        for (int i = 0; i < 4; ++i) { const float v = xv[i] + gv[i] * acc[q * 4 + i]; x3[q * 4 + i] = v; ss += v * v; } }
    const float rstd = 1.0f / sqrtf(wave_sum(ss) * (1.f / D) + EPS);
#pragma unroll
    for (int q = 0; q < 4; ++q) { const int col = (q >> 1) * 512 + lane * 8 + (q & 1) * 4; const f32x4 gf = *(const f32x4*)(P.g_final + col);
        *(f32x4*)(P.out + t * D + col) = (f32x4){x3[q * 4] * rstd * gf.x, x3[q * 4 + 1] * rstd * gf.y, x3[q * 4 + 2] * rstd * gf.z, x3[q * 4 + 3] * rstd * gf.w}; }
}

namespace cg = cooperative_groups;
constexpr int LDS_BYTES = 147456;
struct KArgs { Params P; int ph_lo, ph_hi; };
__global__ void __launch_bounds__(512, 2) mk_fwd(KArgs ka) {
    extern __shared__ __attribute__((aligned(16))) unsigned char lds[];
    const Params& P = ka.P;
    cg::grid_group grid = cg::this_grid();
    PG8_LAS unsigned char* glds = (PG8_LAS unsigned char*)lds;
#define IDS() int tid_ = threadIdx.x; asm volatile("" : "+v"(tid_)); const int lane = tid_ & 63, wave = __builtin_amdgcn_readfirstlane(tid_ >> 6); \
    const int G = gridDim.x, gw = blockIdx.x * 8 + wave, nw = G * 8; const size_t gt = (size_t)blockIdx.x * 512 + tid_, nt = (size_t)G * 512; (void)lane; (void)gw; (void)nw; (void)gt; (void)nt;
#define IN(k) (ka.ph_lo <= (k) && (k) < ka.ph_hi)
#define SYNC(k) do { if (IN(k) && IN((k) + 1)) grid.sync(); } while (0)
#define WSP(T_, off) ((T_*)(P.ws + (off)))
    if (IN(0)) { IDS(); p0_prologue(P, gw, nw, lane, (float*)(lds + wave * 8448)); }
    SYNC(0);
    if (IN(1)) { IDS(); mod_final(P, gt, nt); rownorm_pass<true>(P, P.x, P.g_norm1, 0, 1, WSP(bf16_t, WS_XN), gw, nw, lane); }
    SYNC(1);
    if (IN(2)) {
        { pg8::Gemm g{WSP(const bf16_t, WS_XN), WSP(const bf16_t, WS_W1T), T, 2048, D, D, D}; pg8::StaticOrder S; S.init(T, 2048, gridDim.x, (int)blockIdx.x);
          epi::EpiStore<3> E{WSP(bf16_t, WS_PROJ), PLD, WSP(float, WS_SSQ), 0, 0.f}; pg8::gemm_phase<epi::EpiStore<3>, pg8::StaticOrder, true, true>(glds, g, S, E); }
        { pg8::Gemm g{WSP(const bf16_t, WS_W1TT), WSP(const bf16_t, WS_XN), 1024, T, D, D, D}; pg8::StaticOrder S; S.init(1024, T, gridDim.x, (int)blockIdx.x);
          epi::EpiStore<0> E{WSP(bf16_t, WS_PROJT), T, nullptr, 0, 0.f}; pg8::gemm_phase<epi::EpiStore<0>, pg8::StaticOrder, true, true>(glds, g, S, E); }
    }
    SYNC(2);
    if (IN(3)) {
        { pg8::Gemm g{WSP(const bf16_t, WS_PROJ) + PC_QL, WSP(const bf16_t, WS_WUQ), T, 768, 256, PLD, 256}; pg8::StaticOrder S; S.init(T, 768, gridDim.x, (int)blockIdx.x);
          epi::EpiStore<1> E{WSP(bf16_t, WS_Q), 768, WSP(float, WS_SSQ), 0, 1.f / 256.f}; pg8::gemm_phase<epi::EpiStore<1>, pg8::StaticOrder, true, true>(glds, g, S, E); }
        { pg8::Gemm g{WSP(const bf16_t, WS_PROJ) + PC_KVL, WSP(const bf16_t, WS_WK), T, 512, 256, PLD, 256}; pg8::StaticOrder S; S.init(T, 512, gridDim.x, (int)blockIdx.x);
          epi::EpiStore<1> E{WSP(bf16_t, WS_KN), 512, WSP(float, WS_SSQ), 1, 1.f / 128.f}; pg8::gemm_phase<epi::EpiStore<1>, pg8::StaticOrder, true, true>(glds, g, S, E); }
        { pg8::Gemm g{WSP(const bf16_t, WS_WV), WSP(const bf16_t, WS_PROJ) + PC_KVL, 512, T, 256, 256, PLD}; pg8::StaticOrder S; S.init(512, T, gridDim.x, (int)blockIdx.x);
          epi::EpiStore<2> E{WSP(bf16_t, WS_VT), T, WSP(float, WS_SSQ), 1, 1.f / 128.f}; pg8::gemm_phase<epi::EpiStore<2>, pg8::StaticOrder, true, true>(glds, g, S, E); }
        { IDS(); kr_pass(P, gt, nt); }
    }
    SYNC(3);
    if (IN(4)) { IDS();
        if (gw < 32) ret_wave(P, gw, lane, (LAS float*)(glds + 131072 + wave * 512));
        for (int i = gw; i < 2048; i += nw) { attn_wave(P, i, lane, (LAS float*)(glds + wave * ATT_WLDS)); attn_wave(P, 4095 - i, lane, (LAS float*)(glds + wave * ATT_WLDS)); }
    }
    SYNC(4);
    if (IN(6)) { pg8::Gemm g{WSP(const bf16_t, WS_XN), WSP(const bf16_t, WS_WOUT), T, D, D, D, D}; pg8::StaticOrder S; S.init(T, D, gridDim.x, (int)blockIdx.x);
        epi::EpiResid E{P.x, WSP(const float, WS_MOD), P.out}; pg8::gemm_phase<epi::EpiResid, pg8::StaticOrder, true, true>(glds, g, S, E); }
    SYNC(6);
    if (IN(7)) { IDS(); rownorm_pass<false>(P, P.out, P.g_norm2, 3, 4, WSP(bf16_t, WS_XN), gw, nw, lane); }
    SYNC(7);
    if (IN(8)) { pg8::Gemm g{WSP(const bf16_t, WS_XN), WSP(const bf16_t, WS_WQ), T, 2048, D, D, D}; pg8::StaticOrder S; S.init(T, 2048, gridDim.x, (int)blockIdx.x);
        epi::EpiStore<0> E{WSP(bf16_t, WS_PROJ), 2048, nullptr, 0, 0.f}; pg8::gemm_phase<epi::EpiStore<0>, pg8::StaticOrder, true, true>(glds, g, S, E); }
    SYNC(8);
    if (IN(9)) { IDS(); for (int i = gw; i < T * 8 / 64; i += nw) route_wave(P, i, lane); }
    SYNC(9);
    if (IN(10)) { IDS(); for (size_t t = gw; t < (size_t)T; t += nw) gather_wave(P, t, lane); }
#undef IN
#undef SYNC
#undef IDS
#undef WSP
}

extern "C" void kernel_launch(void* const* d_in, const int* in_sizes, int n_in, void* d_out, int out_size, void* d_ws, size_t ws_size, hipStream_t stream) {
    if (n_in != 19 || out_size != T * D || ws_size < WS_END) { fprintf(stderr, "kernel_launch: unexpected shapes (n_in %d out %d ws %zu)\n", n_in, out_size, ws_size); return; }
    static int grid = 0;
    if (grid == 0) {
        int dev = 0, cus = 0, per_cu = 0;
        if (hipGetDevice(&dev) != hipSuccess || hipDeviceGetAttribute(&cus, hipDeviceAttributeMultiprocessorCount, dev) != hipSuccess) { fprintf(stderr, "kernel_launch: device query failed\n"); grid = -1; return; }
        if (hipFuncSetAttribute((const void*)mk_fwd, hipFuncAttributeMaxDynamicSharedMemorySize, LDS_BYTES) != hipSuccess) { fprintf(stderr, "kernel_launch: hipFuncSetAttribute failed\n"); grid = -1; return; }
        if (hipOccupancyMaxActiveBlocksPerMultiprocessor(&per_cu, (const void*)mk_fwd, 512, LDS_BYTES) != hipSuccess || per_cu < 1) { fprintf(stderr, "kernel_launch: occupancy query failed (%d)\n", per_cu); (void)hipGetLastError(); per_cu = 1; }
        grid = cus * (per_cu > 1 ? 1 : per_cu);
    }
    if (grid < 0) return;
    KArgs ka{};
    Params& P = ka.P;
    P.x = (const float*)d_in[0]; P.c = (const float*)d_in[1]; P.positions = (const int*)d_in[2]; P.w_ada = (const float*)d_in[3]; P.b_ada = (const float*)d_in[4];
    P.g_norm1 = (const float*)d_in[5]; P.w_in = (const float*)d_in[6]; P.g_q_norm = (const float*)d_in[7]; P.w_uq = (const float*)d_in[8]; P.g_kv_norm = (const float*)d_in[9];
    P.w_ukv = (const float*)d_in[10]; P.g_ret_norm = (const float*)d_in[11]; P.w_out = (const float*)d_in[12]; P.g_norm2 = (const float*)d_in[13]; P.w_query = (const float*)d_in[14];
    P.sub_keys = (const float*)d_in[15]; P.expert_u = (const float*)d_in[16]; P.expert_v = (const float*)d_in[17]; P.g_final = (const float*)d_in[18];
    P.out = (float*)d_out; P.ws = (unsigned char*)d_ws;
    ka.ph_lo = 0; ka.ph_hi = 11;
    void* args[] = {&ka};
    const hipError_t e = hipLaunchCooperativeKernel((const void*)mk_fwd, dim3(grid), dim3(512), args, LDS_BYTES, stream);
    if (e != hipSuccess) fprintf(stderr, "kernel_launch: cooperative launch failed: %s (grid %d)\n", hipGetErrorString(e), grid);
}
```

```cpp
#include <hip/hip_runtime.h>
#include <hip/hip_cooperative_groups.h>
#include <cstdint>
#include <cstdio>

typedef unsigned short bf16_t;
typedef float f32x4 __attribute__((ext_vector_type(4)));
typedef unsigned u32x4 __attribute__((ext_vector_type(4)));
typedef unsigned u32x2 __attribute__((ext_vector_type(2)));

constexpr int NB = 4, SEQ = 8192, T = NB * SEQ, D = 1024;
constexpr int IN_COLS = 2464;
constexpr int NH = 8;
constexpr int QK = 96, NOPE = 64, ROPE = 32, DV = 64;
constexpr int QR = 256, KVR = 128;
constexpr int NEXP = 16384, PK = 16, NKEYS = 128;
constexpr float EPS = 1e-6f;
constexpr float LOG2E = 1.4426950408889634f;
constexpr float QSCALE = 0.10206207261596575f * LOG2E;

constexpr size_t MiB = 1u << 20;
constexpr size_t WS_CTL = 0;
constexpr size_t WS_MODP = 1 * MiB;
constexpr size_t WS_MOD = 3 * MiB - 128 * 1024;
constexpr size_t WS_SSQ = 3 * MiB;
constexpr size_t WS_W1T = 4 * MiB;
constexpr size_t WS_W1TT = 8 * MiB;
constexpr size_t WS_WUQ = 10 * MiB;
constexpr size_t WS_WK = 10 * MiB + 512 * 1024;
constexpr size_t WS_WV = 10 * MiB + 768 * 1024;
constexpr size_t WS_WOUT = 11 * MiB;
constexpr size_t WS_WQ = 13 * MiB;
constexpr size_t WS_SK = 17 * MiB;
constexpr size_t WS_EU = 18 * MiB;
constexpr size_t WS_EV = 50 * MiB;
constexpr size_t WS_XN = 82 * MiB;
constexpr size_t WS_PROJ = 146 * MiB;
constexpr size_t WS_PROJT = 274 * MiB;
constexpr size_t WS_Q = 338 * MiB;
constexpr size_t WS_KN = 386 * MiB;
constexpr size_t WS_KR = 418 * MiB;
constexpr size_t WS_VT = 420 * MiB;
constexpr size_t WS_KVC = 452 * MiB;
constexpr size_t WS_END = 484 * MiB;
constexpr size_t WS_EIDX = WS_PROJT;
constexpr size_t WS_GATE = WS_PROJT + 16 * MiB;

constexpr int PC_QL = 0, PC_KVL = 256, PC_KR = 384, PC_RQ = 512, PC_RK = 1024, PC_RG = 1536, PLD = 2048;
constexpr int PT_RK = 0, PT_RV = 512;

__constant__ float INV64[32] = {1.0f, 0.749894261f, 0.562341332f, 0.421696514f, 0.316227764f, 0.237137377f, 0.177827939f, 0.133352131f, 0.100000001f, 0.0749894157f, 0.0562341325f, 0.0421696529f, 0.0316227749f, 0.0237137377f, 0.0177827943f, 0.0133352149f, 0.00999999978f, 0.00749894185f, 0.00562341325f, 0.00421696482f, 0.00316227763f, 0.00237137359f, 0.00177827943f, 0.00133352145f, 0.00100000005f, 0.000749894243f, 0.000562341302f, 0.000421696517f, 0.000316227757f, 0.00023713737f, 0.00017782794f, 0.00013335215f};

struct Params {
    const float *x, *c; const int* positions; const float *w_ada, *b_ada, *g_norm1, *w_in, *g_q_norm, *w_uq, *g_kv_norm, *w_ukv, *g_ret_norm, *w_out, *g_norm2, *w_query, *sub_keys, *expert_u, *expert_v, *g_final;
    float* out; unsigned char* ws;
};

__device__ __forceinline__ unsigned f2bf(float f) { unsigned u = __builtin_bit_cast(unsigned, f); return (u + 0x7fffu + ((u >> 16) & 1u)) >> 16; }
__device__ __forceinline__ unsigned pk2(float lo, float hi) { return f2bf(lo) | (f2bf(hi) << 16); }
__device__ __forceinline__ float bf2f(unsigned short b) { return __builtin_bit_cast(float, (unsigned)b << 16); }
__device__ __forceinline__ float bflo(unsigned w) { return __builtin_bit_cast(float, w << 16); }
__device__ __forceinline__ float bfhi(unsigned w) { return __builtin_bit_cast(float, w & 0xffff0000u); }
__device__ __forceinline__ float wave_sum(float v) {
#pragma unroll
    for (int o = 1; o < 64; o <<= 1) v += __shfl_xor(v, o);
    return v;
}
__device__ __forceinline__ float silu_f(float v) { return v / (1.f + __expf(-v)); }
__device__ __forceinline__ void sincos_rad(float ang, float& s, float& c) {
    const float CH = 0.15915494f, CL = 3.0918913e-09f;
    const float rh = ang * CH, rl = __builtin_fmaf(ang, CH, -rh) + ang * CL;
    const float fr = (rh - __builtin_floorf(rh)) + rl;
    s = __builtin_amdgcn_sinf(fr); c = __builtin_amdgcn_cosf(fr);
}
__device__ __forceinline__ float gelu_exact(float v) { return 0.5f * v * (1.f + erff(v * 0.70710678118654752f)); }

__device__ __forceinline__ void p0_mod_item(const Params& P, int item, int lane) {
    const int kc = item / 24, nc = item % 24, n = nc * 256 + lane * 4;
    f32x4 acc[4] = {};
    for (int kk = 0; kk < 64; ++kk) {
        const int k = kc * 64 + kk;
        const f32x4 w = *(const f32x4*)(P.w_ada + (size_t)k * 6144 + n);
#pragma unroll
        for (int b = 0; b < 4; ++b) { const float s = silu_f(P.c[b * D + k]); acc[b] += w * s; }
    }
    float* modp = (float*)(P.ws + WS_MODP);
#pragma unroll
    for (int b = 0; b < 4; ++b) *(f32x4*)(modp + (size_t)(kc * 4 + b) * 6144 + n) = acc[b];
}
__device__ __forceinline__ void p0_transpose_block(const float* W, int ldw, int k0, int n0, bf16_t* dst, int row0, int ldd, const float* kscale, float scale, float* scr, int lane) {
#pragma unroll 8
    for (int i = 0; i < 32; ++i) { const int kk = 2 * i + (lane >> 5); const float ks = kscale ? kscale[k0 + kk] * scale : scale;
        scr[kk * 33 + (lane & 31)] = W[(size_t)(k0 + kk) * ldw + n0 + (lane & 31)] * ks; }
    asm volatile("s_waitcnt vmcnt(0) lgkmcnt(0)" ::: "memory");
    const int c = lane & 7;
#pragma unroll
    for (int j = 0; j < 4; ++j) { const int n = (lane >> 3) + 8 * j; const float* s = scr + (8 * c) * 33 + n;
        u32x4 o; o.x = pk2(s[0 * 33], s[1 * 33]); o.y = pk2(s[2 * 33], s[3 * 33]); o.z = pk2(s[4 * 33], s[5 * 33]); o.w = pk2(s[6 * 33], s[7 * 33]);
        *(u32x4*)(dst + (size_t)(row0 + n) * ldd + k0 + 8 * c) = o; }
    asm volatile("s_waitcnt vmcnt(0) lgkmcnt(0)" ::: "memory");
}
__device__ __forceinline__ void cvt8(const float* src, bf16_t* dst, size_t n8, size_t gt, size_t nt) {
    for (size_t i = gt; i < n8; i += nt) { const f32x4 a = *(const f32x4*)(src + i * 8), b = *(const f32x4*)(src + i * 8 + 4);
        u32x4 o; o.x = pk2(a.x, a.y); o.y = pk2(a.z, a.w); o.z = pk2(b.x, b.y); o.w = pk2(b.z, b.w); *(u32x4*)(dst + i * 8) = o; }
}
constexpr int IT_MOD = 384, IT_WIN = 16 * 77, IT_WUQ = 4 * 24, IT_WUKV = 2 * 32, IT_WOUT = 16 * 32, IT_WQ = 16 * 64;
constexpr int IT_TOTAL = IT_MOD + IT_WIN + IT_WUQ + IT_WUKV + IT_WOUT + IT_WQ;
__device__ __forceinline__ void p0_prologue(const Params& P, int gw, int nw, int lane, float* scr) {
    unsigned char* ws = P.ws;
    for (int it = gw; it < IT_TOTAL; it += nw) {
        int r = it;
        if (r < IT_MOD) { p0_mod_item(P, r, lane); continue; } r -= IT_MOD;
        if (r < IT_WIN) { const int kb = r / 77, nb = r % 77, n0 = nb * 32, k0 = kb * 64;
            bf16_t* w1t = (bf16_t*)(ws + WS_W1T); bf16_t* w1tt = (bf16_t*)(ws + WS_W1TT);
            if (n0 < 416) p0_transpose_block(P.w_in, IN_COLS, k0, n0, w1t, n0, D, nullptr, 1.f, scr, lane);
            else if (n0 < 928) p0_transpose_block(P.w_in, IN_COLS, k0, n0, w1t, PC_RQ + (n0 - 416), D, nullptr, 1.f, scr, lane);
            else if (n0 < 1440) { p0_transpose_block(P.w_in, IN_COLS, k0, n0, w1t, PC_RK + (n0 - 928), D, nullptr, 1.f, scr, lane);
                                  p0_transpose_block(P.w_in, IN_COLS, k0, n0, w1tt, PT_RK + (n0 - 928), D, nullptr, 1.f, scr, lane); }
            else if (n0 < 1952) p0_transpose_block(P.w_in, IN_COLS, k0, n0, w1tt, PT_RV + (n0 - 1440), D, nullptr, 1.f, scr, lane);
            else p0_transpose_block(P.w_in, IN_COLS, k0, n0, w1t, PC_RG + (n0 - 1952), D, nullptr, 1.f, scr, lane);
            continue; } r -= IT_WIN;
        if (r < IT_WUQ) { const int kb = r / 24, nb = r % 24; p0_transpose_block(P.w_uq, 768, kb * 64, nb * 32, (bf16_t*)(ws + WS_WUQ), nb * 32, 256, P.g_q_norm, QSCALE, scr, lane); continue; } r -= IT_WUQ;
        if (r < IT_WUKV) { const int kb = r / 32, nb = r % 32, n0 = nb * 32, h = n0 >> 7, rr = n0 & 127;
            if (rr < 64) p0_transpose_block(P.w_ukv, 1024, kb * 64, n0, (bf16_t*)(ws + WS_WK), h * 64 + rr, 256, P.g_kv_norm, 1.f, scr, lane);
            else p0_transpose_block(P.w_ukv, 1024, kb * 64, n0, (bf16_t*)(ws + WS_WV), h * 64 + rr - 64, 256, P.g_kv_norm, 1.f, scr, lane);
            continue; } r -= IT_WUKV;
        if (r < IT_WOUT) { const int kb = r / 32, nb = r % 32; p0_transpose_block(P.w_out, 1024, kb * 64, nb * 32, (bf16_t*)(ws + WS_WOUT), nb * 32, 1024, nullptr, 1.f, scr, lane); continue; } r -= IT_WOUT;
        { const int kb = r / 64, nb = r % 64; p0_transpose_block(P.w_query, 2048, kb * 64, nb * 32, (bf16_t*)(ws + WS_WQ), nb * 32, 1024, nullptr, 1.f, scr, lane); }
    }
    const size_t gt = (size_t)gw * 64 + lane, nt = (size_t)nw * 64;
    { u32x4 z = {0u, 0u, 0u, 0u};
      for (size_t i = gt; i < 96 * 1024 / 8; i += nt) *(u32x4*)((bf16_t*)(ws + WS_W1T) + (size_t)416 * 1024 + i * 8) = z;
      for (size_t i = gt; i < 2 * 512 * 16; i += nt) { const size_t m = i / (512 * 16), rr = (i / 16) % 512, cc = i % 16; *(u32x4*)((bf16_t*)(ws + (m ? WS_WV : WS_WK)) + rr * 256 + 128 + cc * 8) = z; }
      for (size_t i = gt; i < (size_t)T * 2 / 4; i += nt) *(u32x4*)((float*)(ws + WS_SSQ) + i * 4) = z; }
    cvt8(P.sub_keys, (bf16_t*)(ws + WS_SK), 2 * 128 * 128 / 8, gt, nt);
    cvt8(P.expert_u, (bf16_t*)(ws + WS_EU), (size_t)NEXP * D / 8, gt, nt);
    cvt8(P.expert_v, (bf16_t*)(ws + WS_EV), (size_t)NEXP * D / 8, gt, nt);
}

template <bool FROM_PART> __device__ __forceinline__ void rownorm_pass(const Params& P, const float* src, const float* g, int seg_sh, int seg_sc, bf16_t* dst, int gw, int nw, int lane) {
    const float* modp = (const float*)(P.ws + WS_MODP); const float* mod = (const float*)(P.ws + WS_MOD);
    for (int r0 = gw * 16; r0 < T; r0 += nw * 16) {
        const int b = r0 / SEQ;
        f32x4 mul[4], add[4];
#pragma unroll
        for (int j = 0; j < 4; ++j) {
            const int col = lane * 4 + 256 * j;
            f32x4 sc, sh;
            if (FROM_PART) {
                sc = *(const f32x4*)(P.b_ada + seg_sc * D + col); sh = *(const f32x4*)(P.b_ada + seg_sh * D + col);
                for (int kc = 0; kc < 16; ++kc) { sc += *(const f32x4*)(modp + (size_t)(kc * 4 + b) * 6144 + seg_sc * D + col); sh += *(const f32x4*)(modp + (size_t)(kc * 4 + b) * 6144 + seg_sh * D + col); }
            } else { sc = *(const f32x4*)(mod + (size_t)b * 6144 + seg_sc * D + col); sh = *(const f32x4*)(mod + (size_t)b * 6144 + seg_sh * D + col); }
            const f32x4 gg = *(const f32x4*)(g + col);
            mul[j] = gg * (sc + 1.0f); add[j] = sh;
        }
        for (int rr = 0; rr < 16; ++rr) {
            const int row = r0 + rr;
            const f32x4* xr = (const f32x4*)(src + (size_t)row * D) + lane;
            f32x4 v[4]; float s = 0.f;
#pragma unroll
            for (int j = 0; j < 4; ++j) { v[j] = xr[64 * j]; s += (v[j].x * v[j].x + v[j].y * v[j].y) + (v[j].z * v[j].z + v[j].w * v[j].w); }
            const float rstd = 1.0f / sqrtf(wave_sum(s) * (1.f / D) + EPS);
            u32x2* o = (u32x2*)(dst + (size_t)row * D) + lane;
#pragma unroll
            for (int j = 0; j < 4; ++j) { const f32x4 y = v[j] * rstd * mul[j] + add[j]; u32x2 w; w.x = pk2(y.x, y.y); w.y = pk2(y.z, y.w); o[64 * j] = w; }
        }
    }
}
__device__ __forceinline__ void mod_final(const Params& P, size_t gt, size_t nt) {
    const float* modp = (const float*)(P.ws + WS_MODP); float* mod = (float*)(P.ws + WS_MOD);
    for (size_t i = gt; i < 4 * 6144; i += nt) { float s = P.b_ada[i % 6144]; for (int kc = 0; kc < 16; ++kc) s += modp[(size_t)kc * 4 * 6144 + i]; mod[i] = s; }
}

__device__ __forceinline__ void kr_pass(const Params& P, size_t gt, size_t nt) {
    const bf16_t* proj = (const bf16_t*)(P.ws + WS_PROJ); bf16_t* kr = (bf16_t*)(P.ws + WS_KR);
    for (size_t i = gt; i < (size_t)T * 16; i += nt) {
        const int t = (int)(i >> 4), f = (int)(i & 15);
        const float x1 = bf2f(proj[(size_t)t * PLD + PC_KR + f]), x2 = bf2f(proj[(size_t)t * PLD + PC_KR + 16 + f]);
        float s, c; sincos_rad((float)P.positions[t] * INV64[2 * f], s, c);
        kr[(size_t)t * 32 + f] = (bf16_t)f2bf(x1 * c - x2 * s); kr[(size_t)t * 32 + 16 + f] = (bf16_t)f2bf(x1 * s + x2 * c);
    }
}

namespace pg8 {
#define PG8_LAS __attribute__((address_space(3)))
typedef unsigned short bf16_t;
typedef short bf16x8 __attribute__((ext_vector_type(8)));
typedef float f32x4 __attribute__((ext_vector_type(4)));
typedef unsigned u32x4 __attribute__((ext_vector_type(4)));
constexpr int BM = 256, BK = 64, HALF = 128, HTB = HALF * BK * 2  , STAGE_BYTES = 8 * HTB, NXCD = 8, WGM = 8;

__host__ __device__ __forceinline__ int lds_byte(int r, int c) { const int st = (r >> 4) * 2 + (c >> 5), rr = r & 15, cc = c & 31, ob = rr * 64 + cc * 2; return st * 1024 + (ob ^ (((ob >> 9) & 1) << 5)); }
__host__ __device__ __forceinline__ void stage_rc(int b, int& R, int& C) { const int st = b / 1024, sb = b % 1024, swz = sb ^ (((sb >> 9) & 1) << 5); R = (st >> 1) * 16 + swz / 64; C = (st & 1) * 32 + (swz % 64) / 2; }
__host__ __device__ __forceinline__ int perm32(int rho) { const int n = rho >> 4, i = rho & 15; return 8 * (i >> 2) + 4 * n + (i & 3); }

struct Unit { int pm, pn; };
struct Gemm { const bf16_t* A; const bf16_t* Bt; int M, N, K, lda, ldb; };

struct StaticOrder {
    int nM, nN, nwg, G, c;
    __host__ __device__ void init(int M, int N, int G_, int c_) { nM = M / BM; nN = N / BM; nwg = nM * nN; G = G_; c = c_; }
    __host__ __device__ bool next(int i, Unit& u) const {
        const long L = (long)i * G + c; if (L >= nwg) return false;
        int wgid = (int)L; { const int q = nwg / NXCD, r = nwg % NXCD, xcd = wgid % NXCD, off = wgid / NXCD; wgid = (xcd < r ? xcd * (q + 1) : r * (q + 1) + (xcd - r) * q) + off; }
        const int nig = WGM * nN, gid = wgid / nig, fm = gid * WGM, gsz = (nM - fm) < WGM ? (nM - fm) : WGM;
        u.pm = fm + ((wgid % nig) % gsz); u.pn = (wgid % nig) / gsz; return true;
    }
    __device__ __forceinline__ void a_ready(const Unit&) const {}
    __device__ __forceinline__ void done(const Unit&) const {}
};


template <class Epi, class Sched, bool ALIGN_EPI = false, bool SP2 = false>
__device__ __forceinline__ void gemm_phase(PG8_LAS unsigned char* lds, const Gemm g, const Sched& S, const Epi& E) {
    int tid = threadIdx.x; asm volatile("" : "+v"(tid));
    const int wid = __builtin_amdgcn_readfirstlane(tid >> 6), lane = tid & 63, wr = wid >> 2, wc = wid & 3, fr = lane & 15, fq = lane >> 4;
    const int K = g.K, nt = K / BK;
    unsigned voffA[2], voffB[2];
#pragma unroll
    for (int i = 0; i < 2; ++i) { int R, C; stage_rc(tid * 16 + i * 8192, R, C); const int Rb = Epi::PERM ? ((R & ~31) + perm32(R & 31)) : R;
        voffA[i] = (unsigned)(R * g.lda + C) * 2u; voffB[i] = (unsigned)(Rb * g.ldb + C) * 2u; }
    const size_t kstep = (size_t)(BK * 2);
    const size_t hstepA = (size_t)HALF * g.lda * 2, hstepB = (size_t)HALF * g.ldb * 2;
    const size_t tstepA = 2 * hstepA, tstepB = 2 * hstepB;
    const unsigned ldsw = (unsigned)wid * 1024u;
    const int aoff = lds_byte(wr * 64 + fr, fq * 8), boff = lds_byte(wc * 32 + fr, fq * 8);
#define PG8_SA(b, h) (((b) * 2 + (h)) * HTB)
#define PG8_SB(b, h) ((4 + (b) * 2 + (h)) * HTB)
#define PG8_STAGE(bufoff, gbase, voff) do { _Pragma("unroll") for (int _i = 0; _i < 2; ++_i) \
        __builtin_amdgcn_global_load_lds((const unsigned*)((const char*)(gbase) + (voff)[_i]), (PG8_LAS unsigned*)(lds + (bufoff) + ldsw + _i * 8192), 16, 0, 0); } while (0)
#define PG8_LDA(dst, b, h) do { _Pragma("unroll") for (int m = 0; m < 4; ++m) _Pragma("unroll") for (int k = 0; k < 2; ++k) dst[m][k] = *(const PG8_LAS bf16x8*)(lds + PG8_SA(b, h) + aoff + m * 2048 + k * 1024); } while (0)
#define PG8_LDB(dst, b, h) do { _Pragma("unroll") for (int n = 0; n < 2; ++n) _Pragma("unroll") for (int k = 0; k < 2; ++k) dst[n][k] = *(const PG8_LAS bf16x8*)(lds + PG8_SB(b, h) + boff + n * 2048 + k * 1024); } while (0)
#define PG8_MMA(ai, bj, At, Bt) do { __builtin_amdgcn_s_setprio(1); _Pragma("unroll") for (int m = 0; m < 4; ++m) _Pragma("unroll") for (int n = 0; n < 2; ++n) _Pragma("unroll") for (int k = 0; k < 2; ++k) \
        acc[ai][bj][m][n] = __builtin_amdgcn_mfma_f32_16x16x32_bf16(Bt[n][k], At[m][k], acc[ai][bj][m][n], 0, 0, 0); __builtin_amdgcn_s_setprio(0); } while (0)
#define PG8_WAIT_V(n) asm volatile("s_waitcnt vmcnt(" #n ")" ::: "memory")
#define PG8_WAIT_L(n) asm volatile("s_waitcnt lgkmcnt(" #n ")" ::: "memory")
#define PG8_BAR __builtin_amdgcn_s_barrier()
#define PG8_SCHED __builtin_amdgcn_sched_barrier(0)
    Unit cur, nxt; int ui = 0;
    if (!S.next(0, cur)) return;
    f32x4 acc[2][2][4][2];
#pragma unroll
    for (int a = 0; a < 2; ++a)
#pragma unroll
        for (int b = 0; b < 2; ++b)
#pragma unroll
            for (int m = 0; m < 4; ++m)
#pragma unroll
                for (int n = 0; n < 2; ++n) acc[a][b][m][n] = (f32x4){0.f, 0.f, 0.f, 0.f};
    bf16x8 At[4][2], B0[2][2], B1[2][2];
    const char* cA = (const char*)g.A + (size_t)cur.pm * tstepA; const char* cB = (const char*)g.Bt + (size_t)cur.pn * tstepB;
    S.a_ready(cur);
    if constexpr (SP2) {
        PG8_STAGE(PG8_SB(0, 0), cB, voffB); PG8_STAGE(PG8_SB(0, 1), cB + hstepB, voffB); PG8_STAGE(PG8_SA(0, 0), cA, voffA); PG8_STAGE(PG8_SA(0, 1), cA + hstepA, voffA);
        if (wr == 1) PG8_BAR;
        PG8_WAIT_V(2); PG8_BAR;
        PG8_STAGE(PG8_SB(1, 0), cB + kstep, voffB); PG8_STAGE(PG8_SA(1, 0), cA + kstep, voffA); PG8_STAGE(PG8_SB(1, 1), cB + hstepB + kstep, voffB);
        PG8_WAIT_V(6); PG8_BAR;
    } else {
        PG8_STAGE(PG8_SB(0, 0), cB, voffB); PG8_STAGE(PG8_SA(0, 0), cA, voffA); PG8_STAGE(PG8_SB(0, 1), cB + hstepB, voffB); PG8_STAGE(PG8_SA(0, 1), cA + hstepA, voffA);
        if (wr == 1) PG8_BAR;
        PG8_WAIT_V(4); PG8_BAR;
        PG8_STAGE(PG8_SB(1, 0), cB + kstep, voffB); PG8_STAGE(PG8_SA(1, 0), cA + kstep, voffA); PG8_STAGE(PG8_SB(1, 1), cB + hstepB + kstep, voffB);
        PG8_WAIT_V(6); PG8_BAR;
    }
    for (;;) {
        const bool has_next = S.next(ui + 1, nxt);
        const char* nA = has_next ? (const char*)g.A + (size_t)nxt.pm * tstepA : cA; const char* nB = has_next ? (const char*)g.Bt + (size_t)nxt.pn * tstepB : cB;
        for (int t = 0; t < nt; t += 2) {
            const bool last = (t == nt - 2);
            const char* a1 = cA + (size_t)(t + 1) * kstep;
            const char* a2 = last ? nA : cA + (size_t)(t + 2) * kstep; const char* b2 = last ? nB : cB + (size_t)(t + 2) * kstep;
            const char* a3 = a2 + kstep; const char* b3 = b2 + kstep;
            if (last && has_next) S.a_ready(nxt);
            if constexpr (SP2) {
            PG8_LDB(B0, 0, 0); PG8_LDB(B1, 0, 1); PG8_SCHED; PG8_LDA(At, 0, 0); PG8_STAGE(PG8_SA(1, 1), a1 + hstepA, voffA);
            PG8_WAIT_V(8); PG8_WAIT_L(0); PG8_BAR; PG8_MMA(0, 0, At, B0); PG8_MMA(0, 1, At, B1); PG8_BAR; PG8_SCHED;
            PG8_LDA(At, 0, 1); PG8_STAGE(PG8_SB(0, 0), b2, voffB); PG8_STAGE(PG8_SB(0, 1), b2 + hstepB, voffB); PG8_STAGE(PG8_SA(0, 0), a2, voffA);
            PG8_WAIT_V(8); PG8_WAIT_L(0); PG8_BAR; PG8_MMA(1, 0, At, B0); PG8_MMA(1, 1, At, B1); PG8_BAR; PG8_SCHED;
            PG8_LDB(B0, 1, 0); PG8_LDB(B1, 1, 1); PG8_SCHED; PG8_LDA(At, 1, 0); PG8_STAGE(PG8_SA(0, 1), a2 + hstepA, voffA);
            PG8_WAIT_V(8); PG8_WAIT_L(0); PG8_BAR; PG8_MMA(0, 0, At, B0); PG8_MMA(0, 1, At, B1); PG8_BAR; PG8_SCHED;
            PG8_LDA(At, 1, 1); PG8_STAGE(PG8_SB(1, 0), b3, voffB); PG8_STAGE(PG8_SB(1, 1), b3 + hstepB, voffB); PG8_STAGE(PG8_SA(1, 0), a3, voffA);
            PG8_WAIT_V(8); PG8_WAIT_L(0); PG8_BAR; PG8_MMA(1, 0, At, B0); PG8_MMA(1, 1, At, B1); PG8_BAR; PG8_SCHED;
            } else {
            PG8_LDB(B0, 0, 0); PG8_SCHED; PG8_LDA(At, 0, 0); PG8_STAGE(PG8_SA(1, 1), a1 + hstepA, voffA);
            PG8_WAIT_L(8); PG8_BAR; PG8_WAIT_L(0); PG8_MMA(0, 0, At, B0); PG8_BAR; PG8_SCHED;
            PG8_LDB(B1, 0, 1); PG8_STAGE(PG8_SB(0, 0), b2, voffB);
            PG8_BAR; PG8_WAIT_L(0); PG8_MMA(0, 1, At, B1); PG8_BAR;
            PG8_LDA(At, 0, 1); PG8_STAGE(PG8_SA(0, 0), a2, voffA);
            PG8_BAR; PG8_WAIT_L(0); PG8_MMA(1, 0, At, B0); PG8_BAR; PG8_SCHED;
            PG8_STAGE(PG8_SB(0, 1), b2 + hstepB, voffB);
            PG8_WAIT_V(6); PG8_BAR; PG8_MMA(1, 1, At, B1); PG8_BAR;
            PG8_LDB(B0, 1, 0); PG8_SCHED; PG8_LDA(At, 1, 0); PG8_STAGE(PG8_SA(0, 1), a2 + hstepA, voffA);
            PG8_WAIT_L(8); PG8_BAR; PG8_WAIT_L(0); PG8_MMA(0, 0, At, B0); PG8_BAR; PG8_SCHED;
            PG8_LDB(B1, 1, 1); PG8_STAGE(PG8_SB(1, 0), b3, voffB);
            PG8_BAR; PG8_WAIT_L(0); PG8_MMA(0, 1, At, B1); PG8_BAR;
            PG8_LDA(At, 1, 1); PG8_STAGE(PG8_SA(1, 0), a3, voffA);
            PG8_BAR; PG8_WAIT_L(0); PG8_MMA(1, 0, At, B0); PG8_BAR; PG8_SCHED;
            PG8_STAGE(PG8_SB(1, 1), b3 + hstepB, voffB);
            PG8_WAIT_V(6); PG8_BAR; PG8_MMA(1, 1, At, B1); PG8_BAR;
            }
        }
        if constexpr (ALIGN_EPI) { if (wr == 0) PG8_BAR; }
        if constexpr (!Epi::AFTER_DRAIN) { E(acc, cur, wr, wc, fr, fq); S.done(cur); }
        if (!has_next) break;
#pragma unroll
        for (int a = 0; a < 2; ++a)
#pragma unroll
            for (int b = 0; b < 2; ++b)
#pragma unroll
                for (int m = 0; m < 4; ++m)
#pragma unroll
                    for (int n = 0; n < 2; ++n) acc[a][b][m][n] = (f32x4){0.f, 0.f, 0.f, 0.f};
        cur = nxt; cA = nA; cB = nB; ++ui;
        if constexpr (ALIGN_EPI) { if (wr == 1) PG8_BAR; }
    }
    PG8_WAIT_V(0);
    if constexpr (!ALIGN_EPI) { if (wr == 0) PG8_BAR; }
    PG8_BAR;
    if constexpr (Epi::AFTER_DRAIN) { E.fused(acc, cur, wr, wc, fr, fq, lds, wid, lane); S.done(cur); }
#undef PG8_SA
#undef PG8_SB
#undef PG8_STAGE
#undef PG8_LDA
#undef PG8_LDB
#undef PG8_MMA
#undef PG8_WAIT_V
#undef PG8_WAIT_L
#undef PG8_BAR
#undef PG8_SCHED
}
}

namespace epi {
using pg8::f32x4; using pg8::u32x4; using pg8::Unit; using pg8::HALF; using pg8::BM;
__device__ __forceinline__ unsigned cvt_pk_bf16(float lo, float hi) { unsigned r; asm volatile("v_cvt_pk_bf16_f32 %0, %1, %2" : "=v"(r) : "v"(lo), "v"(hi)); return r; }
template <int MODE> struct EpiStore {
    static constexpr bool PERM = true, AFTER_DRAIN = false;
    bf16_t* O; int ldc; float* ssq; int which; float inv_n;
    __device__ __forceinline__ void operator()(const f32x4 (&acc)[2][2][4][2], const Unit& u, int wr, int wc, int fr, int fq) const {
        int row0 = u.pm * BM + wr * 64 + fr, col0 = u.pn * BM + wc * 32 + 8 * fq;
        if (MODE == 2) {
#pragma unroll
            for (int bj = 0; bj < 2; ++bj) { float cs[8];
#pragma unroll
                for (int i = 0; i < 8; ++i) cs[i] = __builtin_amdgcn_rsqf(ssq[2 * (col0 + bj * HALF + i) + which] * inv_n + EPS);
#pragma unroll
                for (int ai = 0; ai < 2; ++ai)
#pragma unroll
                    for (int m = 0; m < 4; ++m) { bf16_t* rowp = O + (size_t)(row0 + ai * HALF + m * 16) * ldc + col0 + bj * HALF; const f32x4 v0 = acc[ai][bj][m][0], v1 = acc[ai][bj][m][1];
                        u32x4 w; w.x = cvt_pk_bf16(v0[0] * cs[0], v0[1] * cs[1]); w.y = cvt_pk_bf16(v0[2] * cs[2], v0[3] * cs[3]); w.z = cvt_pk_bf16(v1[0] * cs[4], v1[1] * cs[5]); w.w = cvt_pk_bf16(v1[2] * cs[6], v1[3] * cs[7]);
                        *(u32x4*)rowp = w; } }
            return;
        }
#pragma unroll
        for (int ai = 0; ai < 2; ++ai)
#pragma unroll
            for (int m = 0; m < 4; ++m) { const int row = row0 + ai * HALF + m * 16; bf16_t* rowp = O + (size_t)row * ldc + col0;
                float rs = 1.f; if (MODE == 1) rs = __builtin_amdgcn_rsqf(ssq[2 * row + which] * inv_n + EPS);
                float sq = 0.f;
#pragma unroll
                for (int bj = 0; bj < 2; ++bj) { f32x4 v0 = acc[ai][bj][m][0], v1 = acc[ai][bj][m][1];
                    if (MODE == 1) { v0 = v0 * rs; v1 = v1 * rs; }
                    if (MODE == 3 && (u.pn == 0 || (u.pn == 1 && bj == 0))) sq += (v0.x * v0.x + v0.y * v0.y) + (v0.z * v0.z + v0.w * v0.w) + (v1.x * v1.x + v1.y * v1.y) + (v1.z * v1.z + v1.w * v1.w);
                    u32x4 w; w.x = cvt_pk_bf16(v0[0], v0[1]); w.y = cvt_pk_bf16(v0[2], v0[3]); w.z = cvt_pk_bf16(v1[0], v1[1]); w.w = cvt_pk_bf16(v1[2], v1[3]);
                    *(u32x4*)(rowp + bj * HALF) = w; }
                if (MODE == 3 && u.pn < 2) { sq += __shfl_xor(sq, 16); sq += __shfl_xor(sq, 32); if (fq == 0) atomicAdd(ssq + 2 * row + u.pn, sq); }
            }
    }
};
struct EpiResid {
    static constexpr bool PERM = false, AFTER_DRAIN = false;
    const float* x; const float* mod; float* out;
    __device__ __forceinline__ void operator()(const f32x4 (&acc)[2][2][4][2], const Unit& u, int wr, int wc, int fr, int fq) const {
        int row0 = u.pm * BM + wr * 64 + fr, col0 = u.pn * BM + wc * 32 + 4 * fq; const int b = (u.pm * BM) / SEQ;
        f32x4 gv[2][2];
#pragma unroll
        for (int bj = 0; bj < 2; ++bj)
#pragma unroll
            for (int n = 0; n < 2; ++n) gv[bj][n] = *(const f32x4*)(mod + (size_t)b * 6144 + 2 * D + col0 + bj * HALF + n * 16);
#pragma unroll
        for (int ai = 0; ai < 2; ++ai)
#pragma unroll
            for (int m = 0; m < 4; ++m) { const size_t off = (size_t)(row0 + ai * HALF + m * 16) * D + col0;
#pragma unroll
                for (int bj = 0; bj < 2; ++bj)
#pragma unroll
                    for (int n = 0; n < 2; ++n) { const f32x4 xv = *(const f32x4*)(x + off + bj * HALF + n * 16); *(f32x4*)(out + off + bj * HALF + n * 16) = xv + gv[bj][n] * acc[ai][bj][m][n]; } }
    }
};
}

#define LAS __attribute__((address_space(3)))
#define LDSW() asm volatile("s_waitcnt lgkmcnt(0)" ::: "memory")
constexpr int ATT_WLDS = (16 * 97 + 16 * 65) * 4;
__device__ __forceinline__ void attn_wave(const Params& P, int idx, int lane, LAS float* wl) {
    LAS float* Ks = wl; LAS float* Vs = wl + 16 * 97;
    const bf16_t* Q = (const bf16_t*)(P.ws + WS_Q); const bf16_t* KN = (const bf16_t*)(P.ws + WS_KN); const bf16_t* KR = (const bf16_t*)(P.ws + WS_KR);
    const bf16_t* VT = (const bf16_t*)(P.ws + WS_VT); bf16_t* Y = (bf16_t*)(P.ws + WS_XN);
    const int qb = 127 - (idx >> 5), bh = idx & 31, b = bh >> 3, h = bh & 7;
    const int qi = qb * 64 + lane; const size_t tq = (size_t)b * SEQ + qi;
    float q[96];
#pragma unroll
    for (int d = 0; d < 64; ++d) q[d] = bf2f(Q[tq * 768 + h * 96 + d]);
    { const float pos = (float)P.positions[tq];
#pragma unroll
      for (int f = 0; f < 16; ++f) { const float x1 = bf2f(Q[tq * 768 + h * 96 + 64 + f]), x2 = bf2f(Q[tq * 768 + h * 96 + 80 + f]); float s, c; sincos_rad(pos * INV64[2 * f], s, c);
          q[64 + f] = x1 * c - x2 * s; q[80 + f] = x1 * s + x2 * c; } }
    float o[64];
#pragma unroll
    for (int d = 0; d < 64; ++d) o[d] = 0.f;
    float m = -INFINITY, l = 0.f;
    const int nkt = (qb * 64 + 64) / 16;
    for (int kt = 0; kt < nkt; ++kt) {
        const int j0 = kt * 16;
        LDSW();
        for (int e = lane; e < 16 * 96; e += 64) { const int j = e / 96, d = e % 96; const size_t tk = (size_t)b * SEQ + j0 + j;
            Ks[j * 97 + d] = d < 64 ? bf2f(KN[tk * 512 + h * 64 + d]) : bf2f(KR[tk * 32 + d - 64]); }
        for (int e = lane; e < 16 * 64; e += 64) { const int d = e / 16, j = e % 16; Vs[j * 65 + d] = bf2f(VT[(size_t)(h * 64 + d) * T + (size_t)b * SEQ + j0 + j]); }
        LDSW();
        for (int j = 0; j < 16; ++j) {
            float s = 0.f;
#pragma unroll
            for (int d = 0; d < 96; ++d) s += q[d] * Ks[j * 97 + d];
            if (j0 + j > qi) s = -INFINITY;
            const float mn = fmaxf(m, s), sc = exp2f(m - mn), p = exp2f(s - mn);
            l = l * sc + p; m = mn;
#pragma unroll
            for (int d = 0; d < 64; ++d) o[d] = o[d] * sc + p * Vs[j * 65 + d];
        }
    }
    const float il = 1.f / l;
#pragma unroll
    for (int d = 0; d < 64; d += 8) { u32x4 w; w.x = pk2(o[d] * il, o[d + 1] * il); w.y = pk2(o[d + 2] * il, o[d + 3] * il); w.z = pk2(o[d + 4] * il, o[d + 5] * il); w.w = pk2(o[d + 6] * il, o[d + 7] * il);
        *(u32x4*)(Y + tq * D + h * 64 + d) = w; }
}
__device__ __forceinline__ void ret_wave(const Params& P, int bh, int lane, LAS float* wl) {
    LAS float* qs = wl; LAS float* ks = wl + 64;
    const bf16_t* proj = (const bf16_t*)(P.ws + WS_PROJ); const bf16_t* projt = (const bf16_t*)(P.ws + WS_PROJT); bf16_t* Y = (bf16_t*)(P.ws + WS_XN);
    const int h = bh & 7, b = bh >> 3, dv = lane;
    const float gamma = 1.0f - exp2f(-5.0f - (float)h);
    float S[64];
#pragma unroll
    for (int i = 0; i < 64; ++i) S[i] = 0.f;
    const float gr = P.g_ret_norm[h * 64 + dv];
    const int f = dv & 31; const float inv = INV64[f];
    for (int t = 0; t < SEQ; ++t) {
        const size_t tt = (size_t)b * SEQ + t;
        const float qa = bf2f(proj[tt * PLD + PC_RQ + h * 64 + f]), qb2 = bf2f(proj[tt * PLD + PC_RQ + h * 64 + 32 + f]);
        const float ka = bf2f(proj[tt * PLD + PC_RK + h * 64 + f]), kb2 = bf2f(proj[tt * PLD + PC_RK + h * 64 + 32 + f]);
        float s, c; sincos_rad((float)P.positions[tt] * inv, s, c);
        const float qv = dv < 32 ? qa * c - qb2 * s : qa * s + qb2 * c;
        const float kv = (dv < 32 ? ka * c - kb2 * s : ka * s + kb2 * c) * 0.125f;
        LDSW();
        qs[dv] = qv; ks[dv] = kv;
        LDSW();
        const float v = bf2f(projt[(size_t)(PT_RV + h * 64 + dv) * T + tt]);
        float y = 0.f;
#pragma unroll
        for (int i = 0; i < 64; ++i) { S[i] = S[i] * gamma + ks[i] * v; y += qs[i] * S[i]; }
        const float mu = wave_sum(y) * (1.f / 64.f); const float dlt = y - mu; const float var = wave_sum(dlt * dlt) * (1.f / 64.f);
        const float yn = dlt * (1.0f / sqrtf(var + EPS)) * gr;
        const float gate = bf2f(proj[tt * PLD + PC_RG + h * 64 + dv]);
        Y[tt * D + 512 + h * 64 + dv] = (bf16_t)f2bf(silu_f(gate) * yn);
    }
}
typedef short bf16x8 __attribute__((ext_vector_type(8)));
typedef float f32x16 __attribute__((ext_vector_type(16)));
__device__ __forceinline__ int crow(int r, int hi) { return (r & 3) + 8 * (r >> 2) + 4 * hi; }
__device__ __forceinline__ unsigned cvtpk(float lo, float hi) { unsigned r; asm("v_cvt_pk_bf16_f32 %0, %1, %2" : "=v"(r) : "v"(lo), "v"(hi)); return r; }
__device__ __forceinline__ float bfe(const u32x4& w, int e) { const unsigned d = w[e >> 1]; return (e & 1) ? bfhi(d) : bflo(d); }
__device__ __forceinline__ bf16x8 as_frag(const u32x4& w) { return __builtin_bit_cast(bf16x8, w); }
__device__ __forceinline__ void rope_pair(const u32x4& c1, const u32x4& c2, float pos, const float (&inv)[8], float sc, u32x4& o1, u32x4& o2) {
    float a[8], b[8];
#pragma unroll
    for (int e = 0; e < 8; ++e) { float sn, cs; sincos_rad(pos * inv[e], sn, cs); const float x1 = bfe(c1, e), x2 = bfe(c2, e); a[e] = (x1 * cs - x2 * sn) * sc; b[e] = (x1 * sn + x2 * cs) * sc; }
    o1 = (u32x4){cvtpk(a[0], a[1]), cvtpk(a[2], a[3]), cvtpk(a[4], a[5]), cvtpk(a[6], a[7])};
    o2 = (u32x4){cvtpk(b[0], b[1]), cvtpk(b[2], b[3]), cvtpk(b[4], b[5]), cvtpk(b[6], b[7])};
}
__device__ __forceinline__ void ret_kvc_item(const Params& P, int item, int lane) {
    const bf16_t* projt = (const bf16_t*)(P.ws + WS_PROJT); float* kvc = (float*)(P.ws + WS_KVC) + (size_t)item * 4096;
    const int h = item & 7, n = (item >> 3) & 63, b = item >> 9;
    const size_t t0 = (size_t)b * SEQ + n * 128;
    const float gamma = 1.0f - exp2f(-5.0f - (float)h), lg = log2f(gamma);
    const int f = lane & 31, hi = lane >> 5;
    const float invf = INV64[f];
    const bf16_t* kT0 = projt + (size_t)(PT_RK + h * 64 + f) * T + t0; const bf16_t* kT1 = kT0 + (size_t)32 * T;
    const bf16_t* vT = projt + (size_t)(PT_RV + h * 64 + f) * T + t0;
    f32x16 acc[2][2];
#pragma unroll
    for (int i = 0; i < 2; ++i)
#pragma unroll
        for (int j = 0; j < 2; ++j)
#pragma unroll
            for (int r = 0; r < 16; ++r) acc[i][j][r] = 0.f;
#pragma unroll 2
    for (int s = 0; s < 8; ++s) {
        const int j0 = 16 * s + 8 * hi;
        const u32x4 ka = *(const u32x4*)(kT0 + j0), kb = *(const u32x4*)(kT1 + j0);
        const u32x4 p0 = *(const u32x4*)(P.positions + t0 + j0), p1 = *(const u32x4*)(P.positions + t0 + j0 + 4);
        float c0[8], c1[8];
#pragma unroll
        for (int e = 0; e < 8; ++e) { const int pos = (int)(e < 4 ? p0[e] : p1[e - 4]); float sn, cs; sincos_rad((float)pos * invf, sn, cs);
            const float scj = 0.125f * __builtin_amdgcn_exp2f(-(float)(j0 + e) * lg); const float x1 = bfe(ka, e), x2 = bfe(kb, e);
            c0[e] = (x1 * cs - x2 * sn) * scj; c1[e] = (x1 * sn + x2 * cs) * scj; }
        const bf16x8 B0 = as_frag((u32x4){cvtpk(c0[0], c0[1]), cvtpk(c0[2], c0[3]), cvtpk(c0[4], c0[5]), cvtpk(c0[6], c0[7])});
        const bf16x8 B1 = as_frag((u32x4){cvtpk(c1[0], c1[1]), cvtpk(c1[2], c1[3]), cvtpk(c1[4], c1[5]), cvtpk(c1[6], c1[7])});
#pragma unroll
        for (int blk = 0; blk < 2; ++blk) { const bf16x8 A = *(const bf16x8*)(vT + (size_t)(32 * blk) * T + j0);
            acc[blk][0] = __builtin_amdgcn_mfma_f32_32x32x16_bf16(A, B0, acc[blk][0], 0, 0, 0); acc[blk][1] = __builtin_amdgcn_mfma_f32_32x32x16_bf16(A, B1, acc[blk][1], 0, 0, 0); }
    }
    const float g127 = __builtin_amdgcn_exp2f(127.0f * lg);
#pragma unroll
    for (int blk = 0; blk < 2; ++blk)
#pragma unroll
        for (int c = 0; c < 2; ++c)
#pragma unroll
            for (int r = 0; r < 16; ++r) kvc[(32 * blk + crow(r, hi)) * 64 + 32 * c + f] = acc[blk][c][r] * g127;
}
__device__ __forceinline__ void ret_scan(const Params& P, size_t gt, size_t nt) {
    float* kvc = (float*)(P.ws + WS_KVC);
    for (size_t i = gt; i < (size_t)NB * NH * 4096; i += nt) {
        const int e = (int)(i & 4095), h = (int)((i >> 12) & 7), b = (int)(i >> 15);
        const float gamma = 1.0f - exp2f(-5.0f - (float)h), decay = exp2f(128.0f * log2f(gamma));
        float st = 0.f;
        for (int n = 0; n < 64; ++n) { float* p = kvc + ((size_t)((b * 64 + n) * 8 + h)) * 4096 + e; const float v = *p; *p = st; st = st * decay + v; }
    }
}
__device__ __forceinline__ void ret_out_item(const Params& P, int item, int lane, LAS u32x4* wl) {
    const bf16_t* proj = (const bf16_t*)(P.ws + WS_PROJ); const bf16_t* projt = (const bf16_t*)(P.ws + WS_PROJT); const float* prev = (const float*)(P.ws + WS_KVC) + (size_t)item * 4096;
    bf16_t* Y = (bf16_t*)(P.ws + WS_XN);
    const int h = item & 7, n = (item >> 3) & 63, b = item >> 9;
    const size_t t0 = (size_t)b * SEQ + n * 128;
    const float gamma = 1.0f - exp2f(-5.0f - (float)h), lg = log2f(gamma);
    const int r32 = lane & 31, hi = lane >> 5;
    float invt[2][8];
#pragma unroll
    for (int s2 = 0; s2 < 2; ++s2)
#pragma unroll
        for (int e = 0; e < 8; ++e) invt[s2][e] = INV64[16 * s2 + 8 * hi + e];
#pragma unroll 1
    for (int jb = 0; jb < 4; ++jb) {
        const size_t tj = t0 + 32 * jb + r32; const float pos = (float)P.positions[tj]; const float scj = 0.125f * __builtin_amdgcn_exp2f(-(float)(32 * jb + r32) * lg);
        const bf16_t* row = proj + tj * PLD + PC_RK + h * 64 + 8 * hi;
        const u32x4 c0 = *(const u32x4*)(row), c1 = *(const u32x4*)(row + 16), c2 = *(const u32x4*)(row + 32), c3 = *(const u32x4*)(row + 48);
        u32x4 o0, o1, o2, o3; rope_pair(c0, c2, pos, invt[0], scj, o0, o2); rope_pair(c1, c3, pos, invt[1], scj, o1, o3);
        wl[(jb * 4 + 0) * 64 + lane] = o0; wl[(jb * 4 + 1) * 64 + lane] = o1; wl[(jb * 4 + 2) * 64 + lane] = o2; wl[(jb * 4 + 3) * 64 + lane] = o3;
    }
    bf16x8 pf[2][4];
#pragma unroll
    for (int blk = 0; blk < 2; ++blk)
#pragma unroll
        for (int s = 0; s < 4; ++s) { const float* pp = prev + (32 * blk + r32) * 64 + 16 * s + 8 * hi; const f32x4 a = *(const f32x4*)pp, c = *(const f32x4*)(pp + 4);
            pf[blk][s] = as_frag((u32x4){cvtpk(a.x, a.y), cvtpk(a.z, a.w), cvtpk(c.x, c.y), cvtpk(c.z, c.w)}); }
    const bf16_t* vT = projt + (size_t)(PT_RV + h * 64 + r32) * T + t0 + 4 * hi;
#pragma unroll 1
    for (int ib = 0; ib < 4; ++ib) {
        const size_t ti = t0 + 32 * ib + r32; const float pos = (float)P.positions[ti]; const float sci = __builtin_amdgcn_exp2f((float)(32 * ib + r32) * lg);
        const bf16_t* row = proj + ti * PLD + PC_RQ + h * 64 + 8 * hi;
        bf16x8 qf[4];
        { const u32x4 c0 = *(const u32x4*)(row), c1 = *(const u32x4*)(row + 16), c2 = *(const u32x4*)(row + 32), c3 = *(const u32x4*)(row + 48);
          u32x4 o0, o1, o2, o3; rope_pair(c0, c2, pos, invt[0], sci, o0, o2); rope_pair(c1, c3, pos, invt[1], sci, o1, o3);
          qf[0] = as_frag(o0); qf[1] = as_frag(o1); qf[2] = as_frag(o2); qf[3] = as_frag(o3); }
        f32x16 y[2];
#pragma unroll
        for (int blk = 0; blk < 2; ++blk) {
#pragma unroll
            for (int r = 0; r < 16; ++r) y[blk][r] = 0.f;
#pragma unroll
            for (int s = 0; s < 4; ++s) y[blk] = __builtin_amdgcn_mfma_f32_32x32x16_bf16(pf[blk][s], qf[s], y[blk], 0, 0, 0);
#pragma unroll
            for (int r = 0; r < 16; ++r) y[blk][r] *= gamma;
        }
        for (int jb = 0; jb <= ib; ++jb) {
            f32x16 st;
#pragma unroll
            for (int r = 0; r < 16; ++r) st[r] = 0.f;
#pragma unroll
            for (int s = 0; s < 4; ++s) { const u32x4 kf = wl[(jb * 4 + s) * 64 + lane]; st = __builtin_amdgcn_mfma_f32_32x32x16_bf16(as_frag(kf), qf[s], st, 0, 0, 0); }
            if (jb == ib) {
#pragma unroll
                for (int r = 0; r < 16; ++r) if (crow(r, hi) > r32) st[r] = 0.f;
            }
#pragma unroll
            for (int sp = 0; sp < 2; ++sp) {
                const bf16x8 pb = as_frag((u32x4){cvtpk(st[8 * sp], st[8 * sp + 1]), cvtpk(st[8 * sp + 2], st[8 * sp + 3]), cvtpk(st[8 * sp + 4], st[8 * sp + 5]), cvtpk(st[8 * sp + 6], st[8 * sp + 7])});
#pragma unroll
                for (int blk = 0; blk < 2; ++blk) { const bf16_t* vp = vT + (size_t)(32 * blk) * T + 32 * jb + 16 * sp;
                    const u32x2 lo = *(const u32x2*)vp, hh = *(const u32x2*)(vp + 8);
                    y[blk] = __builtin_amdgcn_mfma_f32_32x32x16_bf16(as_frag((u32x4){lo.x, lo.y, hh.x, hh.y}), pb, y[blk], 0, 0, 0); }
            }
        }
        float sum = 0.f;
#pragma unroll
        for (int blk = 0; blk < 2; ++blk)
#pragma unroll
            for (int r = 0; r < 16; ++r) sum += y[blk][r];
        sum += __shfl_xor(sum, 32); const float mu = sum * (1.f / 64.f);
        float var = 0.f;
#pragma unroll
        for (int blk = 0; blk < 2; ++blk)
#pragma unroll
            for (int r = 0; r < 16; ++r) { const float d = y[blk][r] - mu; var += d * d; }
        var += __shfl_xor(var, 32); const float rstd = 1.0f / sqrtf(var * (1.f / 64.f) + EPS);
#pragma unroll
        for (int blk = 0; blk < 2; ++blk)
#pragma unroll
            for (int g4 = 0; g4 < 4; ++g4) { const int dv0 = 32 * blk + 8 * g4 + 4 * hi;
                const u32x2 gt2 = *(const u32x2*)(proj + ti * PLD + PC_RG + h * 64 + dv0); const f32x4 gr = *(const f32x4*)(P.g_ret_norm + h * 64 + dv0);
                const float o0 = silu_f(bflo(gt2.x)) * (y[blk][4 * g4] - mu) * rstd * gr.x, o1 = silu_f(bfhi(gt2.x)) * (y[blk][4 * g4 + 1] - mu) * rstd * gr.y;
                const float o2 = silu_f(bflo(gt2.y)) * (y[blk][4 * g4 + 2] - mu) * rstd * gr.z, o3 = silu_f(bfhi(gt2.y)) * (y[blk][4 * g4 + 3] - mu) * rstd * gr.w;
                *(u32x2*)(Y + ti * D + 512 + h * 64 + dv0) = (u32x2){cvtpk(o0, o1), cvtpk(o2, o3)}; }
    }
}
#define TOPK_INS(LV, LI, val, id) do { float cv_ = (val); int ci_ = (id); _Pragma("unroll") for (int i_ = 0; i_ < 16; ++i_) { const bool c_ = cv_ > LV[i_]; const float tv_ = c_ ? LV[i_] : cv_; const int ti_ = c_ ? LI[i_] : ci_; \
    LV[i_] = c_ ? cv_ : LV[i_]; LI[i_] = c_ ? ci_ : LI[i_]; cv_ = tv_; ci_ = ti_; } } while (0)
__device__ __forceinline__ void route_wave(const Params& P, int item, int lane) {
    const bf16_t* QP = (const bf16_t*)(P.ws + WS_PROJ); const bf16_t* SK = (const bf16_t*)(P.ws + WS_SK);
    int* eidx = (int*)(P.ws + WS_EIDX); float* gate = (float*)(P.ws + WS_GATE);
    const size_t pair = (size_t)item * 64 + lane; const size_t t = pair >> 3; const int h = (int)(pair & 7);
    float tv[2][16]; int ti[2][16];
#pragma unroll
    for (int p = 0; p < 2; ++p) {
#pragma unroll
        for (int i = 0; i < 16; ++i) { tv[p][i] = -INFINITY; ti[p][i] = 0; }
        float q[128];
#pragma unroll
        for (int d = 0; d < 128; d += 8) { const u32x4 w = *(const u32x4*)(QP + t * 2048 + h * 256 + p * 128 + d);
            q[d] = bflo(w.x); q[d + 1] = bfhi(w.x); q[d + 2] = bflo(w.y); q[d + 3] = bfhi(w.y); q[d + 4] = bflo(w.z); q[d + 5] = bfhi(w.z); q[d + 6] = bflo(w.w); q[d + 7] = bfhi(w.w); }
        for (int k = 0; k < 128; ++k) { float s = 0.f; const unsigned* skr = (const unsigned*)(SK + (size_t)(p * 128 + k) * 128);
#pragma unroll
            for (int d = 0; d < 64; ++d) { const unsigned w = skr[d]; s += q[2 * d] * bflo(w); s += q[2 * d + 1] * bfhi(w); }
            TOPK_INS(tv[p], ti[p], s, k); }
    }
    float best[16]; int bidx[16];
#pragma unroll
    for (int i = 0; i < 16; ++i) { best[i] = -INFINITY; bidx[i] = 0; }
#pragma unroll
    for (int i = 0; i < 16; ++i)
#pragma unroll
        for (int j = 0; j < 16; ++j) if ((i + 1) * (j + 1) <= 16) TOPK_INS(best, bidx, tv[0][i] + tv[1][j], ti[0][i] * 128 + ti[1][j]);
    float ssum = 0.f; float e[16];
#pragma unroll
    for (int r = 0; r < 16; ++r) { e[r] = __expf(best[r] - best[0]); ssum += e[r]; }
    const float inv = 1.f / ssum;
#pragma unroll
    for (int r = 0; r < 16; r += 4) { *(u32x4*)(eidx + t * 128 + h * 16 + r) = (u32x4){(unsigned)bidx[r], (unsigned)bidx[r + 1], (unsigned)bidx[r + 2], (unsigned)bidx[r + 3]};
        *(f32x4*)(gate + t * 128 + h * 16 + r) = (f32x4){e[r] * inv, e[r + 1] * inv, e[r + 2] * inv, e[r + 3] * inv}; }
}
__device__ __forceinline__ void gather_wave(const Params& P, size_t t, int lane) {
    const bf16_t* H2 = (const bf16_t*)(P.ws + WS_XN); const bf16_t* EU = (const bf16_t*)(P.ws + WS_EU); const bf16_t* EV = (const bf16_t*)(P.ws + WS_EV);
    const int* eidx = (const int*)(P.ws + WS_EIDX); const float* gate = (const float*)(P.ws + WS_GATE); const float* mod = (const float*)(P.ws + WS_MOD);
    const int b = (int)(t / SEQ);
    float hv[16];
    { const u32x4 a = *(const u32x4*)(H2 + t * D + lane * 16), c = *(const u32x4*)(H2 + t * D + lane * 16 + 8);
      hv[0] = bflo(a.x); hv[1] = bfhi(a.x); hv[2] = bflo(a.y); hv[3] = bfhi(a.y); hv[4] = bflo(a.z); hv[5] = bfhi(a.z); hv[6] = bflo(a.w); hv[7] = bfhi(a.w);
      hv[8] = bflo(c.x); hv[9] = bfhi(c.x); hv[10] = bflo(c.y); hv[11] = bfhi(c.y); hv[12] = bflo(c.z); hv[13] = bfhi(c.z); hv[14] = bflo(c.w); hv[15] = bfhi(c.w); }
    const int my_e0 = eidx[t * 128 + lane], my_e1 = eidx[t * 128 + 64 + lane];
    const float my_g0 = gate[t * 128 + lane], my_g1 = gate[t * 128 + 64 + lane];
    float w0 = 0.f, w1 = 0.f;
#pragma unroll 4
    for (int s = 0; s < 128; ++s) {
        const int e = __builtin_amdgcn_readlane(s < 64 ? my_e0 : my_e1, s & 63);
        const u32x4 a = *(const u32x4*)(EU + (size_t)e * D + lane * 16), c = *(const u32x4*)(EU + (size_t)e * D + lane * 16 + 8);
        float d = hv[0] * bflo(a.x) + hv[1] * bfhi(a.x); d += hv[2] * bflo(a.y) + hv[3] * bfhi(a.y); d += hv[4] * bflo(a.z) + hv[5] * bfhi(a.z); d += hv[6] * bflo(a.w) + hv[7] * bfhi(a.w);
        d += hv[8] * bflo(c.x) + hv[9] * bfhi(c.x); d += hv[10] * bflo(c.y) + hv[11] * bfhi(c.y); d += hv[12] * bflo(c.z) + hv[13] * bfhi(c.z); d += hv[14] * bflo(c.w) + hv[15] * bfhi(c.w);
        d = wave_sum(d);
        if (lane == (s & 63)) { if (s < 64) w0 = d; else w1 = d; }
    }
    w0 = my_g0 * gelu_exact(w0); w1 = my_g1 * gelu_exact(w1);
    float acc[16];
#pragma unroll
    for (int i = 0; i < 16; ++i) acc[i] = 0.f;
#pragma unroll 4
    for (int s = 0; s < 128; ++s) {
        const int e = __builtin_amdgcn_readlane(s < 64 ? my_e0 : my_e1, s & 63);
        const float ww = __builtin_bit_cast(float, __builtin_amdgcn_readlane(__builtin_bit_cast(int, s < 64 ? w0 : w1), s & 63));
        const u32x4 a = *(const u32x4*)(EV + (size_t)e * D + lane * 8), c = *(const u32x4*)(EV + (size_t)e * D + 512 + lane * 8);
        acc[0] += ww * bflo(a.x); acc[1] += ww * bfhi(a.x); acc[2] += ww * bflo(a.y); acc[3] += ww * bfhi(a.y); acc[4] += ww * bflo(a.z); acc[5] += ww * bfhi(a.z); acc[6] += ww * bflo(a.w); acc[7] += ww * bfhi(a.w);
        acc[8] += ww * bflo(c.x); acc[9] += ww * bfhi(c.x); acc[10] += ww * bflo(c.y); acc[11] += ww * bfhi(c.y); acc[12] += ww * bflo(c.z); acc[13] += ww * bfhi(c.z); acc[14] += ww * bflo(c.w); acc[15] += ww * bfhi(c.w);
    }
    float x3[16]; float ss = 0.f;
#pragma unroll
    for (int q = 0; q < 4; ++q) { const int col = (q >> 1) * 512 + lane * 8 + (q & 1) * 4;
        const f32x4 xv = *(const f32x4*)(P.out + t * D + col), gv = *(const f32x4*)(mod + (size_t)b * 6144 + 5 * D + col);
#pragma unroll
        for (int i = 0; i < 4; ++i) { const float v = xv[i] + gv[i] * acc[q * 4 + i]; x3[q * 4 + i] = v; ss += v * v; } }
    const float rstd = 1.0f / sqrtf(wave_sum(ss) * (1.f / D) + EPS);
#pragma unroll
    for (int q = 0; q < 4; ++q) { const int col = (q >> 1) * 512 + lane * 8 + (q & 1) * 4; const f32x4 gf = *(const f32x4*)(P.g_final + col);
        *(f32x4*)(P.out + t * D + col) = (f32x4){x3[q * 4] * rstd * gf.x, x3[q * 4 + 1] * rstd * gf.y, x3[q * 4 + 2] * rstd * gf.z, x3[q * 4 + 3] * rstd * gf.w}; }
}

namespace cg = cooperative_groups;
constexpr int LDS_BYTES = 147456;
struct KArgs { Params P; int ph_lo, ph_hi; };
__global__ void __launch_bounds__(512, 2) mk_fwd(KArgs ka) {
    extern __shared__ __attribute__((aligned(16))) unsigned char lds[];
    const Params& P = ka.P;
    cg::grid_group grid = cg::this_grid();
    PG8_LAS unsigned char* glds = (PG8_LAS unsigned char*)lds;
#define IDS() int tid_ = threadIdx.x; asm volatile("" : "+v"(tid_)); const int lane = tid_ & 63, wave = __builtin_amdgcn_readfirstlane(tid_ >> 6); \
    const int G = gridDim.x, gw = blockIdx.x * 8 + wave, nw = G * 8; const size_t gt = (size_t)blockIdx.x * 512 + tid_, nt = (size_t)G * 512; (void)lane; (void)gw; (void)nw; (void)gt; (void)nt;
#define IN(k) (ka.ph_lo <= (k) && (k) < ka.ph_hi)
#define SYNC(k) do { if (IN(k) && IN((k) + 1)) grid.sync(); } while (0)
#define WSP(T_, off) ((T_*)(P.ws + (off)))
    if (IN(0)) { IDS(); p0_prologue(P, gw, nw, lane, (float*)(lds + wave * 8448)); }
    SYNC(0);
    if (IN(1)) { IDS(); mod_final(P, gt, nt); rownorm_pass<true>(P, P.x, P.g_norm1, 0, 1, WSP(bf16_t, WS_XN), gw, nw, lane); }
    SYNC(1);
    if (IN(2)) {
        { pg8::Gemm g{WSP(const bf16_t, WS_XN), WSP(const bf16_t, WS_W1T), T, 2048, D, D, D}; pg8::StaticOrder S; S.init(T, 2048, gridDim.x, (int)blockIdx.x);
          epi::EpiStore<3> E{WSP(bf16_t, WS_PROJ), PLD, WSP(float, WS_SSQ), 0, 0.f}; pg8::gemm_phase<epi::EpiStore<3>, pg8::StaticOrder, true, true>(glds, g, S, E); }
        { pg8::Gemm g{WSP(const bf16_t, WS_W1TT), WSP(const bf16_t, WS_XN), 1024, T, D, D, D}; pg8::StaticOrder S; S.init(1024, T, gridDim.x, (int)blockIdx.x);
          epi::EpiStore<0> E{WSP(bf16_t, WS_PROJT), T, nullptr, 0, 0.f}; pg8::gemm_phase<epi::EpiStore<0>, pg8::StaticOrder, true, true>(glds, g, S, E); }
    }
    SYNC(2);
    if (IN(3)) {
        { pg8::Gemm g{WSP(const bf16_t, WS_PROJ) + PC_QL, WSP(const bf16_t, WS_WUQ), T, 768, 256, PLD, 256}; pg8::StaticOrder S; S.init(T, 768, gridDim.x, (int)blockIdx.x);
          epi::EpiStore<1> E{WSP(bf16_t, WS_Q), 768, WSP(float, WS_SSQ), 0, 1.f / 256.f}; pg8::gemm_phase<epi::EpiStore<1>, pg8::StaticOrder, true, true>(glds, g, S, E); }
        { pg8::Gemm g{WSP(const bf16_t, WS_PROJ) + PC_KVL, WSP(const bf16_t, WS_WK), T, 512, 256, PLD, 256}; pg8::StaticOrder S; S.init(T, 512, gridDim.x, (int)blockIdx.x);
          epi::EpiStore<1> E{WSP(bf16_t, WS_KN), 512, WSP(float, WS_SSQ), 1, 1.f / 128.f}; pg8::gemm_phase<epi::EpiStore<1>, pg8::StaticOrder, true, true>(glds, g, S, E); }
        { pg8::Gemm g{WSP(const bf16_t, WS_WV), WSP(const bf16_t, WS_PROJ) + PC_KVL, 512, T, 256, 256, PLD}; pg8::StaticOrder S; S.init(512, T, gridDim.x, (int)blockIdx.x);
          epi::EpiStore<2> E{WSP(bf16_t, WS_VT), T, WSP(float, WS_SSQ), 1, 1.f / 128.f}; pg8::gemm_phase<epi::EpiStore<2>, pg8::StaticOrder, true, true>(glds, g, S, E); }
        { IDS(); kr_pass(P, gt, nt); for (int i = gw; i < NB * 64 * NH; i += nw) ret_kvc_item(P, i, lane); }
    }
    SYNC(3);
    if (IN(4)) { IDS();
        ret_scan(P, gt, nt);
        for (int i = gw; i < 2048; i += nw) { attn_wave(P, i, lane, (LAS float*)(glds + wave * ATT_WLDS)); attn_wave(P, 4095 - i, lane, (LAS float*)(glds + wave * ATT_WLDS)); }
    }
    SYNC(4);
    if (IN(5)) { IDS(); for (int i = gw; i < NB * 64 * NH; i += nw) ret_out_item(P, i, lane, (LAS u32x4*)(glds + wave * 16384)); }
    SYNC(5);
    if (IN(6)) { pg8::Gemm g{WSP(const bf16_t, WS_XN), WSP(const bf16_t, WS_WOUT), T, D, D, D, D}; pg8::StaticOrder S; S.init(T, D, gridDim.x, (int)blockIdx.x);
        epi::EpiResid E{P.x, WSP(const float, WS_MOD), P.out}; pg8::gemm_phase<epi::EpiResid, pg8::StaticOrder, true, true>(glds, g, S, E); }
    SYNC(6);
    if (IN(7)) { IDS(); rownorm_pass<false>(P, P.out, P.g_norm2, 3, 4, WSP(bf16_t, WS_XN), gw, nw, lane); }
    SYNC(7);
    if (IN(8)) { pg8::Gemm g{WSP(const bf16_t, WS_XN), WSP(const bf16_t, WS_WQ), T, 2048, D, D, D}; pg8::StaticOrder S; S.init(T, 2048, gridDim.x, (int)blockIdx.x);
        epi::EpiStore<0> E{WSP(bf16_t, WS_PROJ), 2048, nullptr, 0, 0.f}; pg8::gemm_phase<epi::EpiStore<0>, pg8::StaticOrder, true, true>(glds, g, S, E); }
    SYNC(8);
    if (IN(9)) { IDS(); for (int i = gw; i < T * 8 / 64; i += nw) route_wave(P, i, lane); }
    SYNC(9);
    if (IN(10)) { IDS(); for (size_t t = gw; t < (size_t)T; t += nw) gather_wave(P, t, lane); }
#undef IN
#undef SYNC
#undef IDS
#undef WSP
}

extern "C" void kernel_launch(void* const* d_in, const int* in_sizes, int n_in, void* d_out, int out_size, void* d_ws, size_t ws_size, hipStream_t stream) {
    if (n_in != 19 || out_size != T * D || ws_size < WS_END) { fprintf(stderr, "kernel_launch: unexpected shapes (n_in %d out %d ws %zu)\n", n_in, out_size, ws_size); return; }
    static int grid = 0;
    if (grid == 0) {
        int dev = 0, cus = 0, per_cu = 0;
        if (hipGetDevice(&dev) != hipSuccess || hipDeviceGetAttribute(&cus, hipDeviceAttributeMultiprocessorCount, dev) != hipSuccess) { fprintf(stderr, "kernel_launch: device query failed\n"); grid = -1; return; }
        if (hipFuncSetAttribute((const void*)mk_fwd, hipFuncAttributeMaxDynamicSharedMemorySize, LDS_BYTES) != hipSuccess) { fprintf(stderr, "kernel_launch: hipFuncSetAttribute failed\n"); grid = -1; return; }
        if (hipOccupancyMaxActiveBlocksPerMultiprocessor(&per_cu, (const void*)mk_fwd, 512, LDS_BYTES) != hipSuccess || per_cu < 1) { fprintf(stderr, "kernel_launch: occupancy query failed (%d)\n", per_cu); (void)hipGetLastError(); per_cu = 1; }
        grid = cus * (per_cu > 1 ? 1 : per_cu);
    }
    if (grid < 0) return;
    KArgs ka{};
    Params& P = ka.P;
    P.x = (const float*)d_in[0]; P.c = (const float*)d_in[1]; P.positions = (const int*)d_in[2]; P.w_ada = (const float*)d_in[3]; P.b_ada = (const float*)d_in[4];
    P.g_norm1 = (const float*)d_in[5]; P.w_in = (const float*)d_in[6]; P.g_q_norm = (const float*)d_in[7]; P.w_uq = (const float*)d_in[8]; P.g_kv_norm = (const float*)d_in[9];
    P.w_ukv = (const float*)d_in[10]; P.g_ret_norm = (const float*)d_in[11]; P.w_out = (const float*)d_in[12]; P.g_norm2 = (const float*)d_in[13]; P.w_query = (const float*)d_in[14];
    P.sub_keys = (const float*)d_in[15]; P.expert_u = (const float*)d_in[16]; P.expert_v = (const float*)d_in[17]; P.g_final = (const float*)d_in[18];
    P.out = (float*)d_out; P.ws = (unsigned char*)d_ws;
    ka.ph_lo = 0; ka.ph_hi = 11;
    void* args[] = {&ka};
    const hipError_t e = hipLaunchCooperativeKernel((const void*)mk_fwd, dim3(grid), dim3(512), args, LDS_BYTES, stream);
    if (e != hipSuccess) fprintf(stderr, "kernel_launch: cooperative launch failed: %s (grid %d)\n", hipGetErrorString(e), grid);
}
```

```cpp
#include <hip/hip_runtime.h>
#include <hip/hip_cooperative_groups.h>
#include <cstdint>
#include <cstdio>

typedef unsigned short bf16_t;
typedef float f32x4 __attribute__((ext_vector_type(4)));
typedef unsigned u32x4 __attribute__((ext_vector_type(4)));
typedef unsigned u32x2 __attribute__((ext_vector_type(2)));

constexpr int NB = 4, SEQ = 8192, T = NB * SEQ, D = 1024;
constexpr int IN_COLS = 2464;
constexpr int NH = 8;
constexpr int QK = 96, NOPE = 64, ROPE = 32, DV = 64;
constexpr int QR = 256, KVR = 128;
constexpr int NEXP = 16384, PK = 16, NKEYS = 128;
constexpr float EPS = 1e-6f;
constexpr float LOG2E = 1.4426950408889634f;
constexpr float QSCALE = 0.10206207261596575f * LOG2E;

constexpr size_t MiB = 1u << 20;
constexpr size_t WS_CTL = 0;
constexpr size_t WS_MODP = 1 * MiB;
constexpr size_t WS_MOD = 3 * MiB - 128 * 1024;
constexpr size_t WS_SSQ = 3 * MiB;
constexpr size_t WS_W1T = 4 * MiB;
constexpr size_t WS_W1TT = 8 * MiB;
constexpr size_t WS_WUQ = 10 * MiB;
constexpr size_t WS_WK = 10 * MiB + 512 * 1024;
constexpr size_t WS_WV = 10 * MiB + 768 * 1024;
constexpr size_t WS_WOUT = 11 * MiB;
constexpr size_t WS_WQ = 13 * MiB;
constexpr size_t WS_SK = 17 * MiB;
constexpr size_t WS_EU = 18 * MiB;
constexpr size_t WS_EV = 50 * MiB;
constexpr size_t WS_XN = 82 * MiB;
constexpr size_t WS_PROJ = 146 * MiB;
constexpr size_t WS_PROJT = 274 * MiB;
constexpr size_t WS_Q = 338 * MiB;
constexpr size_t WS_KN = 386 * MiB;
constexpr size_t WS_KR = 418 * MiB;
constexpr size_t WS_VT = 420 * MiB;
constexpr size_t WS_KVC = 452 * MiB;
constexpr size_t WS_END = 484 * MiB;
constexpr size_t WS_EIDX = WS_PROJT;
constexpr size_t WS_GATE = WS_PROJT + 16 * MiB;

constexpr int PC_QL = 0, PC_KVL = 256, PC_KR = 384, PC_RQ = 512, PC_RK = 1024, PC_RG = 1536, PLD = 2048;
constexpr int PT_RK = 0, PT_RV = 512;

__constant__ float INV64[32] = {1.0f, 0.749894261f, 0.562341332f, 0.421696514f, 0.316227764f, 0.237137377f, 0.177827939f, 0.133352131f, 0.100000001f, 0.0749894157f, 0.0562341325f, 0.0421696529f, 0.0316227749f, 0.0237137377f, 0.0177827943f, 0.0133352149f, 0.00999999978f, 0.00749894185f, 0.00562341325f, 0.00421696482f, 0.00316227763f, 0.00237137359f, 0.00177827943f, 0.00133352145f, 0.00100000005f, 0.000749894243f, 0.000562341302f, 0.000421696517f, 0.000316227757f, 0.00023713737f, 0.00017782794f, 0.00013335215f};

struct Params {
    const float *x, *c; const int* positions; const float *w_ada, *b_ada, *g_norm1, *w_in, *g_q_norm, *w_uq, *g_kv_norm, *w_ukv, *g_ret_norm, *w_out, *g_norm2, *w_query, *sub_keys, *expert_u, *expert_v, *g_final;
    float* out; unsigned char* ws;
};

__device__ __forceinline__ unsigned f2bf(float f) { unsigned u = __builtin_bit_cast(unsigned, f); return (u + 0x7fffu + ((u >> 16) & 1u)) >> 16; }
__device__ __forceinline__ unsigned pk2(float lo, float hi) { return f2bf(lo) | (f2bf(hi) << 16); }
__device__ __forceinline__ float bf2f(unsigned short b) { return __builtin_bit_cast(float, (unsigned)b << 16); }
__device__ __forceinline__ float bflo(unsigned w) { return __builtin_bit_cast(float, w << 16); }
__device__ __forceinline__ float bfhi(unsigned w) { return __builtin_bit_cast(float, w & 0xffff0000u); }
__device__ __forceinline__ float wave_sum(float v) {
#pragma unroll
    for (int o = 1; o < 64; o <<= 1) v += __shfl_xor(v, o);
    return v;
}
__device__ __forceinline__ float silu_f(float v) { return v / (1.f + __expf(-v)); }
__device__ __forceinline__ void sincos_rad(float ang, float& s, float& c) {
    const float CH = 0.15915494f, CL = 3.0918913e-09f;
    const float rh = ang * CH, rl = __builtin_fmaf(ang, CH, -rh) + ang * CL;
    const float fr = (rh - __builtin_floorf(rh)) + rl;
    s = __builtin_amdgcn_sinf(fr); c = __builtin_amdgcn_cosf(fr);
}
__device__ __forceinline__ float gelu_exact(float v) { return 0.5f * v * (1.f + erff(v * 0.70710678118654752f)); }

__device__ __forceinline__ void p0_mod_item(const Params& P, int item, int lane) {
    const int kc = item / 24, nc = item % 24, n = nc * 256 + lane * 4;
    f32x4 acc[4] = {};
    for (int kk = 0; kk < 64; ++kk) {
        const int k = kc * 64 + kk;
        const f32x4 w = *(const f32x4*)(P.w_ada + (size_t)k * 6144 + n);
#pragma unroll
        for (int b = 0; b < 4; ++b) { const float s = silu_f(P.c[b * D + k]); acc[b] += w * s; }
    }
    float* modp = (float*)(P.ws + WS_MODP);
#pragma unroll
    for (int b = 0; b < 4; ++b) *(f32x4*)(modp + (size_t)(kc * 4 + b) * 6144 + n) = acc[b];
}
__device__ __forceinline__ void p0_transpose_block(const float* W, int ldw, int k0, int n0, bf16_t* dst, int row0, int ldd, const float* kscale, float scale, float* scr, int lane) {
#pragma unroll 8
    for (int i = 0; i < 32; ++i) { const int kk = 2 * i + (lane >> 5); const float ks = kscale ? kscale[k0 + kk] * scale : scale;
        scr[kk * 33 + (lane & 31)] = W[(size_t)(k0 + kk) * ldw + n0 + (lane & 31)] * ks; }
    asm volatile("s_waitcnt vmcnt(0) lgkmcnt(0)" ::: "memory");
    const int c = lane & 7;
#pragma unroll
    for (int j = 0; j < 4; ++j) { const int n = (lane >> 3) + 8 * j; const float* s = scr + (8 * c) * 33 + n;
        u32x4 o; o.x = pk2(s[0 * 33], s[1 * 33]); o.y = pk2(s[2 * 33], s[3 * 33]); o.z = pk2(s[4 * 33], s[5 * 33]); o.w = pk2(s[6 * 33], s[7 * 33]);
        *(u32x4*)(dst + (size_t)(row0 + n) * ldd + k0 + 8 * c) = o; }
    asm volatile("s_waitcnt vmcnt(0) lgkmcnt(0)" ::: "memory");
}
__device__ __forceinline__ void cvt8(const float* src, bf16_t* dst, size_t n8, size_t gt, size_t nt) {
    for (size_t i = gt; i < n8; i += nt) { const f32x4 a = *(const f32x4*)(src + i * 8), b = *(const f32x4*)(src + i * 8 + 4);
        u32x4 o; o.x = pk2(a.x, a.y); o.y = pk2(a.z, a.w); o.z = pk2(b.x, b.y); o.w = pk2(b.z, b.w); *(u32x4*)(dst + i * 8) = o; }
}
constexpr int IT_MOD = 384, IT_WIN = 16 * 77, IT_WUQ = 4 * 24, IT_WUKV = 2 * 32, IT_WOUT = 16 * 32, IT_WQ = 16 * 64;
constexpr int IT_TOTAL = IT_MOD + IT_WIN + IT_WUQ + IT_WUKV + IT_WOUT + IT_WQ;
__device__ __forceinline__ void p0_prologue(const Params& P, int gw, int nw, int lane, float* scr) {
    unsigned char* ws = P.ws;
    for (int it = gw; it < IT_TOTAL; it += nw) {
        int r = it;
        if (r < IT_MOD) { p0_mod_item(P, r, lane); continue; } r -= IT_MOD;
        if (r < IT_WIN) { const int kb = r / 77, nb = r % 77, n0 = nb * 32, k0 = kb * 64;
            bf16_t* w1t = (bf16_t*)(ws + WS_W1T); bf16_t* w1tt = (bf16_t*)(ws + WS_W1TT);
            if (n0 < 416) p0_transpose_block(P.w_in, IN_COLS, k0, n0, w1t, n0, D, nullptr, 1.f, scr, lane);
            else if (n0 < 928) p0_transpose_block(P.w_in, IN_COLS, k0, n0, w1t, PC_RQ + (n0 - 416), D, nullptr, 1.f, scr, lane);
            else if (n0 < 1440) { p0_transpose_block(P.w_in, IN_COLS, k0, n0, w1t, PC_RK + (n0 - 928), D, nullptr, 1.f, scr, lane);
                                  p0_transpose_block(P.w_in, IN_COLS, k0, n0, w1tt, PT_RK + (n0 - 928), D, nullptr, 1.f, scr, lane); }
            else if (n0 < 1952) p0_transpose_block(P.w_in, IN_COLS, k0, n0, w1tt, PT_RV + (n0 - 1440), D, nullptr, 1.f, scr, lane);
            else p0_transpose_block(P.w_in, IN_COLS, k0, n0, w1t, PC_RG + (n0 - 1952), D, nullptr, 1.f, scr, lane);
            continue; } r -= IT_WIN;
        if (r < IT_WUQ) { const int kb = r / 24, nb = r % 24; p0_transpose_block(P.w_uq, 768, kb * 64, nb * 32, (bf16_t*)(ws + WS_WUQ), nb * 32, 256, P.g_q_norm, QSCALE, scr, lane); continue; } r -= IT_WUQ;
        if (r < IT_WUKV) { const int kb = r / 32, nb = r % 32, n0 = nb * 32, h = n0 >> 7, rr = n0 & 127;
            if (rr < 64) p0_transpose_block(P.w_ukv, 1024, kb * 64, n0, (bf16_t*)(ws + WS_WK), h * 64 + rr, 256, P.g_kv_norm, 1.f, scr, lane);
            else p0_transpose_block(P.w_ukv, 1024, kb * 64, n0, (bf16_t*)(ws + WS_WV), h * 64 + rr - 64, 256, P.g_kv_norm, 1.f, scr, lane);
            continue; } r -= IT_WUKV;
        if (r < IT_WOUT) { const int kb = r / 32, nb = r % 32; p0_transpose_block(P.w_out, 1024, kb * 64, nb * 32, (bf16_t*)(ws + WS_WOUT), nb * 32, 1024, nullptr, 1.f, scr, lane); continue; } r -= IT_WOUT;
        { const int kb = r / 64, nb = r % 64; p0_transpose_block(P.w_query, 2048, kb * 64, nb * 32, (bf16_t*)(ws + WS_WQ), nb * 32, 1024, nullptr, 1.f, scr, lane); }
    }
    const size_t gt = (size_t)gw * 64 + lane, nt = (size_t)nw * 64;
    { u32x4 z = {0u, 0u, 0u, 0u};
      for (size_t i = gt; i < 96 * 1024 / 8; i += nt) *(u32x4*)((bf16_t*)(ws + WS_W1T) + (size_t)416 * 1024 + i * 8) = z;
      for (size_t i = gt; i < 2 * 512 * 16; i += nt) { const size_t m = i / (512 * 16), rr = (i / 16) % 512, cc = i % 16; *(u32x4*)((bf16_t*)(ws + (m ? WS_WV : WS_WK)) + rr * 256 + 128 + cc * 8) = z; }
      for (size_t i = gt; i < (size_t)T * 2 / 4; i += nt) *(u32x4*)((float*)(ws + WS_SSQ) + i * 4) = z; }
    cvt8(P.sub_keys, (bf16_t*)(ws + WS_SK), 2 * 128 * 128 / 8, gt, nt);
    cvt8(P.expert_u, (bf16_t*)(ws + WS_EU), (size_t)NEXP * D / 8, gt, nt);
    cvt8(P.expert_v, (bf16_t*)(ws + WS_EV), (size_t)NEXP * D / 8, gt, nt);
}

template <bool FROM_PART> __device__ __forceinline__ void rownorm_pass(const Params& P, const float* src, const float* g, int seg_sh, int seg_sc, bf16_t* dst, int gw, int nw, int lane) {
    const float* modp = (const float*)(P.ws + WS_MODP); const float* mod = (const float*)(P.ws + WS_MOD);
    for (int r0 = gw * 16; r0 < T; r0 += nw * 16) {
        const int b = r0 / SEQ;
        f32x4 mul[4], add[4];
#pragma unroll
        for (int j = 0; j < 4; ++j) {
            const int col = lane * 4 + 256 * j;
            f32x4 sc, sh;
            if (FROM_PART) {
                sc = *(const f32x4*)(P.b_ada + seg_sc * D + col); sh = *(const f32x4*)(P.b_ada + seg_sh * D + col);
                for (int kc = 0; kc < 16; ++kc) { sc += *(const f32x4*)(modp + (size_t)(kc * 4 + b) * 6144 + seg_sc * D + col); sh += *(const f32x4*)(modp + (size_t)(kc * 4 + b) * 6144 + seg_sh * D + col); }
            } else { sc = *(const f32x4*)(mod + (size_t)b * 6144 + seg_sc * D + col); sh = *(const f32x4*)(mod + (size_t)b * 6144 + seg_sh * D + col); }
            const f32x4 gg = *(const f32x4*)(g + col);
            mul[j] = gg * (sc + 1.0f); add[j] = sh;
        }
        for (int rr = 0; rr < 16; ++rr) {
            const int row = r0 + rr;
            const f32x4* xr = (const f32x4*)(src + (size_t)row * D) + lane;
            f32x4 v[4]; float s = 0.f;
#pragma unroll
            for (int j = 0; j < 4; ++j) { v[j] = xr[64 * j]; s += (v[j].x * v[j].x + v[j].y * v[j].y) + (v[j].z * v[j].z + v[j].w * v[j].w); }
            const float rstd = 1.0f / sqrtf(wave_sum(s) * (1.f / D) + EPS);
            u32x2* o = (u32x2*)(dst + (size_t)row * D) + lane;
#pragma unroll
            for (int j = 0; j < 4; ++j) { const f32x4 y = v[j] * rstd * mul[j] + add[j]; u32x2 w; w.x = pk2(y.x, y.y); w.y = pk2(y.z, y.w); o[64 * j] = w; }
        }
    }
}
__device__ __forceinline__ void mod_final(const Params& P, size_t gt, size_t nt) {
    const float* modp = (const float*)(P.ws + WS_MODP); float* mod = (float*)(P.ws + WS_MOD);
    for (size_t i = gt; i < 4 * 6144; i += nt) { float s = P.b_ada[i % 6144]; for (int kc = 0; kc < 16; ++kc) s += modp[(size_t)kc * 4 * 6144 + i]; mod[i] = s; }
}

__device__ __forceinline__ void kr_pass(const Params& P, size_t gt, size_t nt) {
    const bf16_t* proj = (const bf16_t*)(P.ws + WS_PROJ); bf16_t* kr = (bf16_t*)(P.ws + WS_KR);
    for (size_t i = gt; i < (size_t)T * 16; i += nt) {
        const int t = (int)(i >> 4), f = (int)(i & 15);
        const float x1 = bf2f(proj[(size_t)t * PLD + PC_KR + f]), x2 = bf2f(proj[(size_t)t * PLD + PC_KR + 16 + f]);
        float s, c; sincos_rad((float)P.positions[t] * INV64[2 * f], s, c);
        kr[(size_t)t * 32 + f] = (bf16_t)f2bf(x1 * c - x2 * s); kr[(size_t)t * 32 + 16 + f] = (bf16_t)f2bf(x1 * s + x2 * c);
    }
}

namespace pg8 {
#define PG8_LAS __attribute__((address_space(3)))
typedef unsigned short bf16_t;
typedef short bf16x8 __attribute__((ext_vector_type(8)));
typedef float f32x4 __attribute__((ext_vector_type(4)));
typedef unsigned u32x4 __attribute__((ext_vector_type(4)));
constexpr int BM = 256, BK = 64, HALF = 128, HTB = HALF * BK * 2  , STAGE_BYTES = 8 * HTB, NXCD = 8, WGM = 8;

__host__ __device__ __forceinline__ int lds_byte(int r, int c) { const int st = (r >> 4) * 2 + (c >> 5), rr = r & 15, cc = c & 31, ob = rr * 64 + cc * 2; return st * 1024 + (ob ^ (((ob >> 9) & 1) << 5)); }
__host__ __device__ __forceinline__ void stage_rc(int b, int& R, int& C) { const int st = b / 1024, sb = b % 1024, swz = sb ^ (((sb >> 9) & 1) << 5); R = (st >> 1) * 16 + swz / 64; C = (st & 1) * 32 + (swz % 64) / 2; }
__host__ __device__ __forceinline__ int perm32(int rho) { const int n = rho >> 4, i = rho & 15; return 8 * (i >> 2) + 4 * n + (i & 3); }

struct Unit { int pm, pn; };
struct Gemm { const bf16_t* A; const bf16_t* Bt; int M, N, K, lda, ldb; };

struct StaticOrder {
    int nM, nN, nwg, G, c;
    __host__ __device__ void init(int M, int N, int G_, int c_) { nM = M / BM; nN = N / BM; nwg = nM * nN; G = G_; c = c_; }
    __host__ __device__ bool next(int i, Unit& u) const {
        const long L = (long)i * G + c; if (L >= nwg) return false;
        int wgid = (int)L; { const int q = nwg / NXCD, r = nwg % NXCD, xcd = wgid % NXCD, off = wgid / NXCD; wgid = (xcd < r ? xcd * (q + 1) : r * (q + 1) + (xcd - r) * q) + off; }
        const int nig = WGM * nN, gid = wgid / nig, fm = gid * WGM, gsz = (nM - fm) < WGM ? (nM - fm) : WGM;
        u.pm = fm + ((wgid % nig) % gsz); u.pn = (wgid % nig) / gsz; return true;
    }
    __device__ __forceinline__ void a_ready(const Unit&) const {}
    __device__ __forceinline__ void done(const Unit&) const {}
};


template <class Epi, class Sched, bool ALIGN_EPI = false, bool SP2 = false>
__device__ __forceinline__ void gemm_phase(PG8_LAS unsigned char* lds, const Gemm g, const Sched& S, const Epi& E) {
    int tid = threadIdx.x; asm volatile("" : "+v"(tid));
    const int wid = __builtin_amdgcn_readfirstlane(tid >> 6), lane = tid & 63, wr = wid >> 2, wc = wid & 3, fr = lane & 15, fq = lane >> 4;
    const int K = g.K, nt = K / BK;
    unsigned voffA[2], voffB[2];
#pragma unroll
    for (int i = 0; i < 2; ++i) { int R, C; stage_rc(tid * 16 + i * 8192, R, C); const int Rb = Epi::PERM ? ((R & ~31) + perm32(R & 31)) : R;
        voffA[i] = (unsigned)(R * g.lda + C) * 2u; voffB[i] = (unsigned)(Rb * g.ldb + C) * 2u; }
    const size_t kstep = (size_t)(BK * 2);
    const size_t hstepA = (size_t)HALF * g.lda * 2, hstepB = (size_t)HALF * g.ldb * 2;
    const size_t tstepA = 2 * hstepA, tstepB = 2 * hstepB;
    const unsigned ldsw = (unsigned)wid * 1024u;
    const int aoff = lds_byte(wr * 64 + fr, fq * 8), boff = lds_byte(wc * 32 + fr, fq * 8);
#define PG8_SA(b, h) (((b) * 2 + (h)) * HTB)
#define PG8_SB(b, h) ((4 + (b) * 2 + (h)) * HTB)
#define PG8_STAGE(bufoff, gbase, voff) do { _Pragma("unroll") for (int _i = 0; _i < 2; ++_i) \
        __builtin_amdgcn_global_load_lds((const unsigned*)((const char*)(gbase) + (voff)[_i]), (PG8_LAS unsigned*)(lds + (bufoff) + ldsw + _i * 8192), 16, 0, 0); } while (0)
#define PG8_LDA(dst, b, h) do { _Pragma("unroll") for (int m = 0; m < 4; ++m) _Pragma("unroll") for (int k = 0; k < 2; ++k) dst[m][k] = *(const PG8_LAS bf16x8*)(lds + PG8_SA(b, h) + aoff + m * 2048 + k * 1024); } while (0)
#define PG8_LDB(dst, b, h) do { _Pragma("unroll") for (int n = 0; n < 2; ++n) _Pragma("unroll") for (int k = 0; k < 2; ++k) dst[n][k] = *(const PG8_LAS bf16x8*)(lds + PG8_SB(b, h) + boff + n * 2048 + k * 1024); } while (0)
#define PG8_MMA(ai, bj, At, Bt) do { __builtin_amdgcn_s_setprio(1); _Pragma("unroll") for (int m = 0; m < 4; ++m) _Pragma("unroll") for (int n = 0; n < 2; ++n) _Pragma("unroll") for (int k = 0; k < 2; ++k) \
        acc[ai][bj][m][n] = __builtin_amdgcn_mfma_f32_16x16x32_bf16(Bt[n][k], At[m][k], acc[ai][bj][m][n], 0, 0, 0); __builtin_amdgcn_s_setprio(0); } while (0)
#define PG8_WAIT_V(n) asm volatile("s_waitcnt vmcnt(" #n ")" ::: "memory")
#define PG8_WAIT_L(n) asm volatile("s_waitcnt lgkmcnt(" #n ")" ::: "memory")
#define PG8_BAR __builtin_amdgcn_s_barrier()
#define PG8_SCHED __builtin_amdgcn_sched_barrier(0)
    Unit cur, nxt; int ui = 0;
    if (!S.next(0, cur)) return;
    f32x4 acc[2][2][4][2];
#pragma unroll
    for (int a = 0; a < 2; ++a)
#pragma unroll
        for (int b = 0; b < 2; ++b)
#pragma unroll
            for (int m = 0; m < 4; ++m)
#pragma unroll
                for (int n = 0; n < 2; ++n) acc[a][b][m][n] = (f32x4){0.f, 0.f, 0.f, 0.f};
    bf16x8 At[4][2], B0[2][2], B1[2][2];
    const char* cA = (const char*)g.A + (size_t)cur.pm * tstepA; const char* cB = (const char*)g.Bt + (size_t)cur.pn * tstepB;
    S.a_ready(cur);
    if constexpr (SP2) {
        PG8_STAGE(PG8_SB(0, 0), cB, voffB); PG8_STAGE(PG8_SB(0, 1), cB + hstepB, voffB); PG8_STAGE(PG8_SA(0, 0), cA, voffA); PG8_STAGE(PG8_SA(0, 1), cA + hstepA, voffA);
        if (wr == 1) PG8_BAR;
        PG8_WAIT_V(2); PG8_BAR;
        PG8_STAGE(PG8_SB(1, 0), cB + kstep, voffB); PG8_STAGE(PG8_SA(1, 0), cA + kstep, voffA); PG8_STAGE(PG8_SB(1, 1), cB + hstepB + kstep, voffB);
        PG8_WAIT_V(6); PG8_BAR;
    } else {
        PG8_STAGE(PG8_SB(0, 0), cB, voffB); PG8_STAGE(PG8_SA(0, 0), cA, voffA); PG8_STAGE(PG8_SB(0, 1), cB + hstepB, voffB); PG8_STAGE(PG8_SA(0, 1), cA + hstepA, voffA);
        if (wr == 1) PG8_BAR;
        PG8_WAIT_V(4); PG8_BAR;
        PG8_STAGE(PG8_SB(1, 0), cB + kstep, voffB); PG8_STAGE(PG8_SA(1, 0), cA + kstep, voffA); PG8_STAGE(PG8_SB(1, 1), cB + hstepB + kstep, voffB);
        PG8_WAIT_V(6); PG8_BAR;
    }
    for (;;) {
        const bool has_next = S.next(ui + 1, nxt);
        const char* nA = has_next ? (const char*)g.A + (size_t)nxt.pm * tstepA : cA; const char* nB = has_next ? (const char*)g.Bt + (size_t)nxt.pn * tstepB : cB;
        for (int t = 0; t < nt; t += 2) {
            const bool last = (t == nt - 2);
            const char* a1 = cA + (size_t)(t + 1) * kstep;
            const char* a2 = last ? nA : cA + (size_t)(t + 2) * kstep; const char* b2 = last ? nB : cB + (size_t)(t + 2) * kstep;
            const char* a3 = a2 + kstep; const char* b3 = b2 + kstep;
            if (last && has_next) S.a_ready(nxt);
            if constexpr (SP2) {
            PG8_LDB(B0, 0, 0); PG8_LDB(B1, 0, 1); PG8_SCHED; PG8_LDA(At, 0, 0); PG8_STAGE(PG8_SA(1, 1), a1 + hstepA, voffA);
            PG8_WAIT_V(8); PG8_WAIT_L(0); PG8_BAR; PG8_MMA(0, 0, At, B0); PG8_MMA(0, 1, At, B1); PG8_BAR; PG8_SCHED;
            PG8_LDA(At, 0, 1); PG8_STAGE(PG8_SB(0, 0), b2, voffB); PG8_STAGE(PG8_SB(0, 1), b2 + hstepB, voffB); PG8_STAGE(PG8_SA(0, 0), a2, voffA);
            PG8_WAIT_V(8); PG8_WAIT_L(0); PG8_BAR; PG8_MMA(1, 0, At, B0); PG8_MMA(1, 1, At, B1); PG8_BAR; PG8_SCHED;
            PG8_LDB(B0, 1, 0); PG8_LDB(B1, 1, 1); PG8_SCHED; PG8_LDA(At, 1, 0); PG8_STAGE(PG8_SA(0, 1), a2 + hstepA, voffA);
            PG8_WAIT_V(8); PG8_WAIT_L(0); PG8_BAR; PG8_MMA(0, 0, At, B0); PG8_MMA(0, 1, At, B1); PG8_BAR; PG8_SCHED;
            PG8_LDA(At, 1, 1); PG8_STAGE(PG8_SB(1, 0), b3, voffB); PG8_STAGE(PG8_SB(1, 1), b3 + hstepB, voffB); PG8_STAGE(PG8_SA(1, 0), a3, voffA);
            PG8_WAIT_V(8); PG8_WAIT_L(0); PG8_BAR; PG8_MMA(1, 0, At, B0); PG8_MMA(1, 1, At, B1); PG8_BAR; PG8_SCHED;
            } else {
            PG8_LDB(B0, 0, 0); PG8_SCHED; PG8_LDA(At, 0, 0); PG8_STAGE(PG8_SA(1, 1), a1 + hstepA, voffA);
            PG8_WAIT_L(8); PG8_BAR; PG8_WAIT_L(0); PG8_MMA(0, 0, At, B0); PG8_BAR; PG8_SCHED;
            PG8_LDB(B1, 0, 1); PG8_STAGE(PG8_SB(0, 0), b2, voffB);
            PG8_BAR; PG8_WAIT_L(0); PG8_MMA(0, 1, At, B1); PG8_BAR;
            PG8_LDA(At, 0, 1); PG8_STAGE(PG8_SA(0, 0), a2, voffA);
            PG8_BAR; PG8_WAIT_L(0); PG8_MMA(1, 0, At, B0); PG8_BAR; PG8_SCHED;
            PG8_STAGE(PG8_SB(0, 1), b2 + hstepB, voffB);
            PG8_WAIT_V(6); PG8_BAR; PG8_MMA(1, 1, At, B1); PG8_BAR;
            PG8_LDB(B0, 1, 0); PG8_SCHED; PG8_LDA(At, 1, 0); PG8_STAGE(PG8_SA(0, 1), a2 + hstepA, voffA);
            PG8_WAIT_L(8); PG8_BAR; PG8_WAIT_L(0); PG8_MMA(0, 0, At, B0); PG8_BAR; PG8_SCHED;
            PG8_LDB(B1, 1, 1); PG8_STAGE(PG8_SB(1, 0), b3, voffB);
            PG8_BAR; PG8_WAIT_L(0); PG8_MMA(0, 1, At, B1); PG8_BAR;
            PG8_LDA(At, 1, 1); PG8_STAGE(PG8_SA(1, 0), a3, voffA);
            PG8_BAR; PG8_WAIT_L(0); PG8_MMA(1, 0, At, B0); PG8_BAR; PG8_SCHED;
            PG8_STAGE(PG8_SB(1, 1), b3 + hstepB, voffB);
            PG8_WAIT_V(6); PG8_BAR; PG8_MMA(1, 1, At, B1); PG8_BAR;
            }
        }
        if constexpr (ALIGN_EPI) { if (wr == 0) PG8_BAR; }
        if constexpr (!Epi::AFTER_DRAIN) { E(acc, cur, wr, wc, fr, fq); S.done(cur); }
        if (!has_next) break;
#pragma unroll
        for (int a = 0; a < 2; ++a)
#pragma unroll
            for (int b = 0; b < 2; ++b)
#pragma unroll
                for (int m = 0; m < 4; ++m)
#pragma unroll
                    for (int n = 0; n < 2; ++n) acc[a][b][m][n] = (f32x4){0.f, 0.f, 0.f, 0.f};
        cur = nxt; cA = nA; cB = nB; ++ui;
        if constexpr (ALIGN_EPI) { if (wr == 1) PG8_BAR; }
    }
    PG8_WAIT_V(0);
    if constexpr (!ALIGN_EPI) { if (wr == 0) PG8_BAR; }
    PG8_BAR;
    if constexpr (Epi::AFTER_DRAIN) { E.fused(acc, cur, wr, wc, fr, fq, lds, wid, lane); S.done(cur); }
#undef PG8_SA
#undef PG8_SB
#undef PG8_STAGE
#undef PG8_LDA
#undef PG8_LDB
#undef PG8_MMA
#undef PG8_WAIT_V
#undef PG8_WAIT_L
#undef PG8_BAR
#undef PG8_SCHED
}
}

namespace epi {
using pg8::f32x4; using pg8::u32x4; using pg8::Unit; using pg8::HALF; using pg8::BM;
__device__ __forceinline__ unsigned cvt_pk_bf16(float lo, float hi) { unsigned r; asm volatile("v_cvt_pk_bf16_f32 %0, %1, %2" : "=v"(r) : "v"(lo), "v"(hi)); return r; }
template <int MODE> struct EpiStore {
    static constexpr bool PERM = true, AFTER_DRAIN = false;
    bf16_t* O; int ldc; float* ssq; int which; float inv_n;
    __device__ __forceinline__ void operator()(const f32x4 (&acc)[2][2][4][2], const Unit& u, int wr, int wc, int fr, int fq) const {
        int row0 = u.pm * BM + wr * 64 + fr, col0 = u.pn * BM + wc * 32 + 8 * fq;
        if (MODE == 2) {
#pragma unroll
            for (int bj = 0; bj < 2; ++bj) { float cs[8];
#pragma unroll
                for (int i = 0; i < 8; ++i) cs[i] = __builtin_amdgcn_rsqf(ssq[2 * (col0 + bj * HALF + i) + which] * inv_n + EPS);
#pragma unroll
                for (int ai = 0; ai < 2; ++ai)
#pragma unroll
                    for (int m = 0; m < 4; ++m) { bf16_t* rowp = O + (size_t)(row0 + ai * HALF + m * 16) * ldc + col0 + bj * HALF; const f32x4 v0 = acc[ai][bj][m][0], v1 = acc[ai][bj][m][1];
                        u32x4 w; w.x = cvt_pk_bf16(v0[0] * cs[0], v0[1] * cs[1]); w.y = cvt_pk_bf16(v0[2] * cs[2], v0[3] * cs[3]); w.z = cvt_pk_bf16(v1[0] * cs[4], v1[1] * cs[5]); w.w = cvt_pk_bf16(v1[2] * cs[6], v1[3] * cs[7]);
                        *(u32x4*)rowp = w; } }
            return;
        }
#pragma unroll
        for (int ai = 0; ai < 2; ++ai)
#pragma unroll
            for (int m = 0; m < 4; ++m) { const int row = row0 + ai * HALF + m * 16; bf16_t* rowp = O + (size_t)row * ldc + col0;
                float rs = 1.f; if (MODE == 1) rs = __builtin_amdgcn_rsqf(ssq[2 * row + which] * inv_n + EPS);
                float sq = 0.f;
#pragma unroll
                for (int bj = 0; bj < 2; ++bj) { f32x4 v0 = acc[ai][bj][m][0], v1 = acc[ai][bj][m][1];
                    if (MODE == 1) { v0 = v0 * rs; v1 = v1 * rs; }
                    if (MODE == 3 && (u.pn == 0 || (u.pn == 1 && bj == 0))) sq += (v0.x * v0.x + v0.y * v0.y) + (v0.z * v0.z + v0.w * v0.w) + (v1.x * v1.x + v1.y * v1.y) + (v1.z * v1.z + v1.w * v1.w);
                    u32x4 w; w.x = cvt_pk_bf16(v0[0], v0[1]); w.y = cvt_pk_bf16(v0[2], v0[3]); w.z = cvt_pk_bf16(v1[0], v1[1]); w.w = cvt_pk_bf16(v1[2], v1[3]);
                    *(u32x4*)(rowp + bj * HALF) = w; }
                if (MODE == 3 && u.pn < 2) { sq += __shfl_xor(sq, 16); sq += __shfl_xor(sq, 32); if (fq == 0) atomicAdd(ssq + 2 * row + u.pn, sq); }
            }
    }
};
struct EpiResid {
    static constexpr bool PERM = false, AFTER_DRAIN = false;
    const float* x; const float* mod; float* out;
    __device__ __forceinline__ void operator()(const f32x4 (&acc)[2][2][4][2], const Unit& u, int wr, int wc, int fr, int fq) const {
        int row0 = u.pm * BM + wr * 64 + fr, col0 = u.pn * BM + wc * 32 + 4 * fq; const int b = (u.pm * BM) / SEQ;
        f32x4 gv[2][2];
#pragma unroll
        for (int bj = 0; bj < 2; ++bj)
#pragma unroll
            for (int n = 0; n < 2; ++n) gv[bj][n] = *(const f32x4*)(mod + (size_t)b * 6144 + 2 * D + col0 + bj * HALF + n * 16);
#pragma unroll
        for (int ai = 0; ai < 2; ++ai)
#pragma unroll
            for (int m = 0; m < 4; ++m) { const size_t off = (size_t)(row0 + ai * HALF + m * 16) * D + col0;
#pragma unroll
                for (int bj = 0; bj < 2; ++bj)
#pragma unroll
                    for (int n = 0; n < 2; ++n) { const f32x4 xv = *(const f32x4*)(x + off + bj * HALF + n * 16); *(f32x4*)(out + off + bj * HALF + n * 16) = xv + gv[bj][n] * acc[ai][bj][m][n]; } }
    }
};
}

#define LAS __attribute__((address_space(3)))
#define LDSW() asm volatile("s_waitcnt lgkmcnt(0)" ::: "memory")
constexpr int ATT_WLDS = (16 * 97 + 16 * 65) * 4;
__device__ __forceinline__ void attn_wave(const Params& P, int idx, int lane, LAS float* wl) {
    LAS float* Ks = wl; LAS float* Vs = wl + 16 * 97;
    const bf16_t* Q = (const bf16_t*)(P.ws + WS_Q); const bf16_t* KN = (const bf16_t*)(P.ws + WS_KN); const bf16_t* KR = (const bf16_t*)(P.ws + WS_KR);
    const bf16_t* VT = (const bf16_t*)(P.ws + WS_VT); bf16_t* Y = (bf16_t*)(P.ws + WS_XN);
    const int qb = 127 - (idx >> 5), bh = idx & 31, b = bh >> 3, h = bh & 7;
    const int qi = qb * 64 + lane; const size_t tq = (size_t)b * SEQ + qi;
    float q[96];
#pragma unroll
    for (int d = 0; d < 64; ++d) q[d] = bf2f(Q[tq * 768 + h * 96 + d]);
    { const float pos = (float)P.positions[tq];
#pragma unroll
      for (int f = 0; f < 16; ++f) { const float x1 = bf2f(Q[tq * 768 + h * 96 + 64 + f]), x2 = bf2f(Q[tq * 768 + h * 96 + 80 + f]); float s, c; sincos_rad(pos * INV64[2 * f], s, c);
          q[64 + f] = x1 * c - x2 * s; q[80 + f] = x1 * s + x2 * c; } }
    float o[64];
#pragma unroll
    for (int d = 0; d < 64; ++d) o[d] = 0.f;
    float m = -INFINITY, l = 0.f;
    const int nkt = (qb * 64 + 64) / 16;
    for (int kt = 0; kt < nkt; ++kt) {
        const int j0 = kt * 16;
        LDSW();
        for (int e = lane; e < 16 * 96; e += 64) { const int j = e / 96, d = e % 96; const size_t tk = (size_t)b * SEQ + j0 + j;
            Ks[j * 97 + d] = d < 64 ? bf2f(KN[tk * 512 + h * 64 + d]) : bf2f(KR[tk * 32 + d - 64]); }
        for (int e = lane; e < 16 * 64; e += 64) { const int d = e / 16, j = e % 16; Vs[j * 65 + d] = bf2f(VT[(size_t)(h * 64 + d) * T + (size_t)b * SEQ + j0 + j]); }
        LDSW();
        for (int j = 0; j < 16; ++j) {
            float s = 0.f;
#pragma unroll
            for (int d = 0; d < 96; ++d) s += q[d] * Ks[j * 97 + d];
            if (j0 + j > qi) s = -INFINITY;
            const float mn = fmaxf(m, s), sc = exp2f(m - mn), p = exp2f(s - mn);
            l = l * sc + p; m = mn;
#pragma unroll
            for (int d = 0; d < 64; ++d) o[d] = o[d] * sc + p * Vs[j * 65 + d];
        }
    }
    const float il = 1.f / l;
#pragma unroll
    for (int d = 0; d < 64; d += 8) { u32x4 w; w.x = pk2(o[d] * il, o[d + 1] * il); w.y = pk2(o[d + 2] * il, o[d + 3] * il); w.z = pk2(o[d + 4] * il, o[d + 5] * il); w.w = pk2(o[d + 6] * il, o[d + 7] * il);
        *(u32x4*)(Y + tq * D + h * 64 + d) = w; }
}
__device__ __forceinline__ void ret_wave(const Params& P, int bh, int lane, LAS float* wl) {
    LAS float* qs = wl; LAS float* ks = wl + 64;
    const bf16_t* proj = (const bf16_t*)(P.ws + WS_PROJ); const bf16_t* projt = (const bf16_t*)(P.ws + WS_PROJT); bf16_t* Y = (bf16_t*)(P.ws + WS_XN);
    const int h = bh & 7, b = bh >> 3, dv = lane;
    const float gamma = 1.0f - exp2f(-5.0f - (float)h);
    float S[64];
#pragma unroll
    for (int i = 0; i < 64; ++i) S[i] = 0.f;
    const float gr = P.g_ret_norm[h * 64 + dv];
    const int f = dv & 31; const float inv = INV64[f];
    for (int t = 0; t < SEQ; ++t) {
        const size_t tt = (size_t)b * SEQ + t;
        const float qa = bf2f(proj[tt * PLD + PC_RQ + h * 64 + f]), qb2 = bf2f(proj[tt * PLD + PC_RQ + h * 64 + 32 + f]);
        const float ka = bf2f(proj[tt * PLD + PC_RK + h * 64 + f]), kb2 = bf2f(proj[tt * PLD + PC_RK + h * 64 + 32 + f]);
        float s, c; sincos_rad((float)P.positions[tt] * inv, s, c);
        const float qv = dv < 32 ? qa * c - qb2 * s : qa * s + qb2 * c;
        const float kv = (dv < 32 ? ka * c - kb2 * s : ka * s + kb2 * c) * 0.125f;
        LDSW();
        qs[dv] = qv; ks[dv] = kv;
        LDSW();
        const float v = bf2f(projt[(size_t)(PT_RV + h * 64 + dv) * T + tt]);
        float y = 0.f;
#pragma unroll
        for (int i = 0; i < 64; ++i) { S[i] = S[i] * gamma + ks[i] * v; y += qs[i] * S[i]; }
        const float mu = wave_sum(y) * (1.f / 64.f); const float dlt = y - mu; const float var = wave_sum(dlt * dlt) * (1.f / 64.f);
        const float yn = dlt * (1.0f / sqrtf(var + EPS)) * gr;
        const float gate = bf2f(proj[tt * PLD + PC_RG + h * 64 + dv]);
        Y[tt * D + 512 + h * 64 + dv] = (bf16_t)f2bf(silu_f(gate) * yn);
    }
}
typedef short bf16x8 __attribute__((ext_vector_type(8)));
typedef float f32x16 __attribute__((ext_vector_type(16)));
__device__ __forceinline__ int crow(int r, int hi) { return (r & 3) + 8 * (r >> 2) + 4 * hi; }
__device__ __forceinline__ unsigned cvtpk(float lo, float hi) { unsigned r; asm("v_cvt_pk_bf16_f32 %0, %1, %2" : "=v"(r) : "v"(lo), "v"(hi)); return r; }
__device__ __forceinline__ float bfe(const u32x4& w, int e) { const unsigned d = w[e >> 1]; return (e & 1) ? bfhi(d) : bflo(d); }
__device__ __forceinline__ bf16x8 as_frag(const u32x4& w) { return __builtin_bit_cast(bf16x8, w); }
__device__ __forceinline__ void rope_pair(const u32x4& c1, const u32x4& c2, float pos, const float (&inv)[8], float sc, u32x4& o1, u32x4& o2) {
    float a[8], b[8];
#pragma unroll
    for (int e = 0; e < 8; ++e) { float sn, cs; sincos_rad(pos * inv[e], sn, cs); const float x1 = bfe(c1, e), x2 = bfe(c2, e); a[e] = (x1 * cs - x2 * sn) * sc; b[e] = (x1 * sn + x2 * cs) * sc; }
    o1 = (u32x4){cvtpk(a[0], a[1]), cvtpk(a[2], a[3]), cvtpk(a[4], a[5]), cvtpk(a[6], a[7])};
    o2 = (u32x4){cvtpk(b[0], b[1]), cvtpk(b[2], b[3]), cvtpk(b[4], b[5]), cvtpk(b[6], b[7])};
}
__device__ __forceinline__ void ret_kvc_item(const Params& P, int item, int lane) {
    const bf16_t* projt = (const bf16_t*)(P.ws + WS_PROJT); float* kvc = (float*)(P.ws + WS_KVC) + (size_t)item * 4096;
    const int h = item & 7, n = (item >> 3) & 63, b = item >> 9;
    const size_t t0 = (size_t)b * SEQ + n * 128;
    const float gamma = 1.0f - exp2f(-5.0f - (float)h), lg = log2f(gamma);
    const int f = lane & 31, hi = lane >> 5;
    const float invf = INV64[f];
    const bf16_t* kT0 = projt + (size_t)(PT_RK + h * 64 + f) * T + t0; const bf16_t* kT1 = kT0 + (size_t)32 * T;
    const bf16_t* vT = projt + (size_t)(PT_RV + h * 64 + f) * T + t0;
    f32x16 acc[2][2];
#pragma unroll
    for (int i = 0; i < 2; ++i)
#pragma unroll
        for (int j = 0; j < 2; ++j)
#pragma unroll
            for (int r = 0; r < 16; ++r) acc[i][j][r] = 0.f;
#pragma unroll 2
    for (int s = 0; s < 8; ++s) {
        const int j0 = 16 * s + 8 * hi;
        const u32x4 ka = *(const u32x4*)(kT0 + j0), kb = *(const u32x4*)(kT1 + j0);
        const u32x4 p0 = *(const u32x4*)(P.positions + t0 + j0), p1 = *(const u32x4*)(P.positions + t0 + j0 + 4);
        float c0[8], c1[8];
#pragma unroll
        for (int e = 0; e < 8; ++e) { const int pos = (int)(e < 4 ? p0[e] : p1[e - 4]); float sn, cs; sincos_rad((float)pos * invf, sn, cs);
            const float scj = 0.125f * __builtin_amdgcn_exp2f(-(float)(j0 + e) * lg); const float x1 = bfe(ka, e), x2 = bfe(kb, e);
            c0[e] = (x1 * cs - x2 * sn) * scj; c1[e] = (x1 * sn + x2 * cs) * scj; }
        const bf16x8 B0 = as_frag((u32x4){cvtpk(c0[0], c0[1]), cvtpk(c0[2], c0[3]), cvtpk(c0[4], c0[5]), cvtpk(c0[6], c0[7])});
        const bf16x8 B1 = as_frag((u32x4){cvtpk(c1[0], c1[1]), cvtpk(c1[2], c1[3]), cvtpk(c1[4], c1[5]), cvtpk(c1[6], c1[7])});
#pragma unroll
        for (int blk = 0; blk < 2; ++blk) { const bf16x8 A = *(const bf16x8*)(vT + (size_t)(32 * blk) * T + j0);
            acc[blk][0] = __builtin_amdgcn_mfma_f32_32x32x16_bf16(A, B0, acc[blk][0], 0, 0, 0); acc[blk][1] = __builtin_amdgcn_mfma_f32_32x32x16_bf16(A, B1, acc[blk][1], 0, 0, 0); }
    }
    const float g127 = __builtin_amdgcn_exp2f(127.0f * lg);
#pragma unroll
    for (int blk = 0; blk < 2; ++blk)
#pragma unroll
        for (int c = 0; c < 2; ++c)
#pragma unroll
            for (int r = 0; r < 16; ++r) kvc[(32 * blk + crow(r, hi)) * 64 + 32 * c + f] = acc[blk][c][r] * g127;
}
__device__ __forceinline__ void ret_scan(const Params& P, size_t gt, size_t nt) {
    float* kvc = (float*)(P.ws + WS_KVC);
    for (size_t i = gt; i < (size_t)NB * NH * 4096; i += nt) {
        const int e = (int)(i & 4095), h = (int)((i >> 12) & 7), b = (int)(i >> 15);
        const float gamma = 1.0f - exp2f(-5.0f - (float)h), decay = exp2f(128.0f * log2f(gamma));
        float st = 0.f;
        for (int n = 0; n < 64; ++n) { float* p = kvc + ((size_t)((b * 64 + n) * 8 + h)) * 4096 + e; const float v = *p; *p = st; st = st * decay + v; }
    }
}
__device__ __forceinline__ void ret_out_item(const Params& P, int item, int lane, LAS u32x4* wl) {
    const bf16_t* proj = (const bf16_t*)(P.ws + WS_PROJ); const bf16_t* projt = (const bf16_t*)(P.ws + WS_PROJT); const float* prev = (const float*)(P.ws + WS_KVC) + (size_t)item * 4096;
    bf16_t* Y = (bf16_t*)(P.ws + WS_XN);
    const int h = item & 7, n = (item >> 3) & 63, b = item >> 9;
    const size_t t0 = (size_t)b * SEQ + n * 128;
    const float gamma = 1.0f - exp2f(-5.0f - (float)h), lg = log2f(gamma);
    const int r32 = lane & 31, hi = lane >> 5;
    float invt[2][8];
#pragma unroll
    for (int s2 = 0; s2 < 2; ++s2)
#pragma unroll
        for (int e = 0; e < 8; ++e) invt[s2][e] = INV64[16 * s2 + 8 * hi + e];
#pragma unroll 1
    for (int jb = 0; jb < 4; ++jb) {
        const size_t tj = t0 + 32 * jb + r32; const float pos = (float)P.positions[tj]; const float scj = 0.125f * __builtin_amdgcn_exp2f(-(float)(32 * jb + r32) * lg);
        const bf16_t* row = proj + tj * PLD + PC_RK + h * 64 + 8 * hi;
        const u32x4 c0 = *(const u32x4*)(row), c1 = *(const u32x4*)(row + 16), c2 = *(const u32x4*)(row + 32), c3 = *(const u32x4*)(row + 48);
        u32x4 o0, o1, o2, o3; rope_pair(c0, c2, pos, invt[0], scj, o0, o2); rope_pair(c1, c3, pos, invt[1], scj, o1, o3);
        wl[(jb * 4 + 0) * 64 + lane] = o0; wl[(jb * 4 + 1) * 64 + lane] = o1; wl[(jb * 4 + 2) * 64 + lane] = o2; wl[(jb * 4 + 3) * 64 + lane] = o3;
    }
    bf16x8 pf[2][4];
#pragma unroll
    for (int blk = 0; blk < 2; ++blk)
#pragma unroll
        for (int s = 0; s < 4; ++s) { const float* pp = prev + (32 * blk + r32) * 64 + 16 * s + 8 * hi; const f32x4 a = *(const f32x4*)pp, c = *(const f32x4*)(pp + 4);
            pf[blk][s] = as_frag((u32x4){cvtpk(a.x, a.y), cvtpk(a.z, a.w), cvtpk(c.x, c.y), cvtpk(c.z, c.w)}); }
    const bf16_t* vT = projt + (size_t)(PT_RV + h * 64 + r32) * T + t0 + 4 * hi;
#pragma unroll 1
    for (int ib = 0; ib < 4; ++ib) {
        const size_t ti = t0 + 32 * ib + r32; const float pos = (float)P.positions[ti]; const float sci = __builtin_amdgcn_exp2f((float)(32 * ib + r32) * lg);
        const bf16_t* row = proj + ti * PLD + PC_RQ + h * 64 + 8 * hi;
        bf16x8 qf[4];
        { const u32x4 c0 = *(const u32x4*)(row), c1 = *(const u32x4*)(row + 16), c2 = *(const u32x4*)(row + 32), c3 = *(const u32x4*)(row + 48);
          u32x4 o0, o1, o2, o3; rope_pair(c0, c2, pos, invt[0], sci, o0, o2); rope_pair(c1, c3, pos, invt[1], sci, o1, o3);
          qf[0] = as_frag(o0); qf[1] = as_frag(o1); qf[2] = as_frag(o2); qf[3] = as_frag(o3); }
        f32x16 y[2];
#pragma unroll
        for (int blk = 0; blk < 2; ++blk) {
#pragma unroll
            for (int r = 0; r < 16; ++r) y[blk][r] = 0.f;
#pragma unroll
            for (int s = 0; s < 4; ++s) y[blk] = __builtin_amdgcn_mfma_f32_32x32x16_bf16(pf[blk][s], qf[s], y[blk], 0, 0, 0);
#pragma unroll
            for (int r = 0; r < 16; ++r) y[blk][r] *= gamma;
        }
        for (int jb = 0; jb <= ib; ++jb) {
            f32x16 st;
#pragma unroll
            for (int r = 0; r < 16; ++r) st[r] = 0.f;
#pragma unroll
            for (int s = 0; s < 4; ++s) { const u32x4 kf = wl[(jb * 4 + s) * 64 + lane]; st = __builtin_amdgcn_mfma_f32_32x32x16_bf16(as_frag(kf), qf[s], st, 0, 0, 0); }
            if (jb == ib) {
#pragma unroll
                for (int r = 0; r < 16; ++r) if (crow(r, hi) > r32) st[r] = 0.f;
            }
#pragma unroll
            for (int sp = 0; sp < 2; ++sp) {
                const bf16x8 pb = as_frag((u32x4){cvtpk(st[8 * sp], st[8 * sp + 1]), cvtpk(st[8 * sp + 2], st[8 * sp + 3]), cvtpk(st[8 * sp + 4], st[8 * sp + 5]), cvtpk(st[8 * sp + 6], st[8 * sp + 7])});
#pragma unroll
                for (int blk = 0; blk < 2; ++blk) { const bf16_t* vp = vT + (size_t)(32 * blk) * T + 32 * jb + 16 * sp;
                    const u32x2 lo = *(const u32x2*)vp, hh = *(const u32x2*)(vp + 8);
                    y[blk] = __builtin_amdgcn_mfma_f32_32x32x16_bf16(as_frag((u32x4){lo.x, lo.y, hh.x, hh.y}), pb, y[blk], 0, 0, 0); }
            }
        }
        float sum = 0.f;
#pragma unroll
        for (int blk = 0; blk < 2; ++blk)
#pragma unroll
            for (int r = 0; r < 16; ++r) sum += y[blk][r];
        sum += __shfl_xor(sum, 32); const float mu = sum * (1.f / 64.f);
        float var = 0.f;
#pragma unroll
        for (int blk = 0; blk < 2; ++blk)
#pragma unroll
            for (int r = 0; r < 16; ++r) { const float d = y[blk][r] - mu; var += d * d; }
        var += __shfl_xor(var, 32); const float rstd = 1.0f / sqrtf(var * (1.f / 64.f) + EPS);
#pragma unroll
        for (int blk = 0; blk < 2; ++blk)
#pragma unroll
            for (int g4 = 0; g4 < 4; ++g4) { const int dv0 = 32 * blk + 8 * g4 + 4 * hi;
                const u32x2 gt2 = *(const u32x2*)(proj + ti * PLD + PC_RG + h * 64 + dv0); const f32x4 gr = *(const f32x4*)(P.g_ret_norm + h * 64 + dv0);
                const float o0 = silu_f(bflo(gt2.x)) * (y[blk][4 * g4] - mu) * rstd * gr.x, o1 = silu_f(bfhi(gt2.x)) * (y[blk][4 * g4 + 1] - mu) * rstd * gr.y;
                const float o2 = silu_f(bflo(gt2.y)) * (y[blk][4 * g4 + 2] - mu) * rstd * gr.z, o3 = silu_f(bfhi(gt2.y)) * (y[blk][4 * g4 + 3] - mu) * rstd * gr.w;
                *(u32x2*)(Y + ti * D + 512 + h * 64 + dv0) = (u32x2){cvtpk(o0, o1), cvtpk(o2, o3)}; }
    }
}
constexpr int AT_KSTR = 104, AT_VSTR = 68;
constexpr int AT_KBYTES = 64 * AT_KSTR * 2, AT_VBYTES = 64 * AT_VSTR * 2, AT_BUF = AT_KBYTES + AT_VBYTES;
__device__ __forceinline__ void attn_unit(const Params& P, int b, int h, int qb, LAS unsigned char* lds, int tid) {
    const bf16_t* Q = (const bf16_t*)(P.ws + WS_Q); const bf16_t* KN = (const bf16_t*)(P.ws + WS_KN); const bf16_t* KR = (const bf16_t*)(P.ws + WS_KR);
    const bf16_t* VT = (const bf16_t*)(P.ws + WS_VT); bf16_t* Y = (bf16_t*)(P.ws + WS_XN);
    const int lane = tid & 63, wave = __builtin_amdgcn_readfirstlane(tid >> 6), r32 = lane & 31, hi = lane >> 5;
    const int qfirst = qb * 256 + wave * 32, qrow = qfirst + r32; const size_t tq = (size_t)b * SEQ + qrow;
    bf16x8 qf[6];
    { const bf16_t* qp = Q + tq * 768 + h * 96 + 8 * hi;
#pragma unroll
      for (int s = 0; s < 4; ++s) qf[s] = *(const bf16x8*)(qp + 16 * s);
      const u32x4 c4 = *(const u32x4*)(qp + 64), c5 = *(const u32x4*)(qp + 80);
      float inv[8];
#pragma unroll
      for (int e = 0; e < 8; ++e) inv[e] = INV64[2 * (8 * hi + e)];
      u32x4 o4, o5; rope_pair(c4, c5, (float)P.positions[tq], inv, 1.0f, o4, o5); qf[4] = as_frag(o4); qf[5] = as_frag(o5); }
    f32x16 o[2];
#pragma unroll
    for (int r = 0; r < 16; ++r) { o[0][r] = 0.f; o[1][r] = 0.f; }
    float m_run = -INFINITY, l_part = 0.f;
    const int ntiles = 4 * qb + 4;
    const int kr = tid >> 3, kc = tid & 7, rr = tid >> 2, rc = tid & 3;
    const bf16_t* ksrc = KN + ((size_t)b * SEQ + kr) * 512 + h * 64 + kc * 8;
    const bf16_t* rsrc = KR + ((size_t)b * SEQ + rr) * 32 + rc * 8;
    const bf16_t* vsrc = VT + (size_t)(h * 64 + kr) * T + (size_t)b * SEQ + kc * 8;
    const int kdst = (kr * AT_KSTR + kc * 8) * 2, rdst = (rr * AT_KSTR + 64 + rc * 8) * 2, vdst = AT_KBYTES + (kr * AT_VSTR + kc * 8) * 2;
    u32x4 sk, sr, sv;
    sk = *(const u32x4*)ksrc; if (tid < 256) sr = *(const u32x4*)rsrc; sv = *(const u32x4*)vsrc;
    *(LAS u32x4*)(lds + kdst) = sk; if (tid < 256) *(LAS u32x4*)(lds + rdst) = sr;
    *(LAS u32x2*)(lds + vdst) = (u32x2){sv.x, sv.y}; *(LAS u32x2*)(lds + vdst + 8) = (u32x2){sv.z, sv.w};
    __syncthreads();
    for (int t = 0; t < ntiles; ++t) {
        const bool more = (t + 1 < ntiles);
        if (more) { sk = *(const u32x4*)(ksrc + (size_t)(t + 1) * 64 * 512); if (tid < 256) sr = *(const u32x4*)(rsrc + (size_t)(t + 1) * 64 * 32); sv = *(const u32x4*)(vsrc + (t + 1) * 64); }
        if (64 * t <= qfirst + 31) {
            LAS unsigned char* Kb = lds + (t & 1) * AT_BUF; LAS unsigned char* Vb = Kb + AT_KBYTES;
            f32x16 st[2];
#pragma unroll
            for (int blk = 0; blk < 2; ++blk) {
#pragma unroll
                for (int r = 0; r < 16; ++r) st[blk][r] = 0.f;
#pragma unroll
                for (int s = 0; s < 6; ++s) { const bf16x8 kf = *(const LAS bf16x8*)(Kb + ((32 * blk + r32) * AT_KSTR + 16 * s + 8 * hi) * 2); st[blk] = __builtin_amdgcn_mfma_f32_32x32x16_bf16(kf, qf[s], st[blk], 0, 0, 0); }
            }
            if (64 * t + 63 > qfirst) {
#pragma unroll
                for (int blk = 0; blk < 2; ++blk)
#pragma unroll
                    for (int r = 0; r < 16; ++r) if (64 * t + 32 * blk + crow(r, hi) > qrow) st[blk][r] = -INFINITY;
            }
            float mx = fmaxf(st[0][0], st[1][0]);
#pragma unroll
            for (int r = 1; r < 16; ++r) mx = fmaxf(mx, fmaxf(st[0][r], st[1][r]));
            mx = fmaxf(mx, __shfl_xor(mx, 32));
            if (__any(mx > m_run + 8.0f)) { const float mn = fmaxf(m_run, mx), f = __builtin_amdgcn_exp2f(m_run - mn); l_part *= f;
#pragma unroll
                for (int r = 0; r < 16; ++r) { o[0][r] *= f; o[1][r] *= f; }
                m_run = mn; }
            float ps = 0.f;
#pragma unroll
            for (int blk = 0; blk < 2; ++blk)
#pragma unroll
                for (int r = 0; r < 16; ++r) { const float p = __builtin_amdgcn_exp2f(st[blk][r] - m_run); st[blk][r] = p; ps += p; }
            l_part += ps;
#pragma unroll
            for (int jb = 0; jb < 2; ++jb)
#pragma unroll
                for (int sp = 0; sp < 2; ++sp) {
                    const bf16x8 pb = as_frag((u32x4){cvtpk(st[jb][8 * sp], st[jb][8 * sp + 1]), cvtpk(st[jb][8 * sp + 2], st[jb][8 * sp + 3]), cvtpk(st[jb][8 * sp + 4], st[jb][8 * sp + 5]), cvtpk(st[jb][8 * sp + 6], st[jb][8 * sp + 7])});
#pragma unroll
                    for (int dblk = 0; dblk < 2; ++dblk) { const LAS unsigned char* vp = Vb + ((32 * dblk + r32) * AT_VSTR + 32 * jb + 16 * sp + 4 * hi) * 2;
                        const u32x2 lo = *(const LAS u32x2*)vp, hh = *(const LAS u32x2*)(vp + 16);
                        o[dblk] = __builtin_amdgcn_mfma_f32_32x32x16_bf16(as_frag((u32x4){lo.x, lo.y, hh.x, hh.y}), pb, o[dblk], 0, 0, 0); }
                }
        }
        if (more) { LAS unsigned char* nb = lds + ((t + 1) & 1) * AT_BUF;
            *(LAS u32x4*)(nb + kdst) = sk; if (tid < 256) *(LAS u32x4*)(nb + rdst) = sr;
            *(LAS u32x2*)(nb + vdst) = (u32x2){sv.x, sv.y}; *(LAS u32x2*)(nb + vdst + 8) = (u32x2){sv.z, sv.w}; }
        __syncthreads();
    }
    const float l = l_part + __shfl_xor(l_part, 32), il = 1.0f / l;
#pragma unroll
    for (int dblk = 0; dblk < 2; ++dblk)
#pragma unroll
        for (int g4 = 0; g4 < 4; ++g4) { const int dv0 = 32 * dblk + 8 * g4 + 4 * hi;
            *(u32x2*)(Y + tq * D + h * 64 + dv0) = (u32x2){cvtpk(o[dblk][4 * g4] * il, o[dblk][4 * g4 + 1] * il), cvtpk(o[dblk][4 * g4 + 2] * il, o[dblk][4 * g4 + 3] * il)}; }
}
__device__ __forceinline__ void attn_phase(const Params& P, LAS unsigned char* lds, int tid) {
    const int G = gridDim.x, bx = blockIdx.x;
    if (G == 256) { const int vcu = (bx & 7) * 32 + (bx >> 3), bh = vcu >> 3, s = vcu & 7;
#pragma unroll 1
        for (int i = 0; i < 4; ++i) { const int qb = (i == 0) ? s : (i == 1) ? 15 - s : (i == 2) ? 16 + s : 31 - s; attn_unit(P, bh >> 3, bh & 7, qb, lds, tid); }
    } else {
#pragma unroll 1
        for (int u = bx; u < 1024; u += G) attn_unit(P, u >> 8, (u >> 5) & 7, 31 - (u & 31), lds, tid);
    }
}
#define TOPK_INS(LV, LI, val, id) do { float cv_ = (val); int ci_ = (id); _Pragma("unroll") for (int i_ = 0; i_ < 16; ++i_) { const bool c_ = cv_ > LV[i_]; const float tv_ = c_ ? LV[i_] : cv_; const int ti_ = c_ ? LI[i_] : ci_; \
    LV[i_] = c_ ? cv_ : LV[i_]; LI[i_] = c_ ? ci_ : LI[i_]; cv_ = tv_; ci_ = ti_; } } while (0)
__device__ __forceinline__ void route_wave(const Params& P, int item, int lane) {
    const bf16_t* QP = (const bf16_t*)(P.ws + WS_PROJ); const bf16_t* SK = (const bf16_t*)(P.ws + WS_SK);
    int* eidx = (int*)(P.ws + WS_EIDX); float* gate = (float*)(P.ws + WS_GATE);
    const size_t pair = (size_t)item * 64 + lane; const size_t t = pair >> 3; const int h = (int)(pair & 7);
    float tv[2][16]; int ti[2][16];
#pragma unroll
    for (int p = 0; p < 2; ++p) {
#pragma unroll
        for (int i = 0; i < 16; ++i) { tv[p][i] = -INFINITY; ti[p][i] = 0; }
        float q[128];
#pragma unroll
        for (int d = 0; d < 128; d += 8) { const u32x4 w = *(const u32x4*)(QP + t * 2048 + h * 256 + p * 128 + d);
            q[d] = bflo(w.x); q[d + 1] = bfhi(w.x); q[d + 2] = bflo(w.y); q[d + 3] = bfhi(w.y); q[d + 4] = bflo(w.z); q[d + 5] = bfhi(w.z); q[d + 6] = bflo(w.w); q[d + 7] = bfhi(w.w); }
        for (int k = 0; k < 128; ++k) { float s = 0.f; const unsigned* skr = (const unsigned*)(SK + (size_t)(p * 128 + k) * 128);
#pragma unroll
            for (int d = 0; d < 64; ++d) { const unsigned w = skr[d]; s += q[2 * d] * bflo(w); s += q[2 * d + 1] * bfhi(w); }
            TOPK_INS(tv[p], ti[p], s, k); }
    }
    float best[16]; int bidx[16];
#pragma unroll
    for (int i = 0; i < 16; ++i) { best[i] = -INFINITY; bidx[i] = 0; }
#pragma unroll
    for (int i = 0; i < 16; ++i)
#pragma unroll
        for (int j = 0; j < 16; ++j) if ((i + 1) * (j + 1) <= 16) TOPK_INS(best, bidx, tv[0][i] + tv[1][j], ti[0][i] * 128 + ti[1][j]);
    float ssum = 0.f; float e[16];
#pragma unroll
    for (int r = 0; r < 16; ++r) { e[r] = __expf(best[r] - best[0]); ssum += e[r]; }
    const float inv = 1.f / ssum;
#pragma unroll
    for (int r = 0; r < 16; r += 4) { *(u32x4*)(eidx + t * 128 + h * 16 + r) = (u32x4){(unsigned)bidx[r], (unsigned)bidx[r + 1], (unsigned)bidx[r + 2], (unsigned)bidx[r + 3]};
        *(f32x4*)(gate + t * 128 + h * 16 + r) = (f32x4){e[r] * inv, e[r + 1] * inv, e[r + 2] * inv, e[r + 3] * inv}; }
}
__device__ __forceinline__ void gather_wave(const Params& P, size_t t, int lane) {
    const bf16_t* H2 = (const bf16_t*)(P.ws + WS_XN); const bf16_t* EU = (const bf16_t*)(P.ws + WS_EU); const bf16_t* EV = (const bf16_t*)(P.ws + WS_EV);
    const int* eidx = (const int*)(P.ws + WS_EIDX); const float* gate = (const float*)(P.ws + WS_GATE); const float* mod = (const float*)(P.ws + WS_MOD);
    const int b = (int)(t / SEQ);
    float hv[16];
    { const u32x4 a = *(const u32x4*)(H2 + t * D + lane * 16), c = *(const u32x4*)(H2 + t * D + lane * 16 + 8);
      hv[0] = bflo(a.x); hv[1] = bfhi(a.x); hv[2] = bflo(a.y); hv[3] = bfhi(a.y); hv[4] = bflo(a.z); hv[5] = bfhi(a.z); hv[6] = bflo(a.w); hv[7] = bfhi(a.w);
      hv[8] = bflo(c.x); hv[9] = bfhi(c.x); hv[10] = bflo(c.y); hv[11] = bfhi(c.y); hv[12] = bflo(c.z); hv[13] = bfhi(c.z); hv[14] = bflo(c.w); hv[15] = bfhi(c.w); }
    const int my_e0 = eidx[t * 128 + lane], my_e1 = eidx[t * 128 + 64 + lane];
    const float my_g0 = gate[t * 128 + lane], my_g1 = gate[t * 128 + 64 + lane];
    float w0 = 0.f, w1 = 0.f;
#pragma unroll 4
    for (int s = 0; s < 128; ++s) {
        const int e = __builtin_amdgcn_readlane(s < 64 ? my_e0 : my_e1, s & 63);
        const u32x4 a = *(const u32x4*)(EU + (size_t)e * D + lane * 16), c = *(const u32x4*)(EU + (size_t)e * D + lane * 16 + 8);
        float d = hv[0] * bflo(a.x) + hv[1] * bfhi(a.x); d += hv[2] * bflo(a.y) + hv[3] * bfhi(a.y); d += hv[4] * bflo(a.z) + hv[5] * bfhi(a.z); d += hv[6] * bflo(a.w) + hv[7] * bfhi(a.w);
        d += hv[8] * bflo(c.x) + hv[9] * bfhi(c.x); d += hv[10] * bflo(c.y) + hv[11] * bfhi(c.y); d += hv[12] * bflo(c.z) + hv[13] * bfhi(c.z); d += hv[14] * bflo(c.w) + hv[15] * bfhi(c.w);
        d = wave_sum(d);
        if (lane == (s & 63)) { if (s < 64) w0 = d; else w1 = d; }
    }
    w0 = my_g0 * gelu_exact(w0); w1 = my_g1 * gelu_exact(w1);
    float acc[16];
#pragma unroll
    for (int i = 0; i < 16; ++i) acc[i] = 0.f;
#pragma unroll 4
    for (int s = 0; s < 128; ++s) {
        const int e = __builtin_amdgcn_readlane(s < 64 ? my_e0 : my_e1, s & 63);
        const float ww = __builtin_bit_cast(float, __builtin_amdgcn_readlane(__builtin_bit_cast(int, s < 64 ? w0 : w1), s & 63));
        const u32x4 a = *(const u32x4*)(EV + (size_t)e * D + lane * 8), c = *(const u32x4*)(EV + (size_t)e * D + 512 + lane * 8);
        acc[0] += ww * bflo(a.x); acc[1] += ww * bfhi(a.x); acc[2] += ww * bflo(a.y); acc[3] += ww * bfhi(a.y); acc[4] += ww * bflo(a.z); acc[5] += ww * bfhi(a.z); acc[6] += ww * bflo(a.w); acc[7] += ww * bfhi(a.w);
        acc[8] += ww * bflo(c.x); acc[9] += ww * bfhi(c.x); acc[10] += ww * bflo(c.y); acc[11] += ww * bfhi(c.y); acc[12] += ww * bflo(c.z); acc[13] += ww * bfhi(c.z); acc[14] += ww * bflo(c.w); acc[15] += ww * bfhi(c.w);
    }
    float x3[16]; float ss = 0.f;
#pragma unroll
    for (int q = 0; q < 4; ++q) { const int col = (q >> 1) * 512 + lane * 8 + (q & 1) * 4;
        const f32x4 xv = *(const f32x4*)(P.out + t * D + col), gv = *(const f32x4*)(mod + (size_t)b * 6144 + 5 * D + col);
#pragma unroll
        for (int i = 0; i < 4; ++i) { const float v = xv[i] + gv[i] * acc[q * 4 + i]; x3[q * 4 + i] = v; ss += v * v; } }
    const float rstd = 1.0f / sqrtf(wave_sum(ss) * (1.f / D) + EPS);
#pragma unroll
    for (int q = 0; q < 4; ++q) { const int col = (q >> 1) * 512 + lane * 8 + (q & 1) * 4; const f32x4 gf = *(const f32x4*)(P.g_final + col);
        *(f32x4*)(P.out + t * D + col) = (f32x4){x3[q * 4] * rstd * gf.x, x3[q * 4 + 1] * rstd * gf.y, x3[q * 4 + 2] * rstd * gf.z, x3[q * 4 + 3] * rstd * gf.w}; }
}

namespace cg = cooperative_groups;
constexpr int LDS_BYTES = 147456;
struct KArgs { Params P; int ph_lo, ph_hi; };
__global__ void __launch_bounds__(512, 2) mk_fwd(KArgs ka) {
    extern __shared__ __attribute__((aligned(16))) unsigned char lds[];
    const Params& P = ka.P;
    cg::grid_group grid = cg::this_grid();
    PG8_LAS unsigned char* glds = (PG8_LAS unsigned char*)lds;
#define IDS() int tid_ = threadIdx.x; asm volatile("" : "+v"(tid_)); const int lane = tid_ & 63, wave = __builtin_amdgcn_readfirstlane(tid_ >> 6); \
    const int G = gridDim.x, gw = blockIdx.x * 8 + wave, nw = G * 8; const size_t gt = (size_t)blockIdx.x * 512 + tid_, nt = (size_t)G * 512; (void)lane; (void)gw; (void)nw; (void)gt; (void)nt;
#define IN(k) (ka.ph_lo <= (k) && (k) < ka.ph_hi)
#define SYNC(k) do { if (IN(k) && IN((k) + 1)) grid.sync(); } while (0)
#define WSP(T_, off) ((T_*)(P.ws + (off)))
    if (IN(0)) { IDS(); p0_prologue(P, gw, nw, lane, (float*)(lds + wave * 8448)); }
    SYNC(0);
    if (IN(1)) { IDS(); mod_final(P, gt, nt); rownorm_pass<true>(P, P.x, P.g_norm1, 0, 1, WSP(bf16_t, WS_XN), gw, nw, lane); }
    SYNC(1);
    if (IN(2)) {
        { pg8::Gemm g{WSP(const bf16_t, WS_XN), WSP(const bf16_t, WS_W1T), T, 2048, D, D, D}; pg8::StaticOrder S; S.init(T, 2048, gridDim.x, (int)blockIdx.x);
          epi::EpiStore<3> E{WSP(bf16_t, WS_PROJ), PLD, WSP(float, WS_SSQ), 0, 0.f}; pg8::gemm_phase<epi::EpiStore<3>, pg8::StaticOrder, true, true>(glds, g, S, E); }
        { pg8::Gemm g{WSP(const bf16_t, WS_W1TT), WSP(const bf16_t, WS_XN), 1024, T, D, D, D}; pg8::StaticOrder S; S.init(1024, T, gridDim.x, (int)blockIdx.x);
          epi::EpiStore<0> E{WSP(bf16_t, WS_PROJT), T, nullptr, 0, 0.f}; pg8::gemm_phase<epi::EpiStore<0>, pg8::StaticOrder, true, true>(glds, g, S, E); }
    }
    SYNC(2);
    if (IN(3)) {
        { pg8::Gemm g{WSP(const bf16_t, WS_PROJ) + PC_QL, WSP(const bf16_t, WS_WUQ), T, 768, 256, PLD, 256}; pg8::StaticOrder S; S.init(T, 768, gridDim.x, (int)blockIdx.x);
          epi::EpiStore<1> E{WSP(bf16_t, WS_Q), 768, WSP(float, WS_SSQ), 0, 1.f / 256.f}; pg8::gemm_phase<epi::EpiStore<1>, pg8::StaticOrder, true, true>(glds, g, S, E); }
        { pg8::Gemm g{WSP(const bf16_t, WS_PROJ) + PC_KVL, WSP(const bf16_t, WS_WK), T, 512, 256, PLD, 256}; pg8::StaticOrder S; S.init(T, 512, gridDim.x, (int)blockIdx.x);
          epi::EpiStore<1> E{WSP(bf16_t, WS_KN), 512, WSP(float, WS_SSQ), 1, 1.f / 128.f}; pg8::gemm_phase<epi::EpiStore<1>, pg8::StaticOrder, true, true>(glds, g, S, E); }
        { pg8::Gemm g{WSP(const bf16_t, WS_WV), WSP(const bf16_t, WS_PROJ) + PC_KVL, 512, T, 256, 256, PLD}; pg8::StaticOrder S; S.init(512, T, gridDim.x, (int)blockIdx.x);
          epi::EpiStore<2> E{WSP(bf16_t, WS_VT), T, WSP(float, WS_SSQ), 1, 1.f / 128.f}; pg8::gemm_phase<epi::EpiStore<2>, pg8::StaticOrder, true, true>(glds, g, S, E); }
        { IDS(); kr_pass(P, gt, nt); for (int i = gw; i < NB * 64 * NH; i += nw) ret_kvc_item(P, i, lane); }
    }
    SYNC(3);
    if (IN(4)) { IDS();
        ret_scan(P, gt, nt);
        __syncthreads();
        attn_phase(P, glds, tid_);
    }
    SYNC(4);
    if (IN(5)) { IDS(); for (int i = gw; i < NB * 64 * NH; i += nw) ret_out_item(P, i, lane, (LAS u32x4*)(glds + wave * 16384)); }
    SYNC(5);
    if (IN(6)) { pg8::Gemm g{WSP(const bf16_t, WS_XN), WSP(const bf16_t, WS_WOUT), T, D, D, D, D}; pg8::StaticOrder S; S.init(T, D, gridDim.x, (int)blockIdx.x);
        epi::EpiResid E{P.x, WSP(const float, WS_MOD), P.out}; pg8::gemm_phase<epi::EpiResid, pg8::StaticOrder, true, true>(glds, g, S, E); }
    SYNC(6);
    if (IN(7)) { IDS(); rownorm_pass<false>(P, P.out, P.g_norm2, 3, 4, WSP(bf16_t, WS_XN), gw, nw, lane); }
    SYNC(7);
    if (IN(8)) { pg8::Gemm g{WSP(const bf16_t, WS_XN), WSP(const bf16_t, WS_WQ), T, 2048, D, D, D}; pg8::StaticOrder S; S.init(T, 2048, gridDim.x, (int)blockIdx.x);
        epi::EpiStore<0> E{WSP(bf16_t, WS_PROJ), 2048, nullptr, 0, 0.f}; pg8::gemm_phase<epi::EpiStore<0>, pg8::StaticOrder, true, true>(glds, g, S, E); }
    SYNC(8);
    if (IN(9)) { IDS(); for (int i = gw; i < T * 8 / 64; i += nw) route_wave(P, i, lane); }
    SYNC(9);
    if (IN(10)) { IDS(); for (size_t t = gw; t < (size_t)T; t += nw) gather_wave(P, t, lane); }
#undef IN
#undef SYNC
#undef IDS
#undef WSP
}

extern "C" void kernel_launch(void* const* d_in, const int* in_sizes, int n_in, void* d_out, int out_size, void* d_ws, size_t ws_size, hipStream_t stream) {
    if (n_in != 19 || out_size != T * D || ws_size < WS_END) { fprintf(stderr, "kernel_launch: unexpected shapes (n_in %d out %d ws %zu)\n", n_in, out_size, ws_size); return; }
    static int grid = 0;
    if (grid == 0) {
        int dev = 0, cus = 0, per_cu = 0;
        if (hipGetDevice(&dev) != hipSuccess || hipDeviceGetAttribute(&cus, hipDeviceAttributeMultiprocessorCount, dev) != hipSuccess) { fprintf(stderr, "kernel_launch: device query failed\n"); grid = -1; return; }
        if (hipFuncSetAttribute((const void*)mk_fwd, hipFuncAttributeMaxDynamicSharedMemorySize, LDS_BYTES) != hipSuccess) { fprintf(stderr, "kernel_launch: hipFuncSetAttribute failed\n"); grid = -1; return; }
        if (hipOccupancyMaxActiveBlocksPerMultiprocessor(&per_cu, (const void*)mk_fwd, 512, LDS_BYTES) != hipSuccess || per_cu < 1) { fprintf(stderr, "kernel_launch: occupancy query failed (%d)\n", per_cu); (void)hipGetLastError(); per_cu = 1; }
        grid = cus * (per_cu > 1 ? 1 : per_cu);
    }
    if (grid < 0) return;
    KArgs ka{};
    Params& P = ka.P;
    P.x = (const float*)d_in[0]; P.c = (const float*)d_in[1]; P.positions = (const int*)d_in[2]; P.w_ada = (const float*)d_in[3]; P.b_ada = (const float*)d_in[4];
    P.g_norm1 = (const float*)d_in[5]; P.w_in = (const float*)d_in[6]; P.g_q_norm = (const float*)d_in[7]; P.w_uq = (const float*)d_in[8]; P.g_kv_norm = (const float*)d_in[9];
    P.w_ukv = (const float*)d_in[10]; P.g_ret_norm = (const float*)d_in[11]; P.w_out = (const float*)d_in[12]; P.g_norm2 = (const float*)d_in[13]; P.w_query = (const float*)d_in[14];
    P.sub_keys = (const float*)d_in[15]; P.expert_u = (const float*)d_in[16]; P.expert_v = (const float*)d_in[17]; P.g_final = (const float*)d_in[18];
    P.out = (float*)d_out; P.ws = (unsigned char*)d_ws;
    ka.ph_lo = 0; ka.ph_hi = 11;
    void* args[] = {&ka};
    const hipError_t e = hipLaunchCooperativeKernel((const void*)mk_fwd, dim3(grid), dim3(512), args, LDS_BYTES, stream);
    if (e != hipSuccess) fprintf(stderr, "kernel_launch: cooperative launch failed: %s (grid %d)\n", hipGetErrorString(e), grid);
}
```

```cpp
#include <hip/hip_runtime.h>
#include <hip/hip_cooperative_groups.h>
#include <cstdint>
#include <cstdio>

#define PROBE_MASK 0u
#define PROBE_CLK 0
#define PROBE_MULT 1
#define PROBE_SEC 0
typedef unsigned short bf16_t;
typedef float f32x4 __attribute__((ext_vector_type(4)));
typedef unsigned u32x4 __attribute__((ext_vector_type(4)));
typedef unsigned u32x2 __attribute__((ext_vector_type(2)));
typedef float f32x2 __attribute__((ext_vector_type(2)));
typedef _Float16 h2_t __attribute__((ext_vector_type(2)));

constexpr int NB = 4, SEQ = 8192, T = NB * SEQ, D = 1024;
constexpr int IN_COLS = 2464;
constexpr int NH = 8;
constexpr int QK = 96, NOPE = 64, ROPE = 32, DV = 64;
constexpr int QR = 256, KVR = 128;
constexpr int NEXP = 16384, PK = 16, NKEYS = 128;
constexpr float EPS = 1e-6f;
constexpr float LOG2E = 1.4426950408889634f;
constexpr float QSCALE = 0.10206207261596575f * LOG2E;

constexpr size_t MiB = 1u << 20;
constexpr size_t WS_CTL = 0;
constexpr size_t WS_MOD = 3 * MiB - 128 * 1024;
constexpr size_t WS_SSQ = 3 * MiB;
constexpr size_t WS_W1T = 4 * MiB;
constexpr size_t WS_W1TT = 8 * MiB;
constexpr size_t WS_WUQ = 10 * MiB;
constexpr size_t WS_WK = 10 * MiB + 512 * 1024;
constexpr size_t WS_WV = 10 * MiB + 768 * 1024;
constexpr size_t WS_WOUT = 11 * MiB;
constexpr size_t WS_WQ = 13 * MiB;
constexpr size_t WS_SK = 17 * MiB;
constexpr size_t WS_EU8 = 18 * MiB;
constexpr size_t WS_EV8 = 34 * MiB;
constexpr size_t WS_SUI = 50 * MiB;
constexpr size_t WS_SVI = 50 * MiB + 65536;
constexpr size_t WS_XN = 82 * MiB;
constexpr size_t WS_PROJ = 146 * MiB;
constexpr size_t WS_PROJT = 274 * MiB;
constexpr size_t WS_Q = 338 * MiB;
constexpr size_t WS_KN = 386 * MiB;
constexpr size_t WS_KR = 418 * MiB;
constexpr size_t WS_VT = 420 * MiB;
constexpr size_t WS_KVC = 452 * MiB;
constexpr size_t WS_END = 484 * MiB;
constexpr size_t WS_PREVB = WS_PROJT + 32 * MiB;
constexpr size_t WS_EIDX = WS_PROJT;
constexpr size_t WS_GATE = WS_PROJT + 16 * MiB;
constexpr size_t WS_H2Q = WS_Q;
constexpr size_t WS_PEER = WS_Q;
constexpr size_t WS_X2B = WS_VT;
constexpr size_t WS_APART = WS_PROJ;

constexpr int PC_QL = 0, PC_KVL = 256, PC_KR = 384, PC_RQ = 512, PC_RK = 1024, PC_RG = 1536, PLD = 2048;
constexpr int PT_RV = 0;

__constant__ float INV64[32] = {1.0f, 0.749894261f, 0.562341332f, 0.421696514f, 0.316227764f, 0.237137377f, 0.177827939f, 0.133352131f, 0.100000001f, 0.0749894157f, 0.0562341325f, 0.0421696529f, 0.0316227749f, 0.0237137377f, 0.0177827943f, 0.0133352149f, 0.00999999978f, 0.00749894185f, 0.00562341325f, 0.00421696482f, 0.00316227763f, 0.00237137359f, 0.00177827943f, 0.00133352145f, 0.00100000005f, 0.000749894243f, 0.000562341302f, 0.000421696517f, 0.000316227757f, 0.00023713737f, 0.00017782794f, 0.00013335215f};

struct Params {
    const float *x, *c; const int* positions; const float *w_ada, *b_ada, *g_norm1, *w_in, *g_q_norm, *w_uq, *g_kv_norm, *w_ukv, *g_ret_norm, *w_out, *g_norm2, *w_query, *sub_keys, *expert_u, *expert_v, *g_final;
    float* out; unsigned char* ws;
};

__device__ __forceinline__ unsigned f2bf(float f) { unsigned u = __builtin_bit_cast(unsigned, f); return (u + 0x7fffu + ((u >> 16) & 1u)) >> 16; }
__device__ __forceinline__ unsigned pk2(float lo, float hi) { return f2bf(lo) | (f2bf(hi) << 16); }
__device__ __forceinline__ float bf2f(unsigned short b) { return __builtin_bit_cast(float, (unsigned)b << 16); }
__device__ __forceinline__ float bflo(unsigned w) { return __builtin_bit_cast(float, w << 16); }
__device__ __forceinline__ float bfhi(unsigned w) { return __builtin_bit_cast(float, w & 0xffff0000u); }
__device__ __forceinline__ float wave_sum(float v) {
#pragma unroll
    for (int o = 1; o < 64; o <<= 1) v += __shfl_xor(v, o);
    return v;
}
__device__ __forceinline__ float silu_f(float v) { return v / (1.f + __expf(-v)); }
__device__ __forceinline__ void sincos_rad(float ang, float& s, float& c) {
    const float CH = 0.15915494f, CL = 3.0918913e-09f;
    const float rh = ang * CH, rl = __builtin_fmaf(ang, CH, -rh) + ang * CL;
    const float fr = (rh - __builtin_floorf(rh)) + rl;
    s = __builtin_amdgcn_sinf(fr); c = __builtin_amdgcn_cosf(fr);
}
__device__ __forceinline__ float gelu_exact(float v) { return 0.5f * v * (1.f + erff(v * 0.70710678118654752f)); }

__device__ __forceinline__ void p0_mod_block(const Params& P, int nc, int wave, int lane, int tid, float* scr) {
    const int n = nc * 256 + lane * 4, k0 = wave * 128;
    float sl[2][4];
#pragma unroll
    for (int hf = 0; hf < 2; ++hf)
#pragma unroll
        for (int b = 0; b < 4; ++b) sl[hf][b] = silu_f(P.c[b * D + k0 + 64 * hf + lane]);
    f32x4 acc[4] = {};
#pragma unroll
    for (int hf = 0; hf < 2; ++hf) {
#pragma unroll 1
        for (int kk0 = 0; kk0 < 64; kk0 += 16) {
            f32x4 w[16];
#pragma unroll
            for (int j = 0; j < 16; ++j) w[j] = *(const f32x4*)(P.w_ada + (size_t)(k0 + 64 * hf + kk0 + j) * 6144 + n);
#pragma unroll
            for (int j = 0; j < 16; ++j)
#pragma unroll
                for (int b = 0; b < 4; ++b) { const float sb = __builtin_bit_cast(float, __builtin_amdgcn_readlane(__builtin_bit_cast(int, sl[hf][b]), kk0 + j)); acc[b] += w[j] * sb; }
        }
    }
#pragma unroll
    for (int b = 0; b < 4; ++b) *(f32x4*)(scr + (wave * 4 + b) * 256 + lane * 4) = acc[b];
    __syncthreads();
    float* mod = (float*)(P.ws + WS_MOD);
    for (int o = tid; o < 1024; o += 512) { const int b = o >> 8, c = o & 255; float sum = P.b_ada[nc * 256 + c];
#pragma unroll
        for (int w = 0; w < 8; ++w) sum += scr[(w * 4 + b) * 256 + c];
        mod[(size_t)b * 6144 + nc * 256 + c] = sum; }
    __syncthreads();
}
__device__ __forceinline__ void p0_transpose_block(const float* W, int ldw, int k0, int n0, bf16_t* dst, int row0, int ldd, const float* kscale, float scale, float* scr, int lane) {
#pragma unroll 8
    for (int i = 0; i < 32; ++i) { const int kk = 2 * i + (lane >> 5); const float ks = kscale ? kscale[k0 + kk] * scale : scale;
        scr[kk * 33 + (lane & 31)] = W[(size_t)(k0 + kk) * ldw + n0 + (lane & 31)] * ks; }
    asm volatile("s_waitcnt vmcnt(0) lgkmcnt(0)" ::: "memory");
    const int c = lane & 7;
#pragma unroll
    for (int j = 0; j < 4; ++j) { const int n = (lane >> 3) + 8 * j; const float* s = scr + (8 * c) * 33 + n;
        u32x4 o; o.x = pk2(s[0 * 33], s[1 * 33]); o.y = pk2(s[2 * 33], s[3 * 33]); o.z = pk2(s[4 * 33], s[5 * 33]); o.w = pk2(s[6 * 33], s[7 * 33]);
        *(u32x4*)(dst + (size_t)(row0 + n) * ldd + k0 + 8 * c) = o; }
    asm volatile("s_waitcnt vmcnt(0) lgkmcnt(0)" ::: "memory");
}
__device__ __forceinline__ void cvt8(const float* src, bf16_t* dst, size_t n8, size_t gt, size_t nt) {
    for (size_t i = gt; i < n8; i += nt) { const f32x4 a = *(const f32x4*)(src + i * 8), b = *(const f32x4*)(src + i * 8 + 4);
        u32x4 o; o.x = pk2(a.x, a.y); o.y = pk2(a.z, a.w); o.z = pk2(b.x, b.y); o.w = pk2(b.z, b.w); *(u32x4*)(dst + i * 8) = o; }
}
__device__ __forceinline__ float wave_max(float v) {
#pragma unroll
    for (int o = 1; o < 64; o <<= 1) v = fmaxf(v, __shfl_xor(v, o));
    return v;
}
__device__ __forceinline__ unsigned pk_fp8x4(float a, float b, float c, float d) { int w = __builtin_amdgcn_cvt_pk_fp8_f32(a, b, 0, false); w = __builtin_amdgcn_cvt_pk_fp8_f32(c, d, w, true); return (unsigned)w; }
__device__ __forceinline__ void p0_expert_fp8(const Params& P, int gw, int nw, int lane) {
    f32x4 n0, n1, n2, n3;
    if (gw < 2 * NEXP) { const float* src = (gw >= NEXP ? P.expert_v + (size_t)(gw - NEXP) * D : P.expert_u + (size_t)gw * D) + lane * 16;
        n0 = *(const f32x4*)src; n1 = *(const f32x4*)(src + 4); n2 = *(const f32x4*)(src + 8); n3 = *(const f32x4*)(src + 12); }
    for (int row = gw; row < 2 * NEXP; row += nw) {
        const bool isv = row >= NEXP; const int e = isv ? row - NEXP : row;
        const f32x4 v0 = n0, v1 = n1, v2 = n2, v3 = n3;
        { const int nr = row + nw < 2 * NEXP ? row + nw : row; const float* src = (nr >= NEXP ? P.expert_v + (size_t)(nr - NEXP) * D : P.expert_u + (size_t)nr * D) + lane * 16;
          n0 = *(const f32x4*)src; n1 = *(const f32x4*)(src + 4); n2 = *(const f32x4*)(src + 8); n3 = *(const f32x4*)(src + 12); }
        float am = fmaxf(fmaxf(fmaxf(fabsf(v0.x), fabsf(v0.y)), fmaxf(fabsf(v0.z), fabsf(v0.w))), fmaxf(fmaxf(fabsf(v1.x), fabsf(v1.y)), fmaxf(fabsf(v1.z), fabsf(v1.w))));
        am = fmaxf(am, fmaxf(fmaxf(fmaxf(fabsf(v2.x), fabsf(v2.y)), fmaxf(fabsf(v2.z), fabsf(v2.w))), fmaxf(fmaxf(fabsf(v3.x), fabsf(v3.y)), fmaxf(fabsf(v3.z), fabsf(v3.w)))));
        am = wave_max(am);
        const int be = (int)((__builtin_bit_cast(unsigned, am) >> 23) & 255u);
        float sc = 1.f, sci = 1.f;
        if (be >= 8 && be <= 250) { sc = __builtin_bit_cast(float, (unsigned)(261 - be) << 23); sci = __builtin_bit_cast(float, (unsigned)(be - 7) << 23); }
        u32x4 o; o.x = pk_fp8x4(v0.x * sc, v0.y * sc, v0.z * sc, v0.w * sc); o.y = pk_fp8x4(v1.x * sc, v1.y * sc, v1.z * sc, v1.w * sc);
        o.z = pk_fp8x4(v2.x * sc, v2.y * sc, v2.z * sc, v2.w * sc); o.w = pk_fp8x4(v3.x * sc, v3.y * sc, v3.z * sc, v3.w * sc);
        *(u32x4*)(P.ws + (isv ? WS_EV8 : WS_EU8) + ((size_t)(lane >> 3) * NEXP + e) * 128 + (lane & 7) * 16) = o;
        if (lane == 0) ((float*)(P.ws + (isv ? WS_SVI : WS_SUI)))[e] = sci;
    }
}
constexpr int IT_WIN = 16 * 77, IT_WUQ = 4 * 24, IT_WUKV = 2 * 32, IT_WOUT = 16 * 32, IT_WQ = 16 * 64;
constexpr int IT_TOTAL = IT_WIN + IT_WUQ + IT_WUKV + IT_WOUT + IT_WQ;
__device__ __forceinline__ void p0_prologue(const Params& P, int gw, int nw, int lane, float* scr) {
    unsigned char* ws = P.ws;
    for (int it = gw, rnd = 0; it < IT_TOTAL; it = (++rnd) * nw + (nw - 1 - gw)) {
        int r = it;
        if (r < IT_WIN) { const int kb = r / 77, nb = r % 77, n0 = nb * 32, k0 = kb * 64;
            bf16_t* w1t = (bf16_t*)(ws + WS_W1T); bf16_t* w1tt = (bf16_t*)(ws + WS_W1TT);
            if (n0 < 416) p0_transpose_block(P.w_in, IN_COLS, k0, n0, w1t, n0, D, nullptr, 1.f, scr, lane);
            else if (n0 < 928) p0_transpose_block(P.w_in, IN_COLS, k0, n0, w1t, PC_RQ + (n0 - 416), D, nullptr, 1.f, scr, lane);
            else if (n0 < 1440) p0_transpose_block(P.w_in, IN_COLS, k0, n0, w1t, PC_RK + (n0 - 928), D, nullptr, 1.f, scr, lane);
            else if (n0 < 1952) p0_transpose_block(P.w_in, IN_COLS, k0, n0, w1tt, PT_RV + (n0 - 1440), D, nullptr, 1.f, scr, lane);
            else p0_transpose_block(P.w_in, IN_COLS, k0, n0, w1t, PC_RG + (n0 - 1952), D, nullptr, 1.f, scr, lane);
            continue; } r -= IT_WIN;
        if (r < IT_WUQ) { const int kb = r / 24, nb = r % 24; p0_transpose_block(P.w_uq, 768, kb * 64, nb * 32, (bf16_t*)(ws + WS_WUQ), nb * 32, 256, P.g_q_norm, QSCALE, scr, lane); continue; } r -= IT_WUQ;
        if (r < IT_WUKV) { const int kb = r / 32, nb = r % 32, n0 = nb * 32, h = n0 >> 7, rr = n0 & 127;
            if (rr < 64) p0_transpose_block(P.w_ukv, 1024, kb * 64, n0, (bf16_t*)(ws + WS_WK), h * 64 + rr, 256, P.g_kv_norm, 1.f, scr, lane);
            else p0_transpose_block(P.w_ukv, 1024, kb * 64, n0, (bf16_t*)(ws + WS_WV), h * 64 + rr - 64, 256, P.g_kv_norm, 1.f, scr, lane);
            continue; } r -= IT_WUKV;
        if (r < IT_WOUT) { const int kb = r / 32, nb = r % 32; p0_transpose_block(P.w_out, 1024, kb * 64, nb * 32, (bf16_t*)(ws + WS_WOUT), nb * 32, 1024, nullptr, 1.f, scr, lane); continue; } r -= IT_WOUT;
        { const int kb = r / 64, nb = r % 64; p0_transpose_block(P.w_query, 2048, kb * 64, nb * 32, (bf16_t*)(ws + WS_WQ), nb * 32, 1024, nullptr, 1.f, scr, lane); }
    }
    const size_t gt = (size_t)gw * 64 + lane, nt = (size_t)nw * 64;
    { u32x4 z = {0u, 0u, 0u, 0u};
      for (size_t i = gt; i < 96 * 1024 / 8; i += nt) *(u32x4*)((bf16_t*)(ws + WS_W1T) + (size_t)416 * 1024 + i * 8) = z;
      for (size_t i = gt; i < 2 * 512 * 16; i += nt) { const size_t m = i / (512 * 16), rr = (i / 16) % 512, cc = i % 16; *(u32x4*)((bf16_t*)(ws + (m ? WS_WV : WS_WK)) + rr * 256 + 128 + cc * 8) = z; }
    }
    cvt8(P.sub_keys, (bf16_t*)(ws + WS_SK), 2 * 128 * 128 / 8, gt, nt);
    p0_expert_fp8(P, gw, nw, lane);
}

template <bool FROM_PART, bool WRITE_Q, bool SRC_BF16> __device__ __forceinline__ void rownorm_pass(const Params& P, const void* srcv, const float* g, int seg_sh, int seg_sc, bf16_t* dst, int gw, int nw, int lane) {
    const float* src = (const float*)srcv; const bf16_t* srcb = (const bf16_t*)srcv;
    auto ldrow = [&](int row, f32x4 (&o)[4]) { if (SRC_BF16) { const u32x2* p = (const u32x2*)(srcb + (size_t)row * D) + lane;
#pragma unroll
            for (int j = 0; j < 4; ++j) { const u32x2 w = p[64 * j]; o[j] = (f32x4){bflo(w.x), bfhi(w.x), bflo(w.y), bfhi(w.y)}; } }
        else { const f32x4* p = (const f32x4*)(src + (size_t)row * D) + lane;
#pragma unroll
            for (int j = 0; j < 4; ++j) o[j] = p[64 * j]; } };
    const float* mod = (const float*)(P.ws + WS_MOD);
    for (int r0 = gw * 16; r0 < T; r0 += nw * 16) {
        const int b = r0 / SEQ;
        f32x4 mul[4], add[4];
#pragma unroll
        for (int j = 0; j < 4; ++j) {
            const int col = lane * 4 + 256 * j;
            f32x4 sc, sh;
            { sc = *(const f32x4*)(mod + (size_t)b * 6144 + seg_sc * D + col); sh = *(const f32x4*)(mod + (size_t)b * 6144 + seg_sh * D + col); }
            const f32x4 gg = *(const f32x4*)(g + col);
            mul[j] = gg * (sc + 1.0f); add[j] = sh;
        }
        f32x4 vn[4];
        ldrow(r0, vn);
        for (int rr = 0; rr < 16; ++rr) {
            const int row = r0 + rr;
            f32x4 v[4]; float s = 0.f;
#pragma unroll
            for (int j = 0; j < 4; ++j) v[j] = vn[j];
            ldrow(rr < 15 ? row + 1 : row, vn);
#pragma unroll
            for (int j = 0; j < 4; ++j) s += (v[j].x * v[j].x + v[j].y * v[j].y) + (v[j].z * v[j].z + v[j].w * v[j].w);
            const float rstd = 1.0f / sqrtf(wave_sum(s) * (1.f / D) + EPS);
            u32x2* o = (u32x2*)(dst + (size_t)row * D) + lane;
#pragma unroll
            for (int j = 0; j < 4; ++j) { const f32x4 y = v[j] * rstd * mul[j] + add[j]; u32x2 w; w.x = pk2(y.x, y.y); w.y = pk2(y.z, y.w); o[64 * j] = w;
                if (WRITE_Q) { const unsigned hq = pk_fp8x4(y.x, y.y, y.z, y.w); const f32x2 f01 = __builtin_amdgcn_cvt_pk_f32_fp8((int)hq, false), f23 = __builtin_amdgcn_cvt_pk_f32_fp8((int)hq, true);
                    const unsigned lq = pk_fp8x4(16.f * (y.x - f01.x), 16.f * (y.y - f01.y), 16.f * (y.z - f23.x), 16.f * (y.w - f23.y));
                    unsigned* q = (unsigned*)(P.ws + WS_H2Q + (size_t)row * 2048) + (lane ^ ((lane >> 2) & 2)) + 64 * j; q[0] = hq; q[256] = lq; } }
        }
    }
}
__device__ __forceinline__ void kr_pass(const Params& P, size_t gt, size_t nt) {
    const bf16_t* proj = (const bf16_t*)(P.ws + WS_PROJ); bf16_t* kr = (bf16_t*)(P.ws + WS_KR);
    for (size_t i = gt; i < (size_t)T * 16; i += nt) {
        const int t = (int)(i >> 4), f = (int)(i & 15);
        const float x1 = bf2f(proj[(size_t)t * PLD + PC_KR + f]), x2 = bf2f(proj[(size_t)t * PLD + PC_KR + 16 + f]);
        float s, c; sincos_rad((float)P.positions[t] * INV64[2 * f], s, c);
        kr[(size_t)t * 32 + f] = (bf16_t)f2bf(x1 * c - x2 * s); kr[(size_t)t * 32 + 16 + f] = (bf16_t)f2bf(x1 * s + x2 * c);
    }
}

namespace pg8 {
#define PG8_LAS __attribute__((address_space(3)))
typedef unsigned short bf16_t;
typedef short bf16x8 __attribute__((ext_vector_type(8)));
typedef float f32x4 __attribute__((ext_vector_type(4)));
typedef unsigned u32x4 __attribute__((ext_vector_type(4)));
constexpr int BM = 256, BK = 64, HALF = 128, HTB = HALF * BK * 2  , STAGE_BYTES = 8 * HTB, NXCD = 8, WGM = 8;

__host__ __device__ __forceinline__ int lds_byte(int r, int c) { const int st = (r >> 4) * 2 + (c >> 5), rr = r & 15, cc = c & 31, ob = rr * 64 + cc * 2; return st * 1024 + (ob ^ (((ob >> 9) & 1) << 5)); }
__host__ __device__ __forceinline__ void stage_rc(int b, int& R, int& C) { const int st = b / 1024, sb = b % 1024, swz = sb ^ (((sb >> 9) & 1) << 5); R = (st >> 1) * 16 + swz / 64; C = (st & 1) * 32 + (swz % 64) / 2; }
__host__ __device__ __forceinline__ int perm32(int rho) { const int n = rho >> 4, i = rho & 15; return 8 * (i >> 2) + 4 * n + (i & 3); }

struct Unit { int pm, pn; };
struct Gemm { const bf16_t* A; const bf16_t* Bt; int M, N, K, lda, ldb; };

struct StaticOrder {
    int nM, nN, nwg, G, c;
    __host__ __device__ void init(int M, int N, int G_, int c_) { nM = M / BM; nN = N / BM; nwg = nM * nN; G = G_; c = c_; }
    __host__ __device__ bool next(int i, Unit& u) const {
        const long L = (long)i * G + c; if (L >= nwg) return false;
        int wgid = (int)L; { const int q = nwg / NXCD, r = nwg % NXCD, xcd = wgid % NXCD, off = wgid / NXCD; wgid = (xcd < r ? xcd * (q + 1) : r * (q + 1) + (xcd - r) * q) + off; }
        const int nig = WGM * nN, gid = wgid / nig, fm = gid * WGM, gsz = (nM - fm) < WGM ? (nM - fm) : WGM;
        u.pm = fm + ((wgid % nig) % gsz); u.pn = (wgid % nig) / gsz; return true;
    }
    __device__ __forceinline__ void a_ready(const Unit&) const {}
    __device__ __forceinline__ void done(const Unit&) const {}
};


template <class Epi, class Sched, bool ALIGN_EPI = false, bool SP2 = false>
__device__ __forceinline__ void gemm_phase(PG8_LAS unsigned char* lds, const Gemm g, const Sched& S, const Epi& E) {
    int tid = threadIdx.x; asm volatile("" : "+v"(tid));
    const int wid = __builtin_amdgcn_readfirstlane(tid >> 6), lane = tid & 63, wr = wid >> 2, wc = wid & 3, fr = lane & 15, fq = lane >> 4;
    const int K = g.K, nt = K / BK;
    unsigned voffA[2], voffB[2];
#pragma unroll
    for (int i = 0; i < 2; ++i) { int R, C; stage_rc(tid * 16 + i * 8192, R, C); const int Rb = Epi::PERM ? ((R & ~31) + perm32(R & 31)) : R;
        voffA[i] = (unsigned)(R * g.lda + C) * 2u; voffB[i] = (unsigned)(Rb * g.ldb + C) * 2u; }
    const size_t kstep = (size_t)(BK * 2);
    const size_t hstepA = (size_t)HALF * g.lda * 2, hstepB = (size_t)HALF * g.ldb * 2;
    const size_t tstepA = 2 * hstepA, tstepB = 2 * hstepB;
    const unsigned ldsw = (unsigned)wid * 1024u;
    const int aoff = lds_byte(wr * 64 + fr, fq * 8), boff = lds_byte(wc * 32 + fr, fq * 8);
#define PG8_SA(b, h) (((b) * 2 + (h)) * HTB)
#define PG8_SB(b, h) ((4 + (b) * 2 + (h)) * HTB)
#define PG8_STAGE(bufoff, gbase, voff) do { _Pragma("unroll") for (int _i = 0; _i < 2; ++_i) \
        __builtin_amdgcn_global_load_lds((const unsigned*)((const char*)(gbase) + (voff)[_i]), (PG8_LAS unsigned*)(lds + (bufoff) + ldsw + _i * 8192), 16, 0, 0); } while (0)
#define PG8_LDA(dst, b, h) do { _Pragma("unroll") for (int m = 0; m < 4; ++m) _Pragma("unroll") for (int k = 0; k < 2; ++k) dst[m][k] = *(const PG8_LAS bf16x8*)(lds + PG8_SA(b, h) + aoff + m * 2048 + k * 1024); } while (0)
#define PG8_LDB(dst, b, h) do { _Pragma("unroll") for (int n = 0; n < 2; ++n) _Pragma("unroll") for (int k = 0; k < 2; ++k) dst[n][k] = *(const PG8_LAS bf16x8*)(lds + PG8_SB(b, h) + boff + n * 2048 + k * 1024); } while (0)
#define PG8_MMA(ai, bj, At, Bt) do { __builtin_amdgcn_s_setprio(1); _Pragma("unroll") for (int m = 0; m < 4; ++m) _Pragma("unroll") for (int n = 0; n < 2; ++n) _Pragma("unroll") for (int k = 0; k < 2; ++k) \
        acc[ai][bj][m][n] = __builtin_amdgcn_mfma_f32_16x16x32_bf16(Bt[n][k], At[m][k], acc[ai][bj][m][n], 0, 0, 0); __builtin_amdgcn_s_setprio(0); } while (0)
#define PG8_WAIT_V(n) asm volatile("s_waitcnt vmcnt(" #n ")" ::: "memory")
#define PG8_WAIT_L(n) asm volatile("s_waitcnt lgkmcnt(" #n ")" ::: "memory")
#define PG8_BAR __builtin_amdgcn_s_barrier()
#define PG8_SCHED __builtin_amdgcn_sched_barrier(0)
    Unit cur, nxt; int ui = 0;
    if (!S.next(0, cur)) return;
    f32x4 acc[2][2][4][2];
#pragma unroll
    for (int a = 0; a < 2; ++a)
#pragma unroll
        for (int b = 0; b < 2; ++b)
#pragma unroll
            for (int m = 0; m < 4; ++m)
#pragma unroll
                for (int n = 0; n < 2; ++n) acc[a][b][m][n] = (f32x4){0.f, 0.f, 0.f, 0.f};
    bf16x8 At[4][2], B0[2][2], B1[2][2];
    const char* cA = (const char*)g.A + (size_t)cur.pm * tstepA; const char* cB = (const char*)g.Bt + (size_t)cur.pn * tstepB;
    S.a_ready(cur);
    if constexpr (SP2) {
        PG8_STAGE(PG8_SB(0, 0), cB, voffB); PG8_STAGE(PG8_SB(0, 1), cB + hstepB, voffB); PG8_STAGE(PG8_SA(0, 0), cA, voffA); PG8_STAGE(PG8_SA(0, 1), cA + hstepA, voffA);
        if (wr == 1) PG8_BAR;
        PG8_WAIT_V(2); PG8_BAR;
        PG8_STAGE(PG8_SB(1, 0), cB + kstep, voffB); PG8_STAGE(PG8_SA(1, 0), cA + kstep, voffA); PG8_STAGE(PG8_SB(1, 1), cB + hstepB + kstep, voffB);
        PG8_WAIT_V(6); PG8_BAR;
    } else {
        PG8_STAGE(PG8_SB(0, 0), cB, voffB); PG8_STAGE(PG8_SA(0, 0), cA, voffA); PG8_STAGE(PG8_SB(0, 1), cB + hstepB, voffB); PG8_STAGE(PG8_SA(0, 1), cA + hstepA, voffA);
        if (wr == 1) PG8_BAR;
        PG8_WAIT_V(4); PG8_BAR;
        PG8_STAGE(PG8_SB(1, 0), cB + kstep, voffB); PG8_STAGE(PG8_SA(1, 0), cA + kstep, voffA); PG8_STAGE(PG8_SB(1, 1), cB + hstepB + kstep, voffB);
        PG8_WAIT_V(6); PG8_BAR;
    }
    for (;;) {
        const bool has_next = S.next(ui + 1, nxt);
        const char* nA = has_next ? (const char*)g.A + (size_t)nxt.pm * tstepA : cA; const char* nB = has_next ? (const char*)g.Bt + (size_t)nxt.pn * tstepB : cB;
        for (int t = 0; t < nt; t += 2) {
            const bool last = (t == nt - 2);
            const char* a1 = cA + (size_t)(t + 1) * kstep;
            const char* a2 = last ? nA : cA + (size_t)(t + 2) * kstep; const char* b2 = last ? nB : cB + (size_t)(t + 2) * kstep;
            const char* a3 = a2 + kstep; const char* b3 = b2 + kstep;
            if (last && has_next) S.a_ready(nxt);
            if constexpr (SP2) {
            PG8_LDB(B0, 0, 0); PG8_LDB(B1, 0, 1); PG8_SCHED; PG8_LDA(At, 0, 0); PG8_STAGE(PG8_SA(1, 1), a1 + hstepA, voffA);
            PG8_WAIT_V(8); PG8_WAIT_L(0); PG8_BAR; PG8_MMA(0, 0, At, B0); PG8_MMA(0, 1, At, B1); PG8_BAR; PG8_SCHED;
            PG8_LDA(At, 0, 1); PG8_STAGE(PG8_SB(0, 0), b2, voffB); PG8_STAGE(PG8_SB(0, 1), b2 + hstepB, voffB); PG8_STAGE(PG8_SA(0, 0), a2, voffA);
            PG8_WAIT_V(8); PG8_WAIT_L(0); PG8_BAR; PG8_MMA(1, 0, At, B0); PG8_MMA(1, 1, At, B1); PG8_BAR; PG8_SCHED;
            PG8_LDB(B0, 1, 0); PG8_LDB(B1, 1, 1); PG8_SCHED; PG8_LDA(At, 1, 0); PG8_STAGE(PG8_SA(0, 1), a2 + hstepA, voffA);
            PG8_WAIT_V(8); PG8_WAIT_L(0); PG8_BAR; PG8_MMA(0, 0, At, B0); PG8_MMA(0, 1, At, B1); PG8_BAR; PG8_SCHED;
            PG8_LDA(At, 1, 1); PG8_STAGE(PG8_SB(1, 0), b3, voffB); PG8_STAGE(PG8_SB(1, 1), b3 + hstepB, voffB); PG8_STAGE(PG8_SA(1, 0), a3, voffA);
            PG8_WAIT_V(8); PG8_WAIT_L(0); PG8_BAR; PG8_MMA(1, 0, At, B0); PG8_MMA(1, 1, At, B1); PG8_BAR; PG8_SCHED;
            } else {
            PG8_LDB(B0, 0, 0); PG8_SCHED; PG8_LDA(At, 0, 0); PG8_STAGE(PG8_SA(1, 1), a1 + hstepA, voffA);
            PG8_WAIT_L(8); PG8_BAR; PG8_WAIT_L(0); PG8_MMA(0, 0, At, B0); PG8_BAR; PG8_SCHED;
            PG8_LDB(B1, 0, 1); PG8_STAGE(PG8_SB(0, 0), b2, voffB);
            PG8_BAR; PG8_WAIT_L(0); PG8_MMA(0, 1, At, B1); PG8_BAR;
            PG8_LDA(At, 0, 1); PG8_STAGE(PG8_SA(0, 0), a2, voffA);
            PG8_BAR; PG8_WAIT_L(0); PG8_MMA(1, 0, At, B0); PG8_BAR; PG8_SCHED;
            PG8_STAGE(PG8_SB(0, 1), b2 + hstepB, voffB);
            PG8_WAIT_V(6); PG8_BAR; PG8_MMA(1, 1, At, B1); PG8_BAR;
            PG8_LDB(B0, 1, 0); PG8_SCHED; PG8_LDA(At, 1, 0); PG8_STAGE(PG8_SA(0, 1), a2 + hstepA, voffA);
            PG8_WAIT_L(8); PG8_BAR; PG8_WAIT_L(0); PG8_MMA(0, 0, At, B0); PG8_BAR; PG8_SCHED;
            PG8_LDB(B1, 1, 1); PG8_STAGE(PG8_SB(1, 0), b3, voffB);
            PG8_BAR; PG8_WAIT_L(0); PG8_MMA(0, 1, At, B1); PG8_BAR;
            PG8_LDA(At, 1, 1); PG8_STAGE(PG8_SA(1, 0), a3, voffA);
            PG8_BAR; PG8_WAIT_L(0); PG8_MMA(1, 0, At, B0); PG8_BAR; PG8_SCHED;
            PG8_STAGE(PG8_SB(1, 1), b3 + hstepB, voffB);
            PG8_WAIT_V(6); PG8_BAR; PG8_MMA(1, 1, At, B1); PG8_BAR;
            }
        }
        if constexpr (ALIGN_EPI) { if (wr == 0) PG8_BAR; }
        if constexpr (!Epi::AFTER_DRAIN) { E(acc, cur, wr, wc, fr, fq); S.done(cur); }
        if (!has_next) break;
#pragma unroll
        for (int a = 0; a < 2; ++a)
#pragma unroll
            for (int b = 0; b < 2; ++b)
#pragma unroll
                for (int m = 0; m < 4; ++m)
#pragma unroll
                    for (int n = 0; n < 2; ++n) acc[a][b][m][n] = (f32x4){0.f, 0.f, 0.f, 0.f};
        cur = nxt; cA = nA; cB = nB; ++ui;
        if constexpr (ALIGN_EPI) { if (wr == 1) PG8_BAR; }
    }
    PG8_WAIT_V(0);
    if constexpr (!ALIGN_EPI) { if (wr == 0) PG8_BAR; }
    PG8_BAR;
    if constexpr (Epi::AFTER_DRAIN) { E.fused(acc, cur, wr, wc, fr, fq, lds, wid, lane); S.done(cur); }
#undef PG8_SA
#undef PG8_SB
#undef PG8_STAGE
#undef PG8_LDA
#undef PG8_LDB
#undef PG8_MMA
#undef PG8_WAIT_V
#undef PG8_WAIT_L
#undef PG8_BAR
#undef PG8_SCHED
}
}

namespace epi {
using pg8::f32x4; using pg8::u32x4; using pg8::Unit; using pg8::HALF; using pg8::BM;
__device__ __forceinline__ unsigned cvt_pk_bf16(float lo, float hi) { typedef __bf16 b2 __attribute__((ext_vector_type(2))); const f32x2 v = {lo, hi}; const b2 b = __builtin_convertvector(v, b2); return __builtin_bit_cast(unsigned, b); }
template <int MODE> struct EpiStore {
    static constexpr bool PERM = true, AFTER_DRAIN = false;
    bf16_t* O; int ldc; float* ssq; int which; float inv_n;
    __device__ __forceinline__ void operator()(const f32x4 (&acc)[2][2][4][2], const Unit& u, int wr, int wc, int fr, int fq) const {
        int row0 = u.pm * BM + wr * 64 + fr, col0 = u.pn * BM + wc * 32 + 8 * fq;
        if (MODE == 2) {
#pragma unroll
            for (int bj = 0; bj < 2; ++bj) { float cs[8];
#pragma unroll
                for (int i = 0; i < 8; ++i) { const f32x4 pq = *(const f32x4*)(ssq + 8 * (col0 + bj * HALF + i) + 4 * which); cs[i] = __builtin_amdgcn_rsqf(((pq.x + pq.y) + (pq.z + pq.w)) * inv_n + EPS); }
#pragma unroll
                for (int ai = 0; ai < 2; ++ai)
#pragma unroll
                    for (int m = 0; m < 4; ++m) { bf16_t* rowp = O + (size_t)(row0 + ai * HALF + m * 16) * ldc + col0 + bj * HALF; const f32x4 v0 = acc[ai][bj][m][0], v1 = acc[ai][bj][m][1];
                        u32x4 w; w.x = cvt_pk_bf16(v0[0] * cs[0], v0[1] * cs[1]); w.y = cvt_pk_bf16(v0[2] * cs[2], v0[3] * cs[3]); w.z = cvt_pk_bf16(v1[0] * cs[4], v1[1] * cs[5]); w.w = cvt_pk_bf16(v1[2] * cs[6], v1[3] * cs[7]);
                        *(u32x4*)rowp = w; } }
            return;
        }
#pragma unroll
        for (int ai = 0; ai < 2; ++ai)
#pragma unroll
            for (int m = 0; m < 4; ++m) { const int row = row0 + ai * HALF + m * 16; bf16_t* rowp = O + (size_t)row * ldc + col0;
                float rs = 1.f; if (MODE == 1) { const f32x4 pq = *(const f32x4*)(ssq + 8 * row + 4 * which); rs = __builtin_amdgcn_rsqf(((pq.x + pq.y) + (pq.z + pq.w)) * inv_n + EPS); }
                float sq = 0.f;
#pragma unroll
                for (int bj = 0; bj < 2; ++bj) { f32x4 v0 = acc[ai][bj][m][0], v1 = acc[ai][bj][m][1];
                    if (MODE == 1) { v0 = v0 * rs; v1 = v1 * rs; }
                    if (MODE == 3 && (u.pn == 0 || (u.pn == 1 && bj == 0))) sq += (v0.x * v0.x + v0.y * v0.y) + (v0.z * v0.z + v0.w * v0.w) + (v1.x * v1.x + v1.y * v1.y) + (v1.z * v1.z + v1.w * v1.w);
                    u32x4 w; w.x = cvt_pk_bf16(v0[0], v0[1]); w.y = cvt_pk_bf16(v0[2], v0[3]); w.z = cvt_pk_bf16(v1[0], v1[1]); w.w = cvt_pk_bf16(v1[2], v1[3]);
                    *(u32x4*)(rowp + bj * HALF) = w; }
                if (MODE == 3 && u.pn < 2) { sq += __shfl_xor(sq, 16); sq += __shfl_xor(sq, 32); if (fq == 0) ssq[8 * row + 4 * u.pn + wc] = sq; }
            }
    }
};
struct EpiResid {
    static constexpr bool PERM = true, AFTER_DRAIN = false;
    const float* x; const float* mod; bf16_t* out;
    __device__ __forceinline__ void operator()(const f32x4 (&acc)[2][2][4][2], const Unit& u, int wr, int wc, int fr, int fq) const {
        int row0 = u.pm * BM + wr * 64 + fr, col0 = u.pn * BM + wc * 32 + 8 * fq; const int b = (u.pm * BM) / SEQ;
        f32x4 gv[2][2];
#pragma unroll
        for (int bj = 0; bj < 2; ++bj)
#pragma unroll
            for (int n = 0; n < 2; ++n) gv[bj][n] = *(const f32x4*)(mod + (size_t)b * 6144 + 2 * D + col0 + bj * HALF + n * 4);
#pragma unroll
        for (int ai = 0; ai < 2; ++ai)
#pragma unroll
            for (int m = 0; m < 4; ++m) { const size_t off = (size_t)(row0 + ai * HALF + m * 16) * D + col0;
#pragma unroll
                for (int bj = 0; bj < 2; ++bj) { const f32x4 x0 = *(const f32x4*)(x + off + bj * HALF), x1 = *(const f32x4*)(x + off + bj * HALF + 4);
                    const f32x4 v0 = x0 + gv[bj][0] * acc[ai][bj][m][0], v1 = x1 + gv[bj][1] * acc[ai][bj][m][1];
                    u32x4 w; w.x = cvt_pk_bf16(v0[0], v0[1]); w.y = cvt_pk_bf16(v0[2], v0[3]); w.z = cvt_pk_bf16(v1[0], v1[1]); w.w = cvt_pk_bf16(v1[2], v1[3]);
                    *(u32x4*)(out + off + bj * HALF) = w; } }
    }
};
}

#define LAS __attribute__((address_space(3)))
#define LDSW() asm volatile("s_waitcnt lgkmcnt(0)" ::: "memory")
#define PSEC_WORD ((__attribute__((address_space(3))) volatile unsigned long long*)(unsigned)(131072 + 8192 + 64 + 8 * 16))
#define PSEC_BEGIN(id) unsigned long long psec_t0_##id = 0; do { if (PROBE_SEC == (id) && blockIdx.x == 0 && threadIdx.x == 0) { __builtin_amdgcn_sched_barrier(0); psec_t0_##id = __builtin_amdgcn_s_memrealtime(); __builtin_amdgcn_sched_barrier(0); } } while (0)
#define PSEC_END(id) do { if (PROBE_SEC == (id) && blockIdx.x == 0 && threadIdx.x == 0) { __builtin_amdgcn_sched_barrier(0); *PSEC_WORD += __builtin_amdgcn_s_memrealtime() - psec_t0_##id; __builtin_amdgcn_sched_barrier(0); } } while (0)

typedef short bf16x8 __attribute__((ext_vector_type(8)));
typedef float f32x16 __attribute__((ext_vector_type(16)));
__device__ __forceinline__ int crow(int r, int hi) { return (r & 3) + 8 * (r >> 2) + 4 * hi; }
typedef __bf16 bf16x2_t __attribute__((ext_vector_type(2)));
__device__ __forceinline__ unsigned cvtpk(float lo, float hi) { const f32x2 v = {lo, hi}; const bf16x2_t b = __builtin_convertvector(v, bf16x2_t); return __builtin_bit_cast(unsigned, b); }
__device__ __forceinline__ float bfe(const u32x4& w, int e) { const unsigned d = w[e >> 1]; return (e & 1) ? bfhi(d) : bflo(d); }
__device__ __forceinline__ bf16x8 as_frag(const u32x4& w) { return __builtin_bit_cast(bf16x8, w); }
__device__ __forceinline__ void rope_pair(const u32x4& c1, const u32x4& c2, float pos, const float (&inv)[8], float sc, u32x4& o1, u32x4& o2) {
    float a[8], b[8];
#pragma unroll
    for (int e = 0; e < 8; ++e) { float sn, cs; sincos_rad(pos * inv[e], sn, cs); const float x1 = bfe(c1, e), x2 = bfe(c2, e); a[e] = (x1 * cs - x2 * sn) * sc; b[e] = (x1 * sn + x2 * cs) * sc; }
    o1 = (u32x4){cvtpk(a[0], a[1]), cvtpk(a[2], a[3]), cvtpk(a[4], a[5]), cvtpk(a[6], a[7])};
    o2 = (u32x4){cvtpk(b[0], b[1]), cvtpk(b[2], b[3]), cvtpk(b[4], b[5]), cvtpk(b[6], b[7])};
}
template <int S2> __device__ __forceinline__ void rope_pair_h(const u32x4& c1, const u32x4& c2, float pos, int hi, float sc, u32x4& o1, u32x4& o2) {
    float a[8], b[8];
#pragma unroll
    for (int e = 0; e < 8; ++e) { const float inv = hi ? INV64[16 * S2 + 8 + e] : INV64[16 * S2 + e]; float sn, cs; sincos_rad(pos * inv, sn, cs); const float x1 = bfe(c1, e), x2 = bfe(c2, e); a[e] = (x1 * cs - x2 * sn) * sc; b[e] = (x1 * sn + x2 * cs) * sc; }
    o1 = (u32x4){cvtpk(a[0], a[1]), cvtpk(a[2], a[3]), cvtpk(a[4], a[5]), cvtpk(a[6], a[7])};
    o2 = (u32x4){cvtpk(b[0], b[1]), cvtpk(b[2], b[3]), cvtpk(b[4], b[5]), cvtpk(b[6], b[7])};
}
__device__ __forceinline__ void ret_kvc_item(const Params& P, int item, int lane) {
    const bf16_t* proj = (const bf16_t*)(P.ws + WS_PROJ); const bf16_t* projt = (const bf16_t*)(P.ws + WS_PROJT); float* kvc = (float*)(P.ws + WS_KVC) + (size_t)item * 4096;
    const int h = item & 7, n = (item >> 3) & 63, b = item >> 9;
    const size_t t0 = (size_t)b * SEQ + n * 128;
    const float gamma = 1.0f - exp2f(-5.0f - (float)h), lg = log2f(gamma);
    const int r32 = lane & 31, hi = lane >> 5, f = r32;
    bf16x8 idb[2];
#pragma unroll
    for (int sp = 0; sp < 2; ++sp) { u32x4 w = {0u, 0u, 0u, 0u};
        if ((r32 >> 4) == sp && ((r32 >> 3) & 1) == hi) { const unsigned one = (r32 & 1) ? 0x3f800000u : 0x00003f80u; const int q = (r32 & 7) >> 1; w.x = q == 0 ? one : 0u; w.y = q == 1 ? one : 0u; w.z = q == 2 ? one : 0u; w.w = q == 3 ? one : 0u; }
        idb[sp] = as_frag(w); }
    const unsigned rowoff = (unsigned)(r32 * PLD + 8 * hi) * 2u, voff = (unsigned)(r32 * T + 4 * hi) * 2u, poff = (unsigned)r32 * 4u;
    const char* kbase = (const char*)(proj + t0 * PLD + PC_RK + h * 64); const char* pbase = (const char*)(P.positions + t0); const char* vbase = (const char*)(projt + (size_t)(PT_RV + h * 64) * T + t0);
#define RA_ROW(jb_, c_) (*(const u32x4*)(kbase + (size_t)(jb_) * (32 * PLD * 2) + (c_) * 32 + rowoff))
#define RA_POS(jb_) ((float)*(const int*)(pbase + (size_t)(jb_) * 128 + poff))
#define RA_LOADV(jb_) do { _Pragma("unroll") for (int blk_ = 0; blk_ < 2; ++blk_) _Pragma("unroll") for (int sp_ = 0; sp_ < 2; ++sp_) { const char* vp_ = vbase + (size_t)(32 * blk_) * T * 2 + (32 * (jb_) + 16 * sp_) * 2 + voff; \
        vlo[(jb_) & 1][blk_][sp_] = *(const u32x2*)vp_; vhh[(jb_) & 1][blk_][sp_] = *(const u32x2*)(vp_ + 16); } } while (0)
    u32x4 kn[2][4]; float kpos[2]; u32x2 vlo[2][2][2], vhh[2][2][2];
    kn[0][0] = RA_ROW(0, 0); kn[0][1] = RA_ROW(0, 1); kn[0][2] = RA_ROW(0, 2); kn[0][3] = RA_ROW(0, 3); kpos[0] = RA_POS(0); RA_LOADV(0);
    f32x16 acc[2][2];
#pragma unroll
    for (int i = 0; i < 2; ++i)
#pragma unroll
        for (int j = 0; j < 2; ++j)
#pragma unroll
            for (int r = 0; r < 16; ++r) acc[i][j][r] = 0.f;
#pragma unroll
    for (int jb = 0; jb < 4; ++jb) {
        __builtin_amdgcn_sched_barrier(0);
        if (jb < 3) { kn[(jb + 1) & 1][0] = RA_ROW(jb + 1, 0); kn[(jb + 1) & 1][1] = RA_ROW(jb + 1, 1); kn[(jb + 1) & 1][2] = RA_ROW(jb + 1, 2); kn[(jb + 1) & 1][3] = RA_ROW(jb + 1, 3); kpos[(jb + 1) & 1] = RA_POS(jb + 1);
            if (jb == 0) RA_LOADV(1); else if (jb == 1) RA_LOADV(2); else RA_LOADV(3); }
        __builtin_amdgcn_sched_barrier(0);
        const float scj = 0.125f * __builtin_amdgcn_exp2f(-(float)(32 * jb + r32) * lg);
        u32x4 o[4]; rope_pair_h<0>(kn[jb & 1][0], kn[jb & 1][2], kpos[jb & 1], hi, scj, o[0], o[2]); rope_pair_h<1>(kn[jb & 1][1], kn[jb & 1][3], kpos[jb & 1], hi, scj, o[1], o[3]);
#pragma unroll
        for (int c = 0; c < 2; ++c) {
            f32x16 kc;
#pragma unroll
            for (int r = 0; r < 16; ++r) kc[r] = 0.f;
            kc = __builtin_amdgcn_mfma_f32_32x32x16_bf16(as_frag(o[2 * c]), idb[0], kc, 0, 0, 0);
            kc = __builtin_amdgcn_mfma_f32_32x32x16_bf16(as_frag(o[2 * c + 1]), idb[1], kc, 0, 0, 0);
#pragma unroll
            for (int sp = 0; sp < 2; ++sp) {
                const bf16x8 pb = as_frag((u32x4){cvtpk(kc[8 * sp], kc[8 * sp + 1]), cvtpk(kc[8 * sp + 2], kc[8 * sp + 3]), cvtpk(kc[8 * sp + 4], kc[8 * sp + 5]), cvtpk(kc[8 * sp + 6], kc[8 * sp + 7])});
#pragma unroll
                for (int blk = 0; blk < 2; ++blk)
                    acc[blk][c] = __builtin_amdgcn_mfma_f32_32x32x16_bf16(as_frag((u32x4){vlo[jb & 1][blk][sp].x, vlo[jb & 1][blk][sp].y, vhh[jb & 1][blk][sp].x, vhh[jb & 1][blk][sp].y}), pb, acc[blk][c], 0, 0, 0);
            }
        }
    }
#undef RA_ROW
#undef RA_POS
#undef RA_LOADV
    const float g127 = __builtin_amdgcn_exp2f(127.0f * lg);
#pragma unroll
    for (int blk = 0; blk < 2; ++blk)
#pragma unroll
        for (int c = 0; c < 2; ++c)
#pragma unroll
            for (int r = 0; r < 16; ++r) kvc[(32 * blk + crow(r, hi)) * 64 + 32 * c + f] = acc[blk][c][r] * g127;
}
__device__ __forceinline__ void ret_scan(const Params& P, size_t gt, size_t nt) {
    const float* kvc = (const float*)(P.ws + WS_KVC); bf16_t* prevb = (bf16_t*)(P.ws + WS_PREVB);
    for (size_t i = gt; i < (size_t)NB * NH * 4096; i += nt) {
        const int e = (int)(i & 4095), h = (int)((i >> 12) & 7), b = (int)(i >> 15);
        const float gamma = 1.0f - exp2f(-5.0f - (float)h), decay = exp2f(128.0f * log2f(gamma));
        float st = 0.f;
#pragma unroll 8
        for (int n = 0; n < 64; ++n) { const size_t o = ((size_t)((b * 64 + n) * 8 + h)) * 4096 + e; const float v = kvc[o]; prevb[o] = (bf16_t)f2bf(st * gamma); st = st * decay + v; }
    }
}
__device__ __forceinline__ void ret_out_item(const Params& P, int item, int lane, LAS u32x4* wl) {
    const bf16_t* proj = (const bf16_t*)(P.ws + WS_PROJ); const bf16_t* projt = (const bf16_t*)(P.ws + WS_PROJT); const bf16_t* prevb = (const bf16_t*)(P.ws + WS_PREVB) + (size_t)item * 4096;
    bf16_t* Y = (bf16_t*)(P.ws + WS_XN);
    const int h = item & 7, n = (item >> 3) & 63, b = item >> 9;
    const size_t t0 = (size_t)b * SEQ + n * 128;
    const float gamma = 1.0f - exp2f(-5.0f - (float)h), lg = log2f(gamma);
    const int r32 = lane & 31, hi = lane >> 5;
    const unsigned rowoff = (unsigned)(r32 * PLD + 8 * hi) * 2u, gateoff = (unsigned)(r32 * PLD + 4 * hi) * 2u, voff = (unsigned)(r32 * T + 4 * hi) * 2u, poff = (unsigned)r32 * 4u;
    const unsigned pfoff = (unsigned)(r32 * 64 + 8 * hi) * 2u, yoff = (unsigned)(r32 * D + 4 * hi) * 2u;
    const char* kbase = (const char*)(proj + t0 * PLD + PC_RK + h * 64); const char* qbase = (const char*)(proj + t0 * PLD + PC_RQ + h * 64); const char* gbase = (const char*)(proj + t0 * PLD + PC_RG + h * 64);
    const char* pbase = (const char*)(P.positions + t0); const char* vbase = (const char*)(projt + (size_t)(PT_RV + h * 64) * T + t0); const char* fbase = (const char*)prevb; char* ybase = (char*)(Y + t0 * D + 512 + h * 64);
#define RC_ROW(base_, jb_, c_) (*(const u32x4*)((base_) + (size_t)(jb_) * (32 * PLD * 2) + (c_) * 32 + rowoff))
#define RC_POS(jb_) ((float)*(const int*)(pbase + (size_t)(jb_) * 128 + poff))
    u32x4 kn0 = RC_ROW(kbase, 0, 0), kn1 = RC_ROW(kbase, 0, 1), kn2 = RC_ROW(kbase, 0, 2), kn3 = RC_ROW(kbase, 0, 3); float kposn = RC_POS(0);
    u32x4 qn0 = RC_ROW(qbase, 0, 0), qn1 = RC_ROW(qbase, 0, 1), qn2 = RC_ROW(qbase, 0, 2), qn3 = RC_ROW(qbase, 0, 3); float qposn = kposn;
    u32x2 vlo[4][2][2], vhh[4][2][2];
#define RC_LOADV(jb_) do { _Pragma("unroll") for (int blk_ = 0; blk_ < 2; ++blk_) _Pragma("unroll") for (int sp_ = 0; sp_ < 2; ++sp_) { const char* vp_ = vbase + (size_t)(32 * blk_) * T * 2 + (32 * (jb_) + 16 * sp_) * 2 + voff; \
        vlo[jb_][blk_][sp_] = *(const u32x2*)vp_; vhh[jb_][blk_][sp_] = *(const u32x2*)(vp_ + 16); } } while (0)
    RC_LOADV(0);
#pragma unroll 1
    for (int jb = 0; jb < 4; ++jb) {
        const u32x4 c0 = kn0, c1 = kn1, c2 = kn2, c3 = kn3; const float pos = kposn; const float scj = 0.125f * __builtin_amdgcn_exp2f(-(float)(32 * jb + r32) * lg);
        { const int jn = jb < 3 ? jb + 1 : 3; kn0 = RC_ROW(kbase, jn, 0); kn1 = RC_ROW(kbase, jn, 1); kn2 = RC_ROW(kbase, jn, 2); kn3 = RC_ROW(kbase, jn, 3); kposn = RC_POS(jn); }
        __builtin_amdgcn_sched_barrier(0);
        u32x4 o0, o1, o2, o3; rope_pair_h<0>(c0, c2, pos, hi, scj, o0, o2); rope_pair_h<1>(c1, c3, pos, hi, scj, o1, o3);
        wl[(jb * 4 + 0) * 64 + lane] = o0; wl[(jb * 4 + 1) * 64 + lane] = o1; wl[(jb * 4 + 2) * 64 + lane] = o2; wl[(jb * 4 + 3) * 64 + lane] = o3;
    }
#pragma unroll
    for (int ib = 0; ib < 4; ++ib) {
        __builtin_amdgcn_sched_barrier(0);
        const float sci = __builtin_amdgcn_exp2f((float)(32 * ib + r32) * lg);
        const u32x4 c0 = qn0, c1 = qn1, c2 = qn2, c3 = qn3; const float pos = qposn;
        { const int in = ib < 3 ? ib + 1 : 3; qn0 = RC_ROW(qbase, in, 0); qn1 = RC_ROW(qbase, in, 1); qn2 = RC_ROW(qbase, in, 2); qn3 = RC_ROW(qbase, in, 3); qposn = RC_POS(in); }
        if (ib == 0) RC_LOADV(1); else if (ib == 1) RC_LOADV(2); else if (ib == 2) RC_LOADV(3);
        __builtin_amdgcn_sched_barrier(0);
        bf16x8 qf[4];
        { u32x4 o0, o1, o2, o3; rope_pair_h<0>(c0, c2, pos, hi, sci, o0, o2); rope_pair_h<1>(c1, c3, pos, hi, sci, o1, o3);
          qf[0] = as_frag(o0); qf[1] = as_frag(o1); qf[2] = as_frag(o2); qf[3] = as_frag(o3); }
        __builtin_amdgcn_sched_barrier(0);
        bf16x8 pf[2][4];
#pragma unroll
        for (int blk = 0; blk < 2; ++blk)
#pragma unroll
            for (int s = 0; s < 4; ++s) pf[blk][s] = *(const bf16x8*)(fbase + (size_t)(32 * blk * 64 + 16 * s) * 2 + pfoff);
        u32x2 gt2[2][4];
#pragma unroll
        for (int blk = 0; blk < 2; ++blk)
#pragma unroll
            for (int g4 = 0; g4 < 4; ++g4) gt2[blk][g4] = *(const u32x2*)(gbase + (size_t)ib * (32 * PLD * 2) + (32 * blk + 8 * g4) * 2 + gateoff);
        __builtin_amdgcn_sched_barrier(0);
        f32x16 y[2];
#pragma unroll
        for (int blk = 0; blk < 2; ++blk)
#pragma unroll
            for (int r = 0; r < 16; ++r) y[blk][r] = 0.f;
#pragma unroll
        for (int jb = 0; jb < 4; ++jb) if (jb <= ib) {
            f32x16 st;
#pragma unroll
            for (int r = 0; r < 16; ++r) st[r] = 0.f;
#pragma unroll
            for (int s = 0; s < 4; ++s) { const u32x4 kf = wl[(jb * 4 + s) * 64 + lane]; st = __builtin_amdgcn_mfma_f32_32x32x16_bf16(as_frag(kf), qf[s], st, 0, 0, 0); }
            if (jb == ib) {
#pragma unroll
                for (int r = 0; r < 16; ++r) if (crow(r, hi) > r32) st[r] = 0.f;
            }
#pragma unroll
            for (int sp = 0; sp < 2; ++sp) {
                const bf16x8 pb = as_frag((u32x4){cvtpk(st[8 * sp], st[8 * sp + 1]), cvtpk(st[8 * sp + 2], st[8 * sp + 3]), cvtpk(st[8 * sp + 4], st[8 * sp + 5]), cvtpk(st[8 * sp + 6], st[8 * sp + 7])});
#pragma unroll
                for (int blk = 0; blk < 2; ++blk)
                    y[blk] = __builtin_amdgcn_mfma_f32_32x32x16_bf16(as_frag((u32x4){vlo[jb][blk][sp].x, vlo[jb][blk][sp].y, vhh[jb][blk][sp].x, vhh[jb][blk][sp].y}), pb, y[blk], 0, 0, 0);
            }
        }
#pragma unroll
        for (int blk = 0; blk < 2; ++blk)
#pragma unroll
            for (int s = 0; s < 4; ++s) y[blk] = __builtin_amdgcn_mfma_f32_32x32x16_bf16(pf[blk][s], qf[s], y[blk], 0, 0, 0);
        float sum = 0.f;
#pragma unroll
        for (int blk = 0; blk < 2; ++blk)
#pragma unroll
            for (int r = 0; r < 16; ++r) sum += y[blk][r];
        sum += __shfl_xor(sum, 32); const float mu = sum * (1.f / 64.f);
        float var = 0.f;
#pragma unroll
        for (int blk = 0; blk < 2; ++blk)
#pragma unroll
            for (int r = 0; r < 16; ++r) { const float d = y[blk][r] - mu; var += d * d; }
        var += __shfl_xor(var, 32); const float rstd = 1.0f / sqrtf(var * (1.f / 64.f) + EPS);
#pragma unroll
        for (int blk = 0; blk < 2; ++blk)
#pragma unroll
            for (int g4 = 0; g4 < 4; ++g4) { const int dv0 = 32 * blk + 8 * g4 + 4 * hi;
                const u32x2 g2 = gt2[blk][g4]; const f32x4 gr = *(const f32x4*)(P.g_ret_norm + h * 64 + dv0);
                const float o0 = silu_f(bflo(g2.x)) * (y[blk][4 * g4] - mu) * rstd * gr.x, o1 = silu_f(bfhi(g2.x)) * (y[blk][4 * g4 + 1] - mu) * rstd * gr.y;
                const float o2 = silu_f(bflo(g2.y)) * (y[blk][4 * g4 + 2] - mu) * rstd * gr.z, o3 = silu_f(bfhi(g2.y)) * (y[blk][4 * g4 + 3] - mu) * rstd * gr.w;
                *(u32x2*)(ybase + (size_t)ib * (32 * D * 2) + (32 * blk + 8 * g4) * 2 + yoff) = (u32x2){cvtpk(o0, o1), cvtpk(o2, o3)}; }
    }
#undef RC_LOADV
#undef RC_ROW
#undef RC_POS
}
constexpr int AT_KSTR = 104, AT_VSTR = 68;
constexpr int AT_KBYTES = 64 * AT_KSTR * 2, AT_VBYTES = 64 * AT_VSTR * 2, AT_BUF = AT_KBYTES + AT_VBYTES;
__device__ __forceinline__ void attn_unit(const Params& P, int b, int h, int qb, LAS unsigned char* lds, int tid) {
    const bf16_t* Q = (const bf16_t*)(P.ws + WS_Q); const bf16_t* KN = (const bf16_t*)(P.ws + WS_KN); const bf16_t* KR = (const bf16_t*)(P.ws + WS_KR);
    const bf16_t* VT = (const bf16_t*)(P.ws + WS_VT); bf16_t* Y = (bf16_t*)(P.ws + WS_XN);
    const int lane = tid & 63, wave = __builtin_amdgcn_readfirstlane(tid >> 6), r32 = lane & 31, hi = lane >> 5;
    const int qfirst = qb * 256 + wave * 32, qrow = qfirst + r32; const size_t tq = (size_t)b * SEQ + qrow;
    bf16x8 qf[6];
    { const bf16_t* qp = Q + tq * 768 + h * 96 + 8 * hi;
#pragma unroll
      for (int s = 0; s < 4; ++s) qf[s] = *(const bf16x8*)(qp + 16 * s);
      const u32x4 c4 = *(const u32x4*)(qp + 64), c5 = *(const u32x4*)(qp + 80);
      float inv[8];
#pragma unroll
      for (int e = 0; e < 8; ++e) inv[e] = INV64[2 * (8 * hi + e)];
      u32x4 o4, o5; rope_pair(c4, c5, (float)P.positions[tq], inv, 1.0f, o4, o5); qf[4] = as_frag(o4); qf[5] = as_frag(o5); }
    f32x16 o[2];
#pragma unroll
    for (int r = 0; r < 16; ++r) { o[0][r] = 0.f; o[1][r] = 0.f; }
    float m_run = 0.f, l_part = 0.f;
    f32x16 negm;
#pragma unroll
    for (int r = 0; r < 16; ++r) negm[r] = 0.f;
    const int ntiles = 4 * qb + 4;
    const int kr = tid >> 3, kc = tid & 7, rr = tid >> 2, rc = tid & 3;
    const bf16_t* ksrc = KN + ((size_t)b * SEQ + kr) * 512 + h * 64 + kc * 8;
    const bf16_t* rsrc = KR + ((size_t)b * SEQ + rr) * 32 + rc * 8;
    const bf16_t* vsrc = VT + (size_t)(h * 64 + kr) * T + (size_t)b * SEQ + kc * 8;
    const int kdst = (kr * AT_KSTR + kc * 8) * 2, rdst = (rr * AT_KSTR + 64 + rc * 8) * 2, vdst = AT_KBYTES + (kr * AT_VSTR + kc * 8) * 2;
    u32x4 sk, sr, sv;
    sk = *(const u32x4*)ksrc; if (tid < 256) sr = *(const u32x4*)rsrc; sv = *(const u32x4*)vsrc;
    *(LAS u32x4*)(lds + kdst) = sk; if (tid < 256) *(LAS u32x4*)(lds + rdst) = sr;
    *(LAS u32x2*)(lds + vdst) = (u32x2){sv.x, sv.y}; *(LAS u32x2*)(lds + vdst + 8) = (u32x2){sv.z, sv.w};
    __syncthreads();
    for (int t = 0; t < ntiles; ++t) {
        const bool more = (t + 1 < ntiles);
        if (more) { sk = *(const u32x4*)(ksrc + (size_t)(t + 1) * 64 * 512); if (tid < 256) sr = *(const u32x4*)(rsrc + (size_t)(t + 1) * 64 * 32); sv = *(const u32x4*)(vsrc + (t + 1) * 64); }
        if (64 * t <= qfirst + 31) {
            LAS unsigned char* Kb = lds + (t & 1) * AT_BUF; LAS unsigned char* Vb = Kb + AT_KBYTES;
            f32x16 st[2];
#pragma unroll
            for (int blk = 0; blk < 2; ++blk) {
#pragma unroll
                for (int s = 0; s < 6; ++s) { const bf16x8 kf = *(const LAS bf16x8*)(Kb + ((32 * blk + r32) * AT_KSTR + 16 * s + 8 * hi) * 2); st[blk] = __builtin_amdgcn_mfma_f32_32x32x16_bf16(kf, qf[s], s == 0 ? negm : st[blk], 0, 0, 0); }
            }
            if (64 * t + 63 > qfirst) {
#pragma unroll
                for (int blk = 0; blk < 2; ++blk)
#pragma unroll
                    for (int r = 0; r < 16; ++r) if (64 * t + 32 * blk + crow(r, hi) > qrow) st[blk][r] = -INFINITY;
            }
            float mx = fmaxf(st[0][0], st[1][0]);
#pragma unroll
            for (int r = 1; r < 16; ++r) mx = fmaxf(mx, fmaxf(st[0][r], st[1][r]));
            mx = fmaxf(mx, __shfl_xor(mx, 32));
            if (t == 0 || __any(mx > 8.0f)) {
                const float dl = (t == 0) ? mx : fmaxf(mx, 0.f), f = (t == 0) ? 1.f : __builtin_amdgcn_exp2f(-dl); l_part *= f; m_run += dl;
#pragma unroll
                for (int r = 0; r < 16; ++r) { o[0][r] *= f; o[1][r] *= f; st[0][r] -= dl; st[1][r] -= dl; negm[r] = -m_run; }
            }
            float ps = 0.f;
#pragma unroll
            for (int blk = 0; blk < 2; ++blk)
#pragma unroll
                for (int r = 0; r < 16; ++r) { const float p = __builtin_amdgcn_exp2f(st[blk][r]); st[blk][r] = p; ps += p; }
            l_part += ps;
#pragma unroll
            for (int jb = 0; jb < 2; ++jb)
#pragma unroll
                for (int sp = 0; sp < 2; ++sp) {
                    const bf16x8 pb = as_frag((u32x4){cvtpk(st[jb][8 * sp], st[jb][8 * sp + 1]), cvtpk(st[jb][8 * sp + 2], st[jb][8 * sp + 3]), cvtpk(st[jb][8 * sp + 4], st[jb][8 * sp + 5]), cvtpk(st[jb][8 * sp + 6], st[jb][8 * sp + 7])});
#pragma unroll
                    for (int dblk = 0; dblk < 2; ++dblk) { const LAS unsigned char* vp = Vb + ((32 * dblk + r32) * AT_VSTR + 32 * jb + 16 * sp + 4 * hi) * 2;
                        const u32x2 lo = *(const LAS u32x2*)vp, hh = *(const LAS u32x2*)(vp + 16);
                        o[dblk] = __builtin_amdgcn_mfma_f32_32x32x16_bf16(as_frag((u32x4){lo.x, lo.y, hh.x, hh.y}), pb, o[dblk], 0, 0, 0); }
                }
        }
        if (more) { LAS unsigned char* nb = lds + ((t + 1) & 1) * AT_BUF;
            *(LAS u32x4*)(nb + kdst) = sk; if (tid < 256) *(LAS u32x4*)(nb + rdst) = sr;
            *(LAS u32x2*)(nb + vdst) = (u32x2){sv.x, sv.y}; *(LAS u32x2*)(nb + vdst + 8) = (u32x2){sv.z, sv.w}; }
        __syncthreads();
    }
    const float l = l_part + __shfl_xor(l_part, 32), il = 1.0f / l;
#pragma unroll
    for (int dblk = 0; dblk < 2; ++dblk)
#pragma unroll
        for (int g4 = 0; g4 < 4; ++g4) { const int dv0 = 32 * dblk + 8 * g4 + 4 * hi;
            *(u32x2*)(Y + tq * D + h * 64 + dv0) = (u32x2){cvtpk(o[dblk][4 * g4] * il, o[dblk][4 * g4 + 1] * il), cvtpk(o[dblk][4 * g4 + 2] * il, o[dblk][4 * g4 + 3] * il)}; }
}
__device__ __forceinline__ void attn_phase(const Params& P, LAS unsigned char* lds, int tid) {
    const int G = gridDim.x, bx = blockIdx.x;
    if (G == 256) { const int vcu = (bx & 7) * 32 + (bx >> 3), bh = vcu >> 3, s = vcu & 7;
#pragma unroll 1
        for (int i = 0; i < 4; ++i) { const int qb = (i == 0) ? s : (i == 1) ? 15 - s : (i == 2) ? 16 + s : 31 - s; attn_unit(P, bh >> 3, bh & 7, qb, lds, tid); }
    } else {
#pragma unroll 1
        for (int u = bx; u < 1024; u += G) attn_unit(P, u >> 8, (u >> 5) & 7, 31 - (u & 31), lds, tid);
    }
}
struct UE { u32x4 e0, e1; };
struct UB { u32x4 b0, b1; int t; };
__device__ __forceinline__ unsigned u_load_raw(const Params& P, int t, int half, int lane) { return ((const unsigned*)(P.ws + WS_EIDX))[(size_t)t * 128 + 64 * half + lane]; }
__device__ __forceinline__ void u_expand(int lane, unsigned r, UE& E) {
    const int base = (lane >> 3) * 4;
#pragma unroll
    for (int i = 0; i < 4; ++i) { E.e0[i] = (unsigned)__builtin_amdgcn_ds_bpermute(base + 32 * i, (int)r); E.e1[i] = (unsigned)__builtin_amdgcn_ds_bpermute(base + 128 + 32 * i, (int)r); }
}
__device__ __forceinline__ void u_load_b(const Params& P, int t, int x, int lane, UB& I) {
    const int c = lane & 15, g = lane >> 4;
    I.b0 = (u32x4){0u, 0u, 0u, 0u}; I.b1 = I.b0; I.t = t;
    if (c < 2) { const unsigned char* hp = P.ws + WS_H2Q + (size_t)t * 2048 + c * 1024 + x * 128 + 32 * g; I.b0 = *(const u32x4*)hp; I.b1 = *(const u32x4*)(hp + 16); }
}
struct URing { u32x4 rv[8]; };
template <bool WRITE> __device__ __forceinline__ void u_step(const unsigned char* eu8, int lane, URing& R, const UE& En, LAS unsigned char* img) {
    const unsigned r8 = (unsigned)lane >> 3, p = (unsigned)lane & 7u;
#pragma unroll
    for (int i = 0; i < 8; ++i) { const unsigned e = (i < 4) ? En.e0[i] : En.e1[i - 4]; const unsigned swz = 4u * (unsigned)(i & 1) + (r8 >> 1);
        if (WRITE) *(LAS u32x4*)(img + 1024 * i + lane * 16) = R.rv[i];
        R.rv[i] = *(const u32x4*)(eu8 + (e * 128u + 16u * (p ^ swz)));
        __builtin_amdgcn_sched_barrier(0); }
}
__device__ __forceinline__ float quad_swap1(float v) { return __builtin_bit_cast(float, __builtin_amdgcn_update_dpp(0, __builtin_bit_cast(int, v), 0xB1, 0xf, 0xf, true)); }
__device__ __forceinline__ long mk64(unsigned lo, unsigned hi) { return (long)(((unsigned long long)hi << 32) | lo); }
__device__ __forceinline__ void u_compute(const Params& P, int x, int half, int lane, const UB& I, const LAS unsigned char* const (&ra)[4]) {
    unsigned short* ap = (unsigned short*)(P.ws + WS_APART) + ((size_t)x * T + I.t) * 128 + 64 * half; const int c = lane & 15, g = lane >> 4;
    const long B0 = mk64(I.b0.x, I.b0.y), B1 = mk64(I.b0.z, I.b0.w), B2 = mk64(I.b1.x, I.b1.y), B3 = mk64(I.b1.z, I.b1.w);
    f32x4 acc[4];
#pragma unroll
    for (int rb = 0; rb < 4; ++rb) {
        const long A0 = *(const LAS long*)(ra[0] + rb * 2048), A1 = *(const LAS long*)(ra[1] + rb * 2048), A2 = *(const LAS long*)(ra[2] + rb * 2048), A3 = *(const LAS long*)(ra[3] + rb * 2048);
        f32x4 a = {0.f, 0.f, 0.f, 0.f};
        a = __builtin_amdgcn_mfma_f32_16x16x32_fp8_fp8(A0, B0, a, 0, 0, 0);
        a = __builtin_amdgcn_mfma_f32_16x16x32_fp8_fp8(A1, B1, a, 0, 0, 0);
        a = __builtin_amdgcn_mfma_f32_16x16x32_fp8_fp8(A2, B2, a, 0, 0, 0);
        a = __builtin_amdgcn_mfma_f32_16x16x32_fp8_fp8(A3, B3, a, 0, 0, 0);
        acc[rb] = a;
    }
    float lo[4][4];
#pragma unroll
    for (int rb = 0; rb < 4; ++rb) { lo[rb][0] = quad_swap1(acc[rb].x); lo[rb][1] = quad_swap1(acc[rb].y); lo[rb][2] = quad_swap1(acc[rb].z); lo[rb][3] = quad_swap1(acc[rb].w); }
    if (c == 0) {
#pragma unroll
        for (int rb = 0; rb < 4; ++rb) {
            const h2_t p0 = {(_Float16)((acc[rb].x + lo[rb][0] * 0.0625f) * 0.0625f), (_Float16)((acc[rb].y + lo[rb][1] * 0.0625f) * 0.0625f)}, p1 = {(_Float16)((acc[rb].z + lo[rb][2] * 0.0625f) * 0.0625f), (_Float16)((acc[rb].w + lo[rb][3] * 0.0625f) * 0.0625f)};
            *(u32x2*)(ap + rb * 16 + 4 * g) = (u32x2){__builtin_bit_cast(unsigned, p0), __builtin_bit_cast(unsigned, p1)}; }
    }
}
__device__ __forceinline__ void peer_u_phase(const Params& P, int vw, int nw, int lane, LAS unsigned char* wl) {
    const int n = (T * 8 - vw + nw - 1) / nw, x = vw & 7;
    if (n <= 0) return;
    const unsigned char* eu8 = P.ws + WS_EU8 + (size_t)x * NEXP * 128;
    const int nu = 2 * n;
#define UTOK(u) ((((u) >> 1) < n ? vw + ((u) >> 1) * nw : vw) >> 3)
    const LAS unsigned char* ra[4];
    { const unsigned c = (unsigned)lane & 15u, g = (unsigned)lane >> 4, swz = (c >> 1) & 7u, hf0 = g & 1u; const LAS unsigned char* rowp = wl + c * 128;
      ra[0] = rowp + (((2u * g) ^ swz) * 16u + hf0 * 8u); ra[1] = rowp + (((2u * g) ^ swz) * 16u + (hf0 ^ 1u) * 8u); ra[2] = rowp + (((2u * g + 1u) ^ swz) * 16u + hf0 * 8u); ra[3] = rowp + (((2u * g + 1u) ^ swz) * 16u + (hf0 ^ 1u) * 8u); }
    UE E0, E1; UB B0, B1; URing R; unsigned r0, r1;
    r0 = u_load_raw(P, UTOK(0), 0, lane); r1 = u_load_raw(P, UTOK(1), 1, lane); u_load_b(P, UTOK(0), x, lane, B0);
    u_expand(lane, r0, E0); u_expand(lane, r1, E1);
    r0 = u_load_raw(P, UTOK(2), 0, lane); r1 = u_load_raw(P, UTOK(3), 1, lane);
    u_step<false>(eu8, lane, R, E0, wl);
    for (int u = 0; u < nu; u += 2) {
        u_load_b(P, UTOK(u + 1), x, lane, B1);
        u_expand(lane, r0, E0); r0 = u_load_raw(P, UTOK(u + 4), 0, lane);
        __builtin_amdgcn_sched_barrier(0);
        u_step<true>(eu8, lane, R, E1, wl);
        __builtin_amdgcn_sched_barrier(0);
        u_compute(P, x, 0, lane, B0, ra);
        __builtin_amdgcn_sched_barrier(0);
        u_load_b(P, UTOK(u + 2), x, lane, B0);
        u_expand(lane, r1, E1); r1 = u_load_raw(P, UTOK(u + 5), 1, lane);
        __builtin_amdgcn_sched_barrier(0);
        u_step<true>(eu8, lane, R, E0, wl);
        __builtin_amdgcn_sched_barrier(0);
        u_compute(P, x, 1, lane, B1, ra);
        __builtin_amdgcn_sched_barrier(0);
    }
#undef UTOK
}
__device__ __forceinline__ void peer_w_phase(const Params& P, size_t gt, size_t nt) {
    unsigned* eidx = (unsigned*)(P.ws + WS_EIDX); unsigned* gate = (unsigned*)(P.ws + WS_GATE); const unsigned short* ap = (const unsigned short*)(P.ws + WS_APART);
    const float* sui = (const float*)(P.ws + WS_SUI); const float* svi = (const float*)(P.ws + WS_SVI);
    const size_t N = (size_t)T * 32;
    u32x2 wn[8]; u32x4 en, gn;
#define W_LOAD(i_) do { _Pragma("unroll") for (int xx_ = 0; xx_ < 8; ++xx_) wn[xx_] = *(const u32x2*)(ap + (size_t)xx_ * T * 128 + (i_) * 4); en = *(const u32x4*)(eidx + (i_) * 4); gn = *(const u32x4*)(gate + (i_) * 4); } while (0)
    if (gt < N) W_LOAD(gt);
    for (size_t i = gt; i < N; i += nt) {
        f32x4 a = {0.f, 0.f, 0.f, 0.f};
#pragma unroll
        for (int xx = 0; xx < 8; ++xx) { const unsigned wx = wn[xx].x, wy = wn[xx].y;
            const h2_t f0 = __builtin_bit_cast(h2_t, wx), f1 = __builtin_bit_cast(h2_t, wy);
            a.x += (float)f0.x; a.y += (float)f0.y; a.z += (float)f1.x; a.w += (float)f1.y; }
        const u32x4 e = en; const u32x4 g = gn;
        float su[4], sv[4];
#pragma unroll
        for (int k = 0; k < 4; ++k) { su[k] = sui[e[k]]; sv[k] = svi[e[k]]; }
        { const size_t in = i + nt < N ? i + nt : i; W_LOAD(in); }
        a = a * 16.0f;
        u32x4 wo, eo;
#pragma unroll
        for (int k = 0; k < 4; ++k) { const unsigned gk = g[k]; const float w = __builtin_bit_cast(float, gk) * gelu_exact(a[k] * su[k]);
            const unsigned h = (unsigned)__builtin_bit_cast(unsigned short, (_Float16)w); wo[k] = h | (h << 16);
            eo[k] = ((unsigned)e[k] << 7) | __builtin_bit_cast(unsigned, sv[k]); }
        *(u32x4*)(gate + i * 4) = wo; *(u32x4*)(eidx + i * 4) = eo; }
#undef W_LOAD
}
#ifndef V_SCALE_MASK
#define V_SCALE_MASK 0
#endif
struct VHalf { u32x4 e0, e1, w0, w1; };
struct VRaw { unsigned e, w; };
struct VRing { u32x4 rv[8]; };
__device__ __forceinline__ void v_load_raw(const Params& P, int t, int half, int lane, VRaw& r) {
    r.e = ((const unsigned*)(P.ws + WS_EIDX))[(size_t)t * 128 + 64 * half + lane]; r.w = ((const unsigned*)(P.ws + WS_GATE))[(size_t)t * 128 + 64 * half + lane];
}
__device__ __forceinline__ void v_expand(int lane, const VRaw& r, VHalf& H) {
    const int base = (lane & 56) * 4;
#pragma unroll
    for (int i = 0; i < 4; ++i) { H.e0[i] = (unsigned)__builtin_amdgcn_ds_bpermute(base + 4 * i, (int)r.e); H.e1[i] = (unsigned)__builtin_amdgcn_ds_bpermute(base + 16 + 4 * i, (int)r.e);
        H.w0[i] = (unsigned)__builtin_amdgcn_ds_bpermute(base + 4 * i, (int)r.w); H.w1[i] = (unsigned)__builtin_amdgcn_ds_bpermute(base + 16 + 4 * i, (int)r.w); }
}
template <bool COMPUTE> __device__ __forceinline__ void v_step(const unsigned char* ev8, int lane, VRing& R, const VHalf& Hc, const VHalf& Hn, h2_t (&acc)[8]) {
    const unsigned sub16 = (unsigned)(lane & 7) * 16u;
#pragma unroll
    for (int i = 0; i < 8; ++i) {
        if (COMPUTE) { const unsigned ec = i < 4 ? Hc.e0[i & 3] : Hc.e1[i & 3], wc = i < 4 ? Hc.w0[i & 3] : Hc.w1[i & 3]; const h2_t w2 = __builtin_bit_cast(h2_t, wc);
            const float sc = __builtin_bit_cast(float, V_SCALE_MASK ? (ec & 0x7f800000u) : ec);
#pragma unroll
            for (int q = 0; q < 4; ++q) { const h2_t lo = __builtin_amdgcn_cvt_scalef32_pk_f16_fp8((int)R.rv[i][q], sc, false), hi = __builtin_amdgcn_cvt_scalef32_pk_f16_fp8((int)R.rv[i][q], sc, true);
                acc[2 * q] = __builtin_elementwise_fma(lo, w2, acc[2 * q]); acc[2 * q + 1] = __builtin_elementwise_fma(hi, w2, acc[2 * q + 1]); } }
        const unsigned en = i < 4 ? Hn.e0[i & 3] : Hn.e1[i & 3];
        R.rv[i] = *(const u32x4*)(ev8 + ((en & 0x1fff80u) | sub16));
        __builtin_amdgcn_sched_barrier(0);
    }
}
__device__ __forceinline__ h2_t h2_xor8(h2_t v) { return v + __builtin_bit_cast(h2_t, __builtin_amdgcn_update_dpp(0, __builtin_bit_cast(int, v), 0x128, 0xf, 0xf, false)); }
__device__ __forceinline__ h2_t h2_xor16(h2_t v) { return v + __builtin_bit_cast(h2_t, __builtin_amdgcn_ds_swizzle(__builtin_bit_cast(int, v), 0x401F)); }
__device__ __forceinline__ h2_t h2_xor32(h2_t v) { return v + __builtin_bit_cast(h2_t, __builtin_amdgcn_ds_bpermute((int)((threadIdx.x & 63u) ^ 32u) * 4, __builtin_bit_cast(int, v))); }
__device__ __forceinline__ void v_finish(const Params& P, int x, int lane, int t, h2_t (&acc)[8]) {
    const int sub = lane & 7, gl = lane >> 3;
    unsigned w[8];
#pragma unroll
    for (int k = 0; k < 8; ++k) { const h2_t v = h2_xor32(h2_xor16(h2_xor8(acc[k]))); w[k] = __builtin_bit_cast(unsigned, v); acc[k] = (h2_t){(_Float16)0.f, (_Float16)0.f}; }
    if (gl == 0) { unsigned short* op = (unsigned short*)(P.ws + WS_PEER) + (size_t)t * D + x * 128 + sub * 16;
        *(u32x4*)op = (u32x4){w[0], w[1], w[2], w[3]}; *(u32x4*)(op + 8) = (u32x4){w[4], w[5], w[6], w[7]}; }
}
__device__ __forceinline__ void peer_v_phase(const Params& P, int vw, int nw, int lane) {
    const int n = (T * 8 - vw + nw - 1) / nw, x = vw & 7;
    if (n <= 0) return;
    const unsigned char* ev8 = P.ws + WS_EV8 + (size_t)x * NEXP * 128;
#define VTOK(u) ((((u) >> 1) < n ? vw + ((u) >> 1) * nw : vw) >> 3)
    VHalf A0, A1, B0, B1; VRaw ra, rb; VRing R0, R1; h2_t acc[8];
#pragma unroll
    for (int k = 0; k < 8; ++k) acc[k] = (h2_t){(_Float16)0.f, (_Float16)0.f};
    v_load_raw(P, VTOK(0), 0, lane, ra); v_load_raw(P, VTOK(1), 1, lane, rb); v_expand(lane, ra, A0); v_expand(lane, rb, B0);
    v_load_raw(P, VTOK(2), 0, lane, ra); v_load_raw(P, VTOK(3), 1, lane, rb);
    v_step<false>(ev8, lane, R0, A0, A0, acc); v_step<false>(ev8, lane, R1, B0, B0, acc);
    v_expand(lane, ra, A1); v_expand(lane, rb, B1);
    v_load_raw(P, VTOK(4), 0, lane, ra); v_load_raw(P, VTOK(5), 1, lane, rb);
#define V_PAIR(Ac, An, Bc, Bn, u_) do { \
        v_step<true>(ev8, lane, R0, Ac, An, acc); v_expand(lane, ra, Ac); v_load_raw(P, VTOK((u_) + 6), 0, lane, ra); __builtin_amdgcn_sched_barrier(0); \
        v_step<true>(ev8, lane, R1, Bc, Bn, acc); v_expand(lane, rb, Bc); v_load_raw(P, VTOK((u_) + 7), 1, lane, rb); __builtin_amdgcn_sched_barrier(0); \
        v_finish(P, x, lane, VTOK(u_), acc); } while (0)
    int u = 0;
    for (; u + 4 <= 2 * n; u += 4) { V_PAIR(A0, A1, B0, B1, u); V_PAIR(A1, A0, B1, B0, u + 2); }
    if (u < 2 * n) V_PAIR(A0, A1, B0, B1, u);
#undef V_PAIR
#undef VTOK
}
__device__ __forceinline__ void final_norm(const Params& P, int gw, int nw, int lane) {
    const unsigned short* peer = (const unsigned short*)(P.ws + WS_PEER); const float* mod = (const float*)(P.ws + WS_MOD);
    f32x4 gf[4];
#pragma unroll
    for (int j = 0; j < 4; ++j) gf[j] = *(const f32x4*)(P.g_final + lane * 4 + 256 * j);
    const bf16_t* x2b = (const bf16_t*)(P.ws + WS_X2B);
    f32x4 gn[4]; u32x2 xn[4], pn[4];
    auto load_row = [&](int row) { const u32x2* xr = (const u32x2*)(x2b + (size_t)row * D) + lane; const u32x2* pr = (const u32x2*)(peer + (size_t)row * D) + lane; const f32x4* gr = (const f32x4*)(mod + (size_t)(row / SEQ) * 6144 + 5 * D) + lane;
#pragma unroll
        for (int j = 0; j < 4; ++j) { xn[j] = xr[64 * j]; pn[j] = pr[64 * j]; gn[j] = gr[64 * j]; } };
    if (gw < T) load_row(gw);
    for (int row = gw; row < T; row += nw) { f32x4 v[4]; float ss = 0.f;
#pragma unroll
        for (int j = 0; j < 4; ++j) { const unsigned px = pn[j].x, py = pn[j].y; const h2_t p01 = __builtin_bit_cast(h2_t, px), p23 = __builtin_bit_cast(h2_t, py);
            v[j].x = bflo(xn[j].x) + gn[j].x * (float)p01.x; v[j].y = bfhi(xn[j].x) + gn[j].y * (float)p01.y; v[j].z = bflo(xn[j].y) + gn[j].z * (float)p23.x; v[j].w = bfhi(xn[j].y) + gn[j].w * (float)p23.y; }
        load_row(row + nw < T ? row + nw : row);
#pragma unroll
        for (int j = 0; j < 4; ++j) ss += (v[j].x * v[j].x + v[j].y * v[j].y) + (v[j].z * v[j].z + v[j].w * v[j].w);
        const float rstd = 1.0f / sqrtf(wave_sum(ss) * (1.f / D) + EPS);
        f32x4* xo = (f32x4*)(P.out + (size_t)row * D) + lane;
#pragma unroll
        for (int j = 0; j < 4; ++j) xo[64 * j] = v[j] * rstd * gf[j]; }
}

constexpr int RT_SKSTR = 136;
constexpr int RT_LDS = 2 * 128 * RT_SKSTR * 2;
__device__ __forceinline__ void ce_desc(float& a, float& b) { const float hi = fmaxf(a, b), lo = fminf(a, b); a = hi; b = lo; }
template <int K, int J> __device__ __forceinline__ void bstep(float (&a)[16]) {
#pragma unroll
    for (int i = 0; i < 16; ++i) { const int l = i ^ J; if (l > i) { if ((i & K) == 0) ce_desc(a[i], a[l]); else ce_desc(a[l], a[i]); } }
}
__device__ __forceinline__ void sort16_desc(float (&a)[16]) {
    ce_desc(a[0], a[13]); ce_desc(a[1], a[12]); ce_desc(a[2], a[15]); ce_desc(a[3], a[14]); ce_desc(a[4], a[8]); ce_desc(a[5], a[6]); ce_desc(a[7], a[11]); ce_desc(a[9], a[10]);
    ce_desc(a[0], a[5]); ce_desc(a[1], a[7]); ce_desc(a[2], a[9]); ce_desc(a[3], a[4]); ce_desc(a[6], a[13]); ce_desc(a[8], a[14]); ce_desc(a[10], a[15]); ce_desc(a[11], a[12]);
    ce_desc(a[0], a[1]); ce_desc(a[2], a[3]); ce_desc(a[4], a[5]); ce_desc(a[6], a[8]); ce_desc(a[7], a[9]); ce_desc(a[10], a[11]); ce_desc(a[12], a[13]); ce_desc(a[14], a[15]);
    ce_desc(a[0], a[2]); ce_desc(a[1], a[3]); ce_desc(a[4], a[10]); ce_desc(a[5], a[11]); ce_desc(a[6], a[7]); ce_desc(a[8], a[9]); ce_desc(a[12], a[14]); ce_desc(a[13], a[15]);
    ce_desc(a[1], a[2]); ce_desc(a[3], a[12]); ce_desc(a[4], a[6]); ce_desc(a[5], a[7]); ce_desc(a[8], a[10]); ce_desc(a[9], a[11]); ce_desc(a[13], a[14]);
    ce_desc(a[1], a[4]); ce_desc(a[2], a[6]); ce_desc(a[5], a[8]); ce_desc(a[7], a[10]); ce_desc(a[9], a[13]); ce_desc(a[11], a[14]);
    ce_desc(a[2], a[4]); ce_desc(a[3], a[6]); ce_desc(a[9], a[12]); ce_desc(a[11], a[13]);
    ce_desc(a[3], a[5]); ce_desc(a[6], a[8]); ce_desc(a[7], a[9]); ce_desc(a[10], a[12]);
    ce_desc(a[3], a[4]); ce_desc(a[5], a[6]); ce_desc(a[7], a[8]); ce_desc(a[9], a[10]); ce_desc(a[11], a[12]);
    ce_desc(a[6], a[7]); ce_desc(a[8], a[9]);
}
__device__ __forceinline__ void bitonic_merge16_desc(float (&a)[16]) { bstep<16, 8>(a); bstep<16, 4>(a); bstep<16, 2>(a); bstep<16, 1>(a); }
__device__ __forceinline__ void merge_top16(float (&a)[16], const float (&b)[16]) {
#pragma unroll
    for (int i = 0; i < 16; ++i) a[i] = fmaxf(a[i], b[15 - i]);
    bitonic_merge16_desc(a);
}
__device__ __forceinline__ float pack_key1(float v, unsigned cst) { return __builtin_bit_cast(float, (__builtin_bit_cast(unsigned, v) & 0xffffff80u) | cst); }
__device__ __forceinline__ void route_side(const bf16_t* qrow, const LAS unsigned char* sk, int lane, float (&top)[16]) {
    const int r32 = lane & 31, hi = lane >> 5;
    bf16x8 qf[8];
#pragma unroll
    for (int s = 0; s < 8; ++s) qf[s] = *(const bf16x8*)(qrow + 16 * s + 8 * hi);
    const unsigned hi4 = 4u * (unsigned)hi;
    float run[16];
#pragma unroll
    for (int kb = 0; kb < 4; ++kb) { f32x16 acc; float g[16];
#pragma unroll
        for (int r = 0; r < 16; ++r) acc[r] = 0.f;
#pragma unroll
        for (int s = 0; s < 8; ++s) { const bf16x8 kf = *(const LAS bf16x8*)(sk + ((32 * kb + r32) * RT_SKSTR + 16 * s + 8 * hi) * 2); acc = __builtin_amdgcn_mfma_f32_32x32x16_bf16(kf, qf[s], acc, 0, 0, 0); }
#pragma unroll
        for (int r = 0; r < 16; ++r) g[r] = pack_key1(acc[r], (unsigned)(32 * kb + crow(r, 0)));
        sort16_desc(g);
        if (kb == 0) {
#pragma unroll
            for (int r = 0; r < 16; ++r) run[r] = g[r];
        } else merge_top16(run, g);
        __builtin_amdgcn_sched_barrier(0);
    }
#pragma unroll
    for (int i = 0; i < 16; ++i) run[i] = __builtin_bit_cast(float, __builtin_bit_cast(unsigned, run[i]) | hi4);
    float pb[16]; const int pa = (lane ^ 32) * 4;
#pragma unroll
    for (int i = 0; i < 16; ++i) pb[i] = __builtin_bit_cast(float, __builtin_amdgcn_ds_bpermute(pa, __builtin_bit_cast(int, run[i])));
#pragma unroll
    for (int i = 0; i < 16; ++i) top[i] = run[i];
    merge_top16(top, pb);
}
__device__ __forceinline__ void route_unit(const Params& P, int unit, int lane, const LAS unsigned char* sklds, LAS unsigned char* keylds) {
    const bf16_t* QP = (const bf16_t*)(P.ws + WS_PROJ); int* eidx = (int*)(P.ws + WS_EIDX); float* gate = (float*)(P.ws + WS_GATE);
    const int tile = unit >> 2, hp = unit & 3, r32 = lane & 31, hi = lane >> 5;
    const size_t t = (size_t)tile * 32 + r32; const bf16_t* qt = QP + t * 2048;
    float A0[16], A1[16], B0[16], B1[16];
    PSEC_BEGIN(1);
    route_side(qt + (2 * hp) * 256, sklds, lane, A0); __builtin_amdgcn_sched_barrier(0); route_side(qt + (2 * hp) * 256 + 128, sklds + 128 * RT_SKSTR * 2, lane, A1); __builtin_amdgcn_sched_barrier(0);
    route_side(qt + (2 * hp + 1) * 256, sklds, lane, B0); __builtin_amdgcn_sched_barrier(0); route_side(qt + (2 * hp + 1) * 256 + 128, sklds + 128 * RT_SKSTR * 2, lane, B1); __builtin_amdgcn_sched_barrier(0);
    PSEC_END(1);
    PSEC_BEGIN(2);
    float L0[16], L1[16];
#pragma unroll
    for (int i = 0; i < 16; ++i) { L0[i] = hi ? B0[i] : A0[i]; L1[i] = hi ? B1[i] : A1[i]; }
    const int h = 2 * hp + hi;
#define RT_CAND(i_, j_) __builtin_bit_cast(float, (__builtin_bit_cast(unsigned, L0[i_] + L1[j_]) & 0xffffff00u) | (unsigned)(255 - ((i_) * 16 + (j_))))
    float best[16], x1[16], x2[16], x3[16];
#pragma unroll
    for (int j = 0; j < 16; ++j) best[j] = RT_CAND(0, j);
#pragma unroll
    for (int j = 0; j < 8; ++j) { x1[j] = RT_CAND(1, j); x1[15 - j] = RT_CAND(8 + j, 0); }
    bitonic_merge16_desc(x1);
    x2[0] = RT_CAND(2, 0); x2[1] = RT_CAND(2, 1); x2[2] = RT_CAND(2, 2); x2[3] = RT_CAND(2, 3); x2[4] = RT_CAND(2, 4); x2[5] = RT_CAND(3, 0); x2[6] = RT_CAND(3, 1); x2[7] = RT_CAND(3, 2);
    x2[8] = RT_CAND(3, 3); x2[9] = RT_CAND(4, 0); x2[10] = RT_CAND(4, 1); x2[11] = RT_CAND(4, 2); x2[12] = RT_CAND(5, 0); x2[13] = RT_CAND(5, 1); x2[14] = RT_CAND(6, 0); x2[15] = RT_CAND(6, 1);
    sort16_desc(x2);
    x3[0] = RT_CAND(7, 0); x3[1] = RT_CAND(7, 1);
#pragma unroll
    for (int j = 2; j < 16; ++j) x3[j] = -INFINITY;
    merge_top16(best, x1); merge_top16(best, x2); merge_top16(best, x3);
#undef RT_CAND
    { unsigned w[8];
#pragma unroll
      for (int q = 0; q < 4; ++q) { w[q] = (__builtin_bit_cast(unsigned, L0[4 * q]) & 0x7fu) | ((__builtin_bit_cast(unsigned, L0[4 * q + 1]) & 0x7fu) << 8) | ((__builtin_bit_cast(unsigned, L0[4 * q + 2]) & 0x7fu) << 16) | ((__builtin_bit_cast(unsigned, L0[4 * q + 3]) & 0x7fu) << 24);
          w[4 + q] = (__builtin_bit_cast(unsigned, L1[4 * q]) & 0x7fu) | ((__builtin_bit_cast(unsigned, L1[4 * q + 1]) & 0x7fu) << 8) | ((__builtin_bit_cast(unsigned, L1[4 * q + 2]) & 0x7fu) << 16) | ((__builtin_bit_cast(unsigned, L1[4 * q + 3]) & 0x7fu) << 24); }
      *(LAS u32x4*)(keylds) = (u32x4){w[0], w[1], w[2], w[3]}; *(LAS u32x4*)(keylds + 16) = (u32x4){w[4], w[5], w[6], w[7]}; }
    float e[16]; int ids[16]; float ssum = 0.f;
#pragma unroll
    for (int r = 0; r < 16; ++r) { const unsigned code = 255u - (__builtin_bit_cast(unsigned, best[r]) & 0xffu);
        ids[r] = (int)((unsigned)keylds[code >> 4] * 128u + (unsigned)keylds[16 + (code & 15u)]);
        e[r] = __expf(best[r] - best[0]); ssum += e[r]; }
    const float inv = 1.f / ssum;
#pragma unroll
    for (int r4 = 0; r4 < 4; ++r4) {
        *(u32x4*)(eidx + t * 128 + 16 * h + 4 * r4) = (u32x4){(unsigned)ids[4 * r4], (unsigned)ids[4 * r4 + 1], (unsigned)ids[4 * r4 + 2], (unsigned)ids[4 * r4 + 3]};
        *(f32x4*)(gate + t * 128 + 16 * h + 4 * r4) = (f32x4){e[4 * r4] * inv, e[4 * r4 + 1] * inv, e[4 * r4 + 2] * inv, e[4 * r4 + 3] * inv}; }
    PSEC_END(2);
}
__device__ __forceinline__ void route_phase(const Params& P, LAS unsigned char* lds, int tid, int gw, int nw) {
    const bf16_t* SK = (const bf16_t*)(P.ws + WS_SK);
    for (int i = tid; i < 2 * 128 * 16; i += 512) { const int row = i >> 4, ch = i & 15; *(LAS u32x4*)(lds + (row * RT_SKSTR + ch * 8) * 2) = *(const u32x4*)(SK + row * 128 + ch * 8); }
    __syncthreads();
    for (int u = gw; u < (T / 32) * 4; u += nw) route_unit(P, u, tid & 63, lds, lds + RT_LDS + (tid >> 6) * 2048 + (tid & 63) * 32);
}

#define XB_TMO      128
#define XB_XCNT(j)  (256  + 64 * (j))
#define XB_XSUB(j)  (1280 + 64 * (j))
#define XB_XGEN(j)  (2304 + 64 * (j))
#define XB_TOP      3328
#define XB_TOPGEN   3392
#define XCD_BAR_WORDS 3456
#define XB_SPIN_CAP (1u << 18)

__device__ __forceinline__ unsigned xb_ld(unsigned* p)              { return __hip_atomic_load(p, __ATOMIC_RELAXED, __HIP_MEMORY_SCOPE_AGENT); }
__device__ __forceinline__ unsigned xb_add(unsigned* p, unsigned v) { return __hip_atomic_fetch_add(p, v, __ATOMIC_RELAXED, __HIP_MEMORY_SCOPE_AGENT); }
__device__ __forceinline__ unsigned xb_xcc_id() { return (unsigned)__builtin_amdgcn_s_getreg((3 << 11) | 20) & 0xFu; }
#define XB_SPIN(cond, bar) do { unsigned _sp = 0; while (cond) { __builtin_amdgcn_s_sleep(1); \
    if ((++_sp & 255u) == 0u) { if (xb_ld(&(bar)[XB_TMO])) break; if (_sp > XB_SPIN_CAP) { atomicAdd(&(bar)[XB_TMO], 1u); break; } } } } while (0)

struct XcdBarrier {
    unsigned* bar; unsigned x;
    volatile PG8_LAS unsigned* st;
};

__device__ __forceinline__ XcdBarrier xcd_barrier_post(unsigned* bar, volatile PG8_LAS unsigned* st) {
    XcdBarrier b; b.bar = bar; b.x = xb_xcc_id(); b.st = st;
    if (threadIdx.x == 0) st[2] = xb_add(&bar[XB_XCNT(b.x)], 1u);
    return b;
}
__device__ __forceinline__ void xcd_barrier_complete(unsigned* bar, unsigned x, unsigned& nloc, unsigned& nx) {
    const unsigned G = gridDim.x * gridDim.y * gridDim.z;
    unsigned sum, cnt, mine, sp = 0u;
    for (;;) {
        sum = 0u; cnt = 0u; mine = 0u;
#pragma unroll
        for (unsigned j = 0; j < 16; ++j) { const unsigned c = xb_ld(&bar[XB_XCNT(j)]); sum += c; cnt += (c > 0u) ? 1u : 0u; mine = (j == x) ? c : mine; }
        if (sum == G) break;
        __builtin_amdgcn_s_sleep(1);
        if ((++sp & 255u) == 0u) { if (xb_ld(&bar[XB_TMO])) break; if (sp > XB_SPIN_CAP) { atomicAdd(&bar[XB_TMO], 1u); break; } }
    }
    nloc = mine > 0u ? mine : 1u; nx = cnt > 0u ? cnt : 1u;
}

__device__ __forceinline__ void xcd_barrier(const XcdBarrier& b) {
    asm volatile("s_waitcnt vmcnt(0)" ::: "memory");
    __syncthreads();
    if (threadIdx.x == 0) {
        unsigned* bar = b.bar;
        __builtin_amdgcn_s_waitcnt(0);
        unsigned nloc = b.st[0], nx = b.st[1];
        if (nloc == 0u) { xcd_barrier_complete(bar, b.x, nloc, nx); b.st[0] = nloc; b.st[1] = nx; }
        const unsigned old = xb_add(&bar[XB_XSUB(b.x)], 1u);
        const unsigned gen = old / nloc;
        if (old + 1u == (gen + 1u) * nloc) {
            __builtin_amdgcn_fence(__ATOMIC_RELEASE, "agent");
            asm volatile("s_waitcnt vmcnt(0)" ::: "memory");
            const unsigned og = xb_add(&bar[XB_TOP], 1u);
            const unsigned tg = og / nx;
            if (og + 1u == (tg + 1u) * nx) xb_add(&bar[XB_TOPGEN], 1u);
            else XB_SPIN(xb_ld(&bar[XB_TOPGEN]) == tg, bar);
            __builtin_amdgcn_fence(__ATOMIC_ACQUIRE, "agent");
            xb_add(&bar[XB_XGEN(b.x)], 1u);
            asm volatile("s_waitcnt vmcnt(0)" ::: "memory");
        } else {
            XB_SPIN(xb_ld(&bar[XB_XGEN(b.x)]) == gen, bar);
            __builtin_amdgcn_fence(__ATOMIC_ACQUIRE, "agent");
            asm volatile("s_waitcnt vmcnt(0)" ::: "memory");
        }
    }
    __syncthreads();
}

namespace cg = cooperative_groups;
constexpr int LDS_BYTES = 147456;
constexpr int CENSUS_OFF = 131072 + 8192;
struct KArgs { Params P; int ph_lo, ph_hi; };
__global__ void __launch_bounds__(512, 2) mk_fwd(KArgs ka) {
    extern __shared__ __attribute__((aligned(16))) unsigned char lds[];
    const Params& P = ka.P;
    cg::grid_group grid = cg::this_grid();
    PG8_LAS unsigned char* glds = (PG8_LAS unsigned char*)lds;
    if (threadIdx.x < 16) ((PG8_LAS volatile unsigned*)(glds + CENSUS_OFF))[threadIdx.x] = 0u;
    if (PROBE_SEC != 0 && threadIdx.x == 0) *PSEC_WORD = 0ull;
    __syncthreads();
    const XcdBarrier xbar = xcd_barrier_post((unsigned*)(ka.P.ws + WS_CTL), (PG8_LAS volatile unsigned*)(glds + CENSUS_OFF));
#define IDS() int tid_ = threadIdx.x; asm volatile("" : "+v"(tid_)); const int lane = tid_ & 63, wave = __builtin_amdgcn_readfirstlane(tid_ >> 6); \
    const int G = gridDim.x, gw = blockIdx.x * 8 + wave, nw = G * 8; const size_t gt = (size_t)blockIdx.x * 512 + tid_, nt = (size_t)G * 512; (void)lane; (void)gw; (void)nw; (void)gt; (void)nt;
#define IN(k) (ka.ph_lo <= (k) && (k) < ka.ph_hi)
#define STAMP(k) do { if (PROBE_MASK != 0u && blockIdx.x == 0 && threadIdx.x == 0) ((PG8_LAS volatile unsigned long long*)(glds + CENSUS_OFF + 64))[k] = PROBE_CLK ? __builtin_amdgcn_s_memtime() : __builtin_amdgcn_s_memrealtime(); } while (0)
    STAMP(0);
#define SYNC(k) do { if (IN(k) && IN((k) + 1)) { if ((k) == 0) grid.sync(); else xcd_barrier(xbar); } STAMP((k) + 1); } while (0)
#define WSP(T_, off) ((T_*)(P.ws + (off)))
    if (IN(0)) { IDS(); for (int nc = (int)blockIdx.x; nc < 24; nc += G) p0_mod_block(P, nc, wave, lane, tid_, (float*)lds); p0_prologue(P, wave * G + (int)blockIdx.x, nw, lane, (float*)(lds + wave * 8448)); }
    SYNC(0);
    if (IN(1)) { IDS(); rownorm_pass<false, false, false>(P, P.x, P.g_norm1, 0, 1, WSP(bf16_t, WS_XN), gw, nw, lane); }
    SYNC(1);
    if (IN(2)) {
        { pg8::Gemm g{WSP(const bf16_t, WS_XN), WSP(const bf16_t, WS_W1T), T, 2048, D, D, D}; pg8::StaticOrder S; S.init(T, 2048, gridDim.x, (int)blockIdx.x);
          epi::EpiStore<3> E{WSP(bf16_t, WS_PROJ), PLD, WSP(float, WS_SSQ), 0, 0.f}; pg8::gemm_phase<epi::EpiStore<3>, pg8::StaticOrder, true, true>(glds, g, S, E); }
        { pg8::Gemm g{WSP(const bf16_t, WS_W1TT), WSP(const bf16_t, WS_XN), 512, T, D, D, D}; pg8::StaticOrder S; S.init(512, T, gridDim.x, (int)blockIdx.x);
          epi::EpiStore<0> E{WSP(bf16_t, WS_PROJT), T, nullptr, 0, 0.f}; pg8::gemm_phase<epi::EpiStore<0>, pg8::StaticOrder, true, true>(glds, g, S, E); }
    }
    SYNC(2);
    if (IN(3)) {
        { pg8::Gemm g{WSP(const bf16_t, WS_PROJ) + PC_QL, WSP(const bf16_t, WS_WUQ), T, 768, 256, PLD, 256}; pg8::StaticOrder S; S.init(T, 768, gridDim.x, (int)blockIdx.x);
          epi::EpiStore<1> E{WSP(bf16_t, WS_Q), 768, WSP(float, WS_SSQ), 0, 1.f / 256.f}; pg8::gemm_phase<epi::EpiStore<1>, pg8::StaticOrder, true, true>(glds, g, S, E); }
        { pg8::Gemm g{WSP(const bf16_t, WS_PROJ) + PC_KVL, WSP(const bf16_t, WS_WK), T, 512, 256, PLD, 256}; pg8::StaticOrder S; S.init(T, 512, gridDim.x, (int)blockIdx.x);
          epi::EpiStore<1> E{WSP(bf16_t, WS_KN), 512, WSP(float, WS_SSQ), 1, 1.f / 128.f}; pg8::gemm_phase<epi::EpiStore<1>, pg8::StaticOrder, true, true>(glds, g, S, E); }
        { pg8::Gemm g{WSP(const bf16_t, WS_WV), WSP(const bf16_t, WS_PROJ) + PC_KVL, 512, T, 256, 256, PLD}; pg8::StaticOrder S; S.init(512, T, gridDim.x, (int)blockIdx.x);
          epi::EpiStore<2> E{WSP(bf16_t, WS_VT), T, WSP(float, WS_SSQ), 1, 1.f / 128.f}; pg8::gemm_phase<epi::EpiStore<2>, pg8::StaticOrder, true, true>(glds, g, S, E); }
        { IDS(); kr_pass(P, gt, nt); for (int i = gw; i < NB * 64 * NH; i += nw) ret_kvc_item(P, i, lane); }
    }
    SYNC(3);
    if (IN(4)) { IDS();
        ret_scan(P, gt, nt);
        __syncthreads();
        attn_phase(P, glds, tid_);
    }
    SYNC(4);
    if (IN(5)) { IDS(); for (int i = gw; i < NB * 64 * NH; i += nw) ret_out_item(P, i, lane, (LAS u32x4*)(glds + wave * 16384)); }
    SYNC(5);
    if (IN(6)) { pg8::Gemm g{WSP(const bf16_t, WS_XN), WSP(const bf16_t, WS_WOUT), T, D, D, D, D}; pg8::StaticOrder S; S.init(T, D, gridDim.x, (int)blockIdx.x);
        epi::EpiResid E{P.x, WSP(const float, WS_MOD), WSP(bf16_t, WS_X2B)}; pg8::gemm_phase<epi::EpiResid, pg8::StaticOrder, true, true>(glds, g, S, E); }
    SYNC(6);
    if (IN(7)) { IDS(); rownorm_pass<false, true, true>(P, WSP(const bf16_t, WS_X2B), P.g_norm2, 3, 4, WSP(bf16_t, WS_XN), gw, nw, lane); }
    SYNC(7);
    if (IN(8)) { pg8::Gemm g{WSP(const bf16_t, WS_XN), WSP(const bf16_t, WS_WQ), T, 2048, D, D, D}; pg8::StaticOrder S; S.init(T, 2048, gridDim.x, (int)blockIdx.x);
        epi::EpiStore<0> E{WSP(bf16_t, WS_PROJ), 2048, nullptr, 0, 0.f}; pg8::gemm_phase<epi::EpiStore<0>, pg8::StaticOrder, true, true>(glds, g, S, E); }
    SYNC(8);
    if (IN(9)) { IDS(); route_phase(P, glds, tid_, gw, nw); }
    SYNC(9);
#define SLICE_MAP() int vb = (int)blockIdx.x; { bool even = (G % 8) == 0; for (int j = 0; j < 8; ++j) even = even && (xb_ld((unsigned*)(P.ws + WS_CTL) + XB_XCNT(j)) == (unsigned)(G / 8)); \
        if (even) vb = (int)(((PG8_LAS volatile unsigned*)(glds + CENSUS_OFF))[2] * 8u + (xbar.x & 7u)); } const int vw = wave * G + vb;
    if (IN(10)) { IDS(); SLICE_MAP(); peer_u_phase(P, vw, nw, lane, glds + wave * 8192); }
    SYNC(10);
    if (IN(11)) { IDS(); peer_w_phase(P, gt, nt); }
    SYNC(11);
    if (IN(12)) { IDS(); SLICE_MAP(); peer_v_phase(P, vw, nw, lane); }
    SYNC(12);
    if (IN(13)) { IDS(); final_norm(P, gw, nw, lane); }
    if (PROBE_MASK != 0u && blockIdx.x == 0 && threadIdx.x == 0) {
        const unsigned long long tend = __builtin_amdgcn_s_memrealtime(); ((PG8_LAS volatile unsigned long long*)(glds + CENSUS_OFF + 64))[14] = PROBE_CLK ? __builtin_amdgcn_s_memtime() : tend;
        unsigned long long extra = 0;
        for (int k = 0; k < 14; ++k) if ((PROBE_MASK >> k) & 1u) extra += ((PG8_LAS volatile unsigned long long*)(glds + CENSUS_OFF + 64))[k + 1] - ((PG8_LAS volatile unsigned long long*)(glds + CENSUS_OFF + 64))[k];
        extra = PROBE_CLK ? extra * PROBE_MULT / 100 : extra * PROBE_MULT;
        if (PROBE_SEC != 0) extra = *PSEC_WORD * PROBE_MULT;
        while (__builtin_amdgcn_s_memrealtime() - tend < extra) __builtin_amdgcn_s_sleep(8);
    }
#undef IN
#undef SYNC
#undef IDS
#undef WSP
}

extern "C" void kernel_launch(void* const* d_in, const int* in_sizes, int n_in, void* d_out, int out_size, void* d_ws, size_t ws_size, hipStream_t stream) {
    if (n_in != 19 || out_size != T * D || ws_size < WS_END) { fprintf(stderr, "kernel_launch: unexpected shapes (n_in %d out %d ws %zu)\n", n_in, out_size, ws_size); return; }
    static int grid = 0;
    if (grid == 0) {
        int dev = 0, cus = 0, per_cu = 0;
        if (hipGetDevice(&dev) != hipSuccess || hipDeviceGetAttribute(&cus, hipDeviceAttributeMultiprocessorCount, dev) != hipSuccess) { fprintf(stderr, "kernel_launch: device query failed\n"); grid = -1; return; }
        if (hipFuncSetAttribute((const void*)mk_fwd, hipFuncAttributeMaxDynamicSharedMemorySize, LDS_BYTES) != hipSuccess) { fprintf(stderr, "kernel_launch: hipFuncSetAttribute failed\n"); grid = -1; return; }
        if (hipOccupancyMaxActiveBlocksPerMultiprocessor(&per_cu, (const void*)mk_fwd, 512, LDS_BYTES) != hipSuccess || per_cu < 1) { fprintf(stderr, "kernel_launch: occupancy query failed (%d)\n", per_cu); (void)hipGetLastError(); per_cu = 1; }
        grid = cus * (per_cu > 1 ? 1 : per_cu);
    }
    if (grid < 0) return;
    KArgs ka{};
    Params& P = ka.P;
    P.x = (const float*)d_in[0]; P.c = (const float*)d_in[1]; P.positions = (const int*)d_in[2]; P.w_ada = (const float*)d_in[3]; P.b_ada = (const float*)d_in[4];
    P.g_norm1 = (const float*)d_in[5]; P.w_in = (const float*)d_in[6]; P.g_q_norm = (const float*)d_in[7]; P.w_uq = (const float*)d_in[8]; P.g_kv_norm = (const float*)d_in[9];
    P.w_ukv = (const float*)d_in[10]; P.g_ret_norm = (const float*)d_in[11]; P.w_out = (const float*)d_in[12]; P.g_norm2 = (const float*)d_in[13]; P.w_query = (const float*)d_in[14];
    P.sub_keys = (const float*)d_in[15]; P.expert_u = (const float*)d_in[16]; P.expert_v = (const float*)d_in[17]; P.g_final = (const float*)d_in[18];
    P.out = (float*)d_out; P.ws = (unsigned char*)d_ws;
    ka.ph_lo = 0; ka.ph_hi = 14;
    if (hipMemsetAsync((char*)d_ws + WS_CTL, 0, 65536, stream) != hipSuccess) { fprintf(stderr, "kernel_launch: memset failed\n"); return; }
    void* args[] = {&ka};
    const hipError_t e = hipLaunchCooperativeKernel((const void*)mk_fwd, dim3(grid), dim3(512), args, LDS_BYTES, stream);
    if (e != hipSuccess) fprintf(stderr, "kernel_launch: cooperative launch failed: %s (grid %d)\n", hipGetErrorString(e), grid);
}
```

```cpp
#include <hip/hip_runtime.h>
#include <hip/hip_cooperative_groups.h>
#include <cstdint>
#include <cstdio>

#define PROBE_MASK 0u
#define PROBE_CLK 0
#define PROBE_MULT 1
#define PROBE_SEC 0
#define WAVE_TAB_OFF (131072 + 8192 + 512)
__device__ __forceinline__ unsigned hw_slot() { return (unsigned)__builtin_amdgcn_s_getreg((5 << 11) | 4) & 63u; }
__device__ __forceinline__ int wave_now() { return __builtin_amdgcn_readfirstlane((int)*((__attribute__((address_space(3))) volatile unsigned*)(unsigned)WAVE_TAB_OFF + hw_slot())); }
__device__ __forceinline__ int lane_now() { return (int)__builtin_amdgcn_mbcnt_hi(~0u, __builtin_amdgcn_mbcnt_lo(~0u, 0u)); }
__device__ __forceinline__ int tid_now() { return wave_now() * 64 + lane_now(); }
typedef unsigned short bf16_t;
typedef float f32x4 __attribute__((ext_vector_type(4)));
typedef unsigned u32x4 __attribute__((ext_vector_type(4)));
typedef unsigned u32x2 __attribute__((ext_vector_type(2)));
typedef float f32x2 __attribute__((ext_vector_type(2)));
typedef _Float16 h2_t __attribute__((ext_vector_type(2)));

constexpr int NB = 4, SEQ = 8192, T = NB * SEQ, D = 1024;
constexpr int IN_COLS = 2464;
constexpr int NH = 8;
constexpr int QK = 96, NOPE = 64, ROPE = 32, DV = 64;
constexpr int QR = 256, KVR = 128;
constexpr int NEXP = 16384, PK = 16, NKEYS = 128;
constexpr float EPS = 1e-6f;
constexpr float LOG2E = 1.4426950408889634f;
constexpr float QSCALE = 0.10206207261596575f * LOG2E;

constexpr size_t MiB = 1u << 20;
constexpr size_t WS_CTL = 0;
constexpr size_t WS_MOD = 3 * MiB - 128 * 1024;
constexpr size_t WS_SSQ = 3 * MiB;
constexpr size_t WS_W1T = 4 * MiB;
constexpr size_t WS_W1TT = 8 * MiB;
constexpr size_t WS_WUQ = 10 * MiB;
constexpr size_t WS_WK = 10 * MiB + 512 * 1024;
constexpr size_t WS_WV = 10 * MiB + 768 * 1024;
constexpr size_t WS_WOUT = 11 * MiB;
constexpr size_t WS_WQ = 13 * MiB;
constexpr size_t WS_SK = 17 * MiB;
constexpr size_t WS_EU8 = 18 * MiB;
constexpr size_t WS_EV8 = 34 * MiB;
constexpr size_t WS_SUI = 50 * MiB;
constexpr size_t WS_SVI = 50 * MiB + 65536;
constexpr size_t WS_XN = 82 * MiB;
constexpr size_t WS_PROJ = 146 * MiB;
constexpr size_t WS_PROJT = 274 * MiB;
constexpr size_t WS_Q = 338 * MiB;
constexpr size_t WS_KN = 386 * MiB;
constexpr size_t WS_KR = 418 * MiB;
constexpr size_t WS_VT = 420 * MiB;
constexpr size_t WS_KVC = 452 * MiB;
constexpr size_t WS_END = 484 * MiB;
constexpr size_t WS_PREVB = WS_PROJT + 32 * MiB;
constexpr size_t WS_EIDX = WS_PROJT;
constexpr size_t WS_GATE = WS_PROJT + 16 * MiB;
constexpr size_t WS_H2Q = WS_Q;
constexpr size_t WS_PEER = WS_Q;
constexpr size_t WS_X2B = WS_VT;
constexpr size_t WS_APART = WS_PROJ;

constexpr int PC_QL = 0, PC_KVL = 256, PC_KR = 384, PC_RQ = 512, PC_RK = 1024, PC_RG = 1536, PLD = 2048;
constexpr int PT_RV = 0;

__constant__ float INV64[32] = {1.0f, 0.749894261f, 0.562341332f, 0.421696514f, 0.316227764f, 0.237137377f, 0.177827939f, 0.133352131f, 0.100000001f, 0.0749894157f, 0.0562341325f, 0.0421696529f, 0.0316227749f, 0.0237137377f, 0.0177827943f, 0.0133352149f, 0.00999999978f, 0.00749894185f, 0.00562341325f, 0.00421696482f, 0.00316227763f, 0.00237137359f, 0.00177827943f, 0.00133352145f, 0.00100000005f, 0.000749894243f, 0.000562341302f, 0.000421696517f, 0.000316227757f, 0.00023713737f, 0.00017782794f, 0.00013335215f};

struct Params {
    const float *x, *c; const int* positions; const float *w_ada, *b_ada, *g_norm1, *w_in, *g_q_norm, *w_uq, *g_kv_norm, *w_ukv, *g_ret_norm, *w_out, *g_norm2, *w_query, *sub_keys, *expert_u, *expert_v, *g_final;
    float* out; unsigned char* ws;
};

__device__ __forceinline__ unsigned f2bf(float f) { unsigned u = __builtin_bit_cast(unsigned, f); return (u + 0x7fffu + ((u >> 16) & 1u)) >> 16; }
__device__ __forceinline__ unsigned pk2(float lo, float hi) { return f2bf(lo) | (f2bf(hi) << 16); }
__device__ __forceinline__ float bf2f(unsigned short b) { return __builtin_bit_cast(float, (unsigned)b << 16); }
__device__ __forceinline__ float bflo(unsigned w) { return __builtin_bit_cast(float, w << 16); }
__device__ __forceinline__ float bfhi(unsigned w) { return __builtin_bit_cast(float, w & 0xffff0000u); }
__device__ __forceinline__ float wave_sum(float v) {
#pragma unroll
    for (int o = 1; o < 64; o <<= 1) v += __shfl_xor(v, o);
    return v;
}
__device__ __forceinline__ float silu_f(float v) { return v / (1.f + __expf(-v)); }
__device__ __forceinline__ void sincos_rad(float ang, float& s, float& c) {
    const float CH = 0.15915494f, CL = 3.0918913e-09f;
    const float rh = ang * CH, rl = __builtin_fmaf(ang, CH, -rh) + ang * CL;
    const float fr = (rh - __builtin_floorf(rh)) + rl;
    s = __builtin_amdgcn_sinf(fr); c = __builtin_amdgcn_cosf(fr);
}
__device__ __forceinline__ float gelu_exact(float v) { return 0.5f * v * (1.f + erff(v * 0.70710678118654752f)); }

__device__ __forceinline__ void p0_mod_block(const Params& P, int nc, int wave, int lane, int tid, float* scr) {
    const int n = nc * 256 + lane * 4, k0 = wave * 128;
    float sl[2][4];
#pragma unroll
    for (int hf = 0; hf < 2; ++hf)
#pragma unroll
        for (int b = 0; b < 4; ++b) sl[hf][b] = silu_f(P.c[b * D + k0 + 64 * hf + lane]);
    f32x4 acc[4] = {};
#pragma unroll
    for (int hf = 0; hf < 2; ++hf) {
#pragma unroll 1
        for (int kk0 = 0; kk0 < 64; kk0 += 16) {
            f32x4 w[16];
#pragma unroll
            for (int j = 0; j < 16; ++j) w[j] = *(const f32x4*)(P.w_ada + (size_t)(k0 + 64 * hf + kk0 + j) * 6144 + n);
#pragma unroll
            for (int j = 0; j < 16; ++j)
#pragma unroll
                for (int b = 0; b < 4; ++b) { const float sb = __builtin_bit_cast(float, __builtin_amdgcn_readlane(__builtin_bit_cast(int, sl[hf][b]), kk0 + j)); acc[b] += w[j] * sb; }
        }
    }
#pragma unroll
    for (int b = 0; b < 4; ++b) *(f32x4*)(scr + (wave * 4 + b) * 256 + lane * 4) = acc[b];
    __syncthreads();
    float* mod = (float*)(P.ws + WS_MOD);
    for (int o = tid; o < 1024; o += 512) { const int b = o >> 8, c = o & 255; float sum = P.b_ada[nc * 256 + c];
#pragma unroll
        for (int w = 0; w < 8; ++w) sum += scr[(w * 4 + b) * 256 + c];
        mod[(size_t)b * 6144 + nc * 256 + c] = sum; }
    __syncthreads();
}
__device__ __forceinline__ void p0_transpose_block(const float* W, int ldw, int k0, int n0, bf16_t* dst, int row0, int ldd, const float* kscale, float scale, float* scr, int lane) {
#pragma unroll 8
    for (int i = 0; i < 32; ++i) { const int kk = 2 * i + (lane >> 5); const float ks = kscale ? kscale[k0 + kk] * scale : scale;
        scr[kk * 33 + (lane & 31)] = W[(size_t)(k0 + kk) * ldw + n0 + (lane & 31)] * ks; }
    asm volatile("s_waitcnt vmcnt(0) lgkmcnt(0)" ::: "memory");
    const int c = lane & 7;
#pragma unroll
    for (int j = 0; j < 4; ++j) { const int n = (lane >> 3) + 8 * j; const float* s = scr + (8 * c) * 33 + n;
        u32x4 o; o.x = pk2(s[0 * 33], s[1 * 33]); o.y = pk2(s[2 * 33], s[3 * 33]); o.z = pk2(s[4 * 33], s[5 * 33]); o.w = pk2(s[6 * 33], s[7 * 33]);
        *(u32x4*)(dst + (size_t)(row0 + n) * ldd + k0 + 8 * c) = o; }
    asm volatile("s_waitcnt vmcnt(0) lgkmcnt(0)" ::: "memory");
}
__device__ __forceinline__ void cvt8(const float* src, bf16_t* dst, size_t n8, size_t gt, size_t nt) {
    for (size_t i = gt; i < n8; i += nt) { const f32x4 a = *(const f32x4*)(src + i * 8), b = *(const f32x4*)(src + i * 8 + 4);
        u32x4 o; o.x = pk2(a.x, a.y); o.y = pk2(a.z, a.w); o.z = pk2(b.x, b.y); o.w = pk2(b.z, b.w); *(u32x4*)(dst + i * 8) = o; }
}
__device__ __forceinline__ float wave_max(float v) {
#pragma unroll
    for (int o = 1; o < 64; o <<= 1) v = fmaxf(v, __shfl_xor(v, o));
    return v;
}
__device__ __forceinline__ unsigned pk_fp8x4(float a, float b, float c, float d) { int w = __builtin_amdgcn_cvt_pk_fp8_f32(a, b, 0, false); w = __builtin_amdgcn_cvt_pk_fp8_f32(c, d, w, true); return (unsigned)w; }
__device__ __forceinline__ void p0_expert_fp8(const Params& P, int gw, int nw, int lane) {
    f32x4 n0, n1, n2, n3;
    if (gw < 2 * NEXP) { const float* src = (gw >= NEXP ? P.expert_v + (size_t)(gw - NEXP) * D : P.expert_u + (size_t)gw * D) + lane * 16;
        n0 = *(const f32x4*)src; n1 = *(const f32x4*)(src + 4); n2 = *(const f32x4*)(src + 8); n3 = *(const f32x4*)(src + 12); }
    for (int row = gw; row < 2 * NEXP; row += nw) {
        const bool isv = row >= NEXP; const int e = isv ? row - NEXP : row;
        const f32x4 v0 = n0, v1 = n1, v2 = n2, v3 = n3;
        { const int nr = row + nw < 2 * NEXP ? row + nw : row; const float* src = (nr >= NEXP ? P.expert_v + (size_t)(nr - NEXP) * D : P.expert_u + (size_t)nr * D) + lane * 16;
          n0 = *(const f32x4*)src; n1 = *(const f32x4*)(src + 4); n2 = *(const f32x4*)(src + 8); n3 = *(const f32x4*)(src + 12); }
        float am = fmaxf(fmaxf(fmaxf(fabsf(v0.x), fabsf(v0.y)), fmaxf(fabsf(v0.z), fabsf(v0.w))), fmaxf(fmaxf(fabsf(v1.x), fabsf(v1.y)), fmaxf(fabsf(v1.z), fabsf(v1.w))));
        am = fmaxf(am, fmaxf(fmaxf(fmaxf(fabsf(v2.x), fabsf(v2.y)), fmaxf(fabsf(v2.z), fabsf(v2.w))), fmaxf(fmaxf(fabsf(v3.x), fabsf(v3.y)), fmaxf(fabsf(v3.z), fabsf(v3.w)))));
        am = wave_max(am);
        const int be = (int)((__builtin_bit_cast(unsigned, am) >> 23) & 255u);
        float sc = 1.f, sci = 1.f;
        if (be >= 8 && be <= 250) { sc = __builtin_bit_cast(float, (unsigned)(261 - be) << 23); sci = __builtin_bit_cast(float, (unsigned)(be - 7) << 23); }
        u32x4 o; o.x = pk_fp8x4(v0.x * sc, v0.y * sc, v0.z * sc, v0.w * sc); o.y = pk_fp8x4(v1.x * sc, v1.y * sc, v1.z * sc, v1.w * sc);
        o.z = pk_fp8x4(v2.x * sc, v2.y * sc, v2.z * sc, v2.w * sc); o.w = pk_fp8x4(v3.x * sc, v3.y * sc, v3.z * sc, v3.w * sc);
        *(u32x4*)(P.ws + (isv ? WS_EV8 : WS_EU8) + ((size_t)(lane >> 3) * NEXP + e) * 128 + (lane & 7) * 16) = o;
        if (lane == 0) ((float*)(P.ws + (isv ? WS_SVI : WS_SUI)))[e] = sci;
    }
}
constexpr int IT_WIN = 16 * 77, IT_WUQ = 4 * 24, IT_WUKV = 2 * 32, IT_WOUT = 16 * 32, IT_WQ = 16 * 64;
constexpr int IT_TOTAL = IT_WIN + IT_WUQ + IT_WUKV + IT_WOUT + IT_WQ;
__device__ __forceinline__ void p0_prologue(const Params& P, int gw, int nw, int lane, float* scr) {
    unsigned char* ws = P.ws;
    for (int it = gw, rnd = 0; it < IT_TOTAL; it = (++rnd) * nw + (nw - 1 - gw)) {
        int r = it;
        if (r < IT_WIN) { const int kb = r / 77, nb = r % 77, n0 = nb * 32, k0 = kb * 64;
            bf16_t* w1t = (bf16_t*)(ws + WS_W1T); bf16_t* w1tt = (bf16_t*)(ws + WS_W1TT);
            if (n0 < 416) p0_transpose_block(P.w_in, IN_COLS, k0, n0, w1t, n0, D, nullptr, 1.f, scr, lane);
            else if (n0 < 928) p0_transpose_block(P.w_in, IN_COLS, k0, n0, w1t, PC_RQ + (n0 - 416), D, nullptr, 1.f, scr, lane);
            else if (n0 < 1440) p0_transpose_block(P.w_in, IN_COLS, k0, n0, w1t, PC_RK + (n0 - 928), D, nullptr, 1.f, scr, lane);
            else if (n0 < 1952) p0_transpose_block(P.w_in, IN_COLS, k0, n0, w1tt, PT_RV + (n0 - 1440), D, nullptr, 1.f, scr, lane);
            else p0_transpose_block(P.w_in, IN_COLS, k0, n0, w1t, PC_RG + (n0 - 1952), D, nullptr, 1.f, scr, lane);
            continue; } r -= IT_WIN;
        if (r < IT_WUQ) { const int kb = r / 24, nb = r % 24; p0_transpose_block(P.w_uq, 768, kb * 64, nb * 32, (bf16_t*)(ws + WS_WUQ), nb * 32, 256, P.g_q_norm, QSCALE, scr, lane); continue; } r -= IT_WUQ;
        if (r < IT_WUKV) { const int kb = r / 32, nb = r % 32, n0 = nb * 32, h = n0 >> 7, rr = n0 & 127;
            if (rr < 64) p0_transpose_block(P.w_ukv, 1024, kb * 64, n0, (bf16_t*)(ws + WS_WK), h * 64 + rr, 256, P.g_kv_norm, 1.f, scr, lane);
            else p0_transpose_block(P.w_ukv, 1024, kb * 64, n0, (bf16_t*)(ws + WS_WV), h * 64 + rr - 64, 256, P.g_kv_norm, 1.f, scr, lane);
            continue; } r -= IT_WUKV;
        if (r < IT_WOUT) { const int kb = r / 32, nb = r % 32; p0_transpose_block(P.w_out, 1024, kb * 64, nb * 32, (bf16_t*)(ws + WS_WOUT), nb * 32, 1024, nullptr, 1.f, scr, lane); continue; } r -= IT_WOUT;
        { const int kb = r / 64, nb = r % 64; p0_transpose_block(P.w_query, 2048, kb * 64, nb * 32, (bf16_t*)(ws + WS_WQ), nb * 32, 1024, nullptr, 1.f, scr, lane); }
    }
    const size_t gt = (size_t)gw * 64 + lane, nt = (size_t)nw * 64;
    { u32x4 z = {0u, 0u, 0u, 0u};
      for (size_t i = gt; i < 96 * 1024 / 8; i += nt) *(u32x4*)((bf16_t*)(ws + WS_W1T) + (size_t)416 * 1024 + i * 8) = z;
      for (size_t i = gt; i < 2 * 512 * 16; i += nt) { const size_t m = i / (512 * 16), rr = (i / 16) % 512, cc = i % 16; *(u32x4*)((bf16_t*)(ws + (m ? WS_WV : WS_WK)) + rr * 256 + 128 + cc * 8) = z; }
    }
    cvt8(P.sub_keys, (bf16_t*)(ws + WS_SK), 2 * 128 * 128 / 8, gt, nt);
    p0_expert_fp8(P, gw, nw, lane);
}

template <bool FROM_PART, bool WRITE_Q, bool SRC_BF16> __device__ __forceinline__ void rownorm_pass(const Params& P, const void* srcv, const float* g, int seg_sh, int seg_sc, bf16_t* dst, int gw, int nw, int lane) {
    const float* src = (const float*)srcv; const bf16_t* srcb = (const bf16_t*)srcv;
    auto ldrow = [&](int row, f32x4 (&o)[4]) { if (SRC_BF16) { const u32x2* p = (const u32x2*)(srcb + (size_t)row * D) + lane;
#pragma unroll
            for (int j = 0; j < 4; ++j) { const u32x2 w = p[64 * j]; o[j] = (f32x4){bflo(w.x), bfhi(w.x), bflo(w.y), bfhi(w.y)}; } }
        else { const f32x4* p = (const f32x4*)(src + (size_t)row * D) + lane;
#pragma unroll
            for (int j = 0; j < 4; ++j) o[j] = p[64 * j]; } };
    const float* mod = (const float*)(P.ws + WS_MOD);
    for (int r0 = gw * 16; r0 < T; r0 += nw * 16) {
        const int b = r0 / SEQ;
        f32x4 mul[4], add[4];
#pragma unroll
        for (int j = 0; j < 4; ++j) {
            const int col = lane * 4 + 256 * j;
            f32x4 sc, sh;
            { sc = *(const f32x4*)(mod + (size_t)b * 6144 + seg_sc * D + col); sh = *(const f32x4*)(mod + (size_t)b * 6144 + seg_sh * D + col); }
            const f32x4 gg = *(const f32x4*)(g + col);
            mul[j] = gg * (sc + 1.0f); add[j] = sh;
        }
        f32x4 vn[4];
        ldrow(r0, vn);
        for (int rr = 0; rr < 16; ++rr) {
            const int row = r0 + rr;
            f32x4 v[4]; float s = 0.f;
#pragma unroll
            for (int j = 0; j < 4; ++j) v[j] = vn[j];
            ldrow(rr < 15 ? row + 1 : row, vn);
#pragma unroll
            for (int j = 0; j < 4; ++j) s += (v[j].x * v[j].x + v[j].y * v[j].y) + (v[j].z * v[j].z + v[j].w * v[j].w);
            const float rstd = 1.0f / sqrtf(wave_sum(s) * (1.f / D) + EPS);
            u32x2* o = (u32x2*)(dst + (size_t)row * D) + lane;
#pragma unroll
            for (int j = 0; j < 4; ++j) { const f32x4 y = v[j] * rstd * mul[j] + add[j]; u32x2 w; w.x = pk2(y.x, y.y); w.y = pk2(y.z, y.w); o[64 * j] = w;
                if (WRITE_Q) { const unsigned hq = pk_fp8x4(y.x, y.y, y.z, y.w); const f32x2 f01 = __builtin_amdgcn_cvt_pk_f32_fp8((int)hq, false), f23 = __builtin_amdgcn_cvt_pk_f32_fp8((int)hq, true);
                    const unsigned lq = pk_fp8x4(16.f * (y.x - f01.x), 16.f * (y.y - f01.y), 16.f * (y.z - f23.x), 16.f * (y.w - f23.y));
                    unsigned* q = (unsigned*)(P.ws + WS_H2Q + (size_t)row * 2048) + (lane ^ ((lane >> 2) & 2)) + 64 * j; q[0] = hq; q[256] = lq; } }
        }
    }
}
__device__ __forceinline__ void kr_pass(const Params& P, size_t gt, size_t nt) {
    const bf16_t* proj = (const bf16_t*)(P.ws + WS_PROJ); bf16_t* kr = (bf16_t*)(P.ws + WS_KR);
    for (size_t i = gt; i < (size_t)T * 16; i += nt) {
        const int t = (int)(i >> 4), f = (int)(i & 15);
        const float x1 = bf2f(proj[(size_t)t * PLD + PC_KR + f]), x2 = bf2f(proj[(size_t)t * PLD + PC_KR + 16 + f]);
        float s, c; sincos_rad((float)P.positions[t] * INV64[2 * f], s, c);
        kr[(size_t)t * 32 + f] = (bf16_t)f2bf(x1 * c - x2 * s); kr[(size_t)t * 32 + 16 + f] = (bf16_t)f2bf(x1 * s + x2 * c);
    }
}

namespace pg8 {
#define PG8_LAS __attribute__((address_space(3)))
typedef unsigned short bf16_t;
typedef short bf16x8 __attribute__((ext_vector_type(8)));
typedef float f32x4 __attribute__((ext_vector_type(4)));
typedef unsigned u32x4 __attribute__((ext_vector_type(4)));
constexpr int BM = 256, BK = 64, HALF = 128, HTB = HALF * BK * 2  , STAGE_BYTES = 8 * HTB, NXCD = 8, WGM = 8;

__host__ __device__ __forceinline__ int lds_byte(int r, int c) { const int st = (r >> 4) * 2 + (c >> 5), rr = r & 15, cc = c & 31, ob = rr * 64 + cc * 2; return st * 1024 + (ob ^ (((ob >> 9) & 1) << 5)); }
__host__ __device__ __forceinline__ void stage_rc(int b, int& R, int& C) { const int st = b / 1024, sb = b % 1024, swz = sb ^ (((sb >> 9) & 1) << 5); R = (st >> 1) * 16 + swz / 64; C = (st & 1) * 32 + (swz % 64) / 2; }
__host__ __device__ __forceinline__ int perm32(int rho) { const int n = rho >> 4, i = rho & 15; return 8 * (i >> 2) + 4 * n + (i & 3); }

struct Unit { int pm, pn; };
struct Gemm { const bf16_t* A; const bf16_t* Bt; int M, N, K, lda, ldb; };

struct StaticOrder {
    int nM, nN, nwg, G, c;
    __host__ __device__ void init(int M, int N, int G_, int c_) { nM = M / BM; nN = N / BM; nwg = nM * nN; G = G_; c = c_; }
    __host__ __device__ bool next(int i, Unit& u) const {
        const long L = (long)i * G + c; if (L >= nwg) return false;
        int wgid = (int)L; { const int q = nwg / NXCD, r = nwg % NXCD, xcd = wgid % NXCD, off = wgid / NXCD; wgid = (xcd < r ? xcd * (q + 1) : r * (q + 1) + (xcd - r) * q) + off; }
        const int nig = WGM * nN, gid = wgid / nig, fm = gid * WGM, gsz = (nM - fm) < WGM ? (nM - fm) : WGM;
        u.pm = fm + ((wgid % nig) % gsz); u.pn = (wgid % nig) / gsz; return true;
    }
    __device__ __forceinline__ void a_ready(const Unit&) const {}
    __device__ __forceinline__ void done(const Unit&) const {}
};


template <class Epi, class Sched, bool ALIGN_EPI = false, bool SP2 = false>
__device__ __forceinline__ void gemm_phase(PG8_LAS unsigned char* lds, const Gemm g, const Sched& S, const Epi& E) {
    int tid = tid_now(); asm volatile("" : "+v"(tid));
    const int wid = __builtin_amdgcn_readfirstlane(tid >> 6), lane = tid & 63, wr = wid >> 2, wc = wid & 3, fr = lane & 15, fq = lane >> 4;
    const int K = g.K, nt = K / BK;
    unsigned voffA[2], voffB[2];
#pragma unroll
    for (int i = 0; i < 2; ++i) { int R, C; stage_rc(tid * 16 + i * 8192, R, C); const int Rb = Epi::PERM ? ((R & ~31) + perm32(R & 31)) : R;
        voffA[i] = (unsigned)(R * g.lda + C) * 2u; voffB[i] = (unsigned)(Rb * g.ldb + C) * 2u; }
    const size_t kstep = (size_t)(BK * 2);
    const size_t hstepA = (size_t)HALF * g.lda * 2, hstepB = (size_t)HALF * g.ldb * 2;
    const size_t tstepA = 2 * hstepA, tstepB = 2 * hstepB;
    const unsigned ldsw = (unsigned)wid * 1024u;
    const int aoff = lds_byte(wr * 64 + fr, fq * 8), boff = lds_byte(wc * 32 + fr, fq * 8);
#define PG8_SA(b, h) (((b) * 2 + (h)) * HTB)
#define PG8_SB(b, h) ((4 + (b) * 2 + (h)) * HTB)
#define PG8_STAGE(bufoff, gbase, voff) do { _Pragma("unroll") for (int _i = 0; _i < 2; ++_i) \
        __builtin_amdgcn_global_load_lds((const unsigned*)((const char*)(gbase) + (voff)[_i]), (PG8_LAS unsigned*)(lds + (bufoff) + ldsw + _i * 8192), 16, 0, 0); } while (0)
#define PG8_LDA(dst, b, h) do { _Pragma("unroll") for (int m = 0; m < 4; ++m) _Pragma("unroll") for (int k = 0; k < 2; ++k) dst[m][k] = *(const PG8_LAS bf16x8*)(lds + PG8_SA(b, h) + aoff + m * 2048 + k * 1024); } while (0)
#define PG8_LDB(dst, b, h) do { _Pragma("unroll") for (int n = 0; n < 2; ++n) _Pragma("unroll") for (int k = 0; k < 2; ++k) dst[n][k] = *(const PG8_LAS bf16x8*)(lds + PG8_SB(b, h) + boff + n * 2048 + k * 1024); } while (0)
#define PG8_MMA(ai, bj, At, Bt) do { __builtin_amdgcn_s_setprio(1); _Pragma("unroll") for (int m = 0; m < 4; ++m) _Pragma("unroll") for (int n = 0; n < 2; ++n) _Pragma("unroll") for (int k = 0; k < 2; ++k) \
        acc[ai][bj][m][n] = __builtin_amdgcn_mfma_f32_16x16x32_bf16(Bt[n][k], At[m][k], acc[ai][bj][m][n], 0, 0, 0); __builtin_amdgcn_s_setprio(0); } while (0)
#define PG8_WAIT_V(n) asm volatile("s_waitcnt vmcnt(" #n ")" ::: "memory")
#define PG8_WAIT_L(n) asm volatile("s_waitcnt lgkmcnt(" #n ")" ::: "memory")
#define PG8_BAR __builtin_amdgcn_s_barrier()
#define PG8_SCHED __builtin_amdgcn_sched_barrier(0)
    Unit cur, nxt; int ui = 0;
    if (!S.next(0, cur)) return;
    f32x4 acc[2][2][4][2];
#pragma unroll
    for (int a = 0; a < 2; ++a)
#pragma unroll
        for (int b = 0; b < 2; ++b)
#pragma unroll
            for (int m = 0; m < 4; ++m)
#pragma unroll
                for (int n = 0; n < 2; ++n) acc[a][b][m][n] = (f32x4){0.f, 0.f, 0.f, 0.f};
    bf16x8 At[4][2], B0[2][2], B1[2][2];
    const char* cA = (const char*)g.A + (size_t)cur.pm * tstepA; const char* cB = (const char*)g.Bt + (size_t)cur.pn * tstepB;
    S.a_ready(cur);
    if constexpr (SP2) {
        PG8_STAGE(PG8_SB(0, 0), cB, voffB); PG8_STAGE(PG8_SB(0, 1), cB + hstepB, voffB); PG8_STAGE(PG8_SA(0, 0), cA, voffA); PG8_STAGE(PG8_SA(0, 1), cA + hstepA, voffA);
        if (wr == 1) PG8_BAR;
        PG8_WAIT_V(2); PG8_BAR;
        PG8_STAGE(PG8_SB(1, 0), cB + kstep, voffB); PG8_STAGE(PG8_SA(1, 0), cA + kstep, voffA); PG8_STAGE(PG8_SB(1, 1), cB + hstepB + kstep, voffB);
        PG8_WAIT_V(6); PG8_BAR;
    } else {
        PG8_STAGE(PG8_SB(0, 0), cB, voffB); PG8_STAGE(PG8_SA(0, 0), cA, voffA); PG8_STAGE(PG8_SB(0, 1), cB + hstepB, voffB); PG8_STAGE(PG8_SA(0, 1), cA + hstepA, voffA);
        if (wr == 1) PG8_BAR;
        PG8_WAIT_V(4); PG8_BAR;
        PG8_STAGE(PG8_SB(1, 0), cB + kstep, voffB); PG8_STAGE(PG8_SA(1, 0), cA + kstep, voffA); PG8_STAGE(PG8_SB(1, 1), cB + hstepB + kstep, voffB);
        PG8_WAIT_V(6); PG8_BAR;
    }
    for (;;) {
        const bool has_next = S.next(ui + 1, nxt);
        const char* nA = has_next ? (const char*)g.A + (size_t)nxt.pm * tstepA : cA; const char* nB = has_next ? (const char*)g.Bt + (size_t)nxt.pn * tstepB : cB;
        for (int t = 0; t < nt; t += 2) {
            const bool last = (t == nt - 2);
            const char* a1 = cA + (size_t)(t + 1) * kstep;
            const char* a2 = last ? nA : cA + (size_t)(t + 2) * kstep; const char* b2 = last ? nB : cB + (size_t)(t + 2) * kstep;
            const char* a3 = a2 + kstep; const char* b3 = b2 + kstep;
            if (last && has_next) S.a_ready(nxt);
            if constexpr (SP2) {
            PG8_LDB(B0, 0, 0); PG8_LDB(B1, 0, 1); PG8_SCHED; PG8_LDA(At, 0, 0); PG8_STAGE(PG8_SA(1, 1), a1 + hstepA, voffA);
            PG8_WAIT_V(8); PG8_WAIT_L(0); PG8_BAR; PG8_MMA(0, 0, At, B0); PG8_MMA(0, 1, At, B1); PG8_BAR; PG8_SCHED;
            PG8_LDA(At, 0, 1); PG8_STAGE(PG8_SB(0, 0), b2, voffB); PG8_STAGE(PG8_SB(0, 1), b2 + hstepB, voffB); PG8_STAGE(PG8_SA(0, 0), a2, voffA);
            PG8_WAIT_V(8); PG8_WAIT_L(0); PG8_BAR; PG8_MMA(1, 0, At, B0); PG8_MMA(1, 1, At, B1); PG8_BAR; PG8_SCHED;
            PG8_LDB(B0, 1, 0); PG8_LDB(B1, 1, 1); PG8_SCHED; PG8_LDA(At, 1, 0); PG8_STAGE(PG8_SA(0, 1), a2 + hstepA, voffA);
            PG8_WAIT_V(8); PG8_WAIT_L(0); PG8_BAR; PG8_MMA(0, 0, At, B0); PG8_MMA(0, 1, At, B1); PG8_BAR; PG8_SCHED;
            PG8_LDA(At, 1, 1); PG8_STAGE(PG8_SB(1, 0), b3, voffB); PG8_STAGE(PG8_SB(1, 1), b3 + hstepB, voffB); PG8_STAGE(PG8_SA(1, 0), a3, voffA);
            PG8_WAIT_V(8); PG8_WAIT_L(0); PG8_BAR; PG8_MMA(1, 0, At, B0); PG8_MMA(1, 1, At, B1); PG8_BAR; PG8_SCHED;
            } else {
            PG8_LDB(B0, 0, 0); PG8_SCHED; PG8_LDA(At, 0, 0); PG8_STAGE(PG8_SA(1, 1), a1 + hstepA, voffA);
            PG8_WAIT_L(8); PG8_BAR; PG8_WAIT_L(0); PG8_MMA(0, 0, At, B0); PG8_BAR; PG8_SCHED;
            PG8_LDB(B1, 0, 1); PG8_STAGE(PG8_SB(0, 0), b2, voffB);
            PG8_BAR; PG8_WAIT_L(0); PG8_MMA(0, 1, At, B1); PG8_BAR;
            PG8_LDA(At, 0, 1); PG8_STAGE(PG8_SA(0, 0), a2, voffA);
            PG8_BAR; PG8_WAIT_L(0); PG8_MMA(1, 0, At, B0); PG8_BAR; PG8_SCHED;
            PG8_STAGE(PG8_SB(0, 1), b2 + hstepB, voffB);
            PG8_WAIT_V(6); PG8_BAR; PG8_MMA(1, 1, At, B1); PG8_BAR;
            PG8_LDB(B0, 1, 0); PG8_SCHED; PG8_LDA(At, 1, 0); PG8_STAGE(PG8_SA(0, 1), a2 + hstepA, voffA);
            PG8_WAIT_L(8); PG8_BAR; PG8_WAIT_L(0); PG8_MMA(0, 0, At, B0); PG8_BAR; PG8_SCHED;
            PG8_LDB(B1, 1, 1); PG8_STAGE(PG8_SB(1, 0), b3, voffB);
            PG8_BAR; PG8_WAIT_L(0); PG8_MMA(0, 1, At, B1); PG8_BAR;
            PG8_LDA(At, 1, 1); PG8_STAGE(PG8_SA(1, 0), a3, voffA);
            PG8_BAR; PG8_WAIT_L(0); PG8_MMA(1, 0, At, B0); PG8_BAR; PG8_SCHED;
            PG8_STAGE(PG8_SB(1, 1), b3 + hstepB, voffB);
            PG8_WAIT_V(6); PG8_BAR; PG8_MMA(1, 1, At, B1); PG8_BAR;
            }
        }
        if constexpr (ALIGN_EPI) { if (wr == 0) PG8_BAR; }
        if constexpr (!Epi::AFTER_DRAIN) { E(acc, cur, wr, wc, fr, fq); S.done(cur); }
        if (!has_next) break;
#pragma unroll
        for (int a = 0; a < 2; ++a)
#pragma unroll
            for (int b = 0; b < 2; ++b)
#pragma unroll
                for (int m = 0; m < 4; ++m)
#pragma unroll
                    for (int n = 0; n < 2; ++n) acc[a][b][m][n] = (f32x4){0.f, 0.f, 0.f, 0.f};
        cur = nxt; cA = nA; cB = nB; ++ui;
        if constexpr (ALIGN_EPI) { if (wr == 1) PG8_BAR; }
    }
    PG8_WAIT_V(0);
    if constexpr (!ALIGN_EPI) { if (wr == 0) PG8_BAR; }
    PG8_BAR;
    if constexpr (Epi::AFTER_DRAIN) { E.fused(acc, cur, wr, wc, fr, fq, lds, wid, lane); S.done(cur); }
#undef PG8_SA
#undef PG8_SB
#undef PG8_STAGE
#undef PG8_LDA
#undef PG8_LDB
#undef PG8_MMA
#undef PG8_WAIT_V
#undef PG8_WAIT_L
#undef PG8_BAR
#undef PG8_SCHED
}
}

namespace epi {
using pg8::f32x4; using pg8::u32x4; using pg8::Unit; using pg8::HALF; using pg8::BM;
__device__ __forceinline__ unsigned cvt_pk_bf16(float lo, float hi) { typedef __bf16 b2 __attribute__((ext_vector_type(2))); const f32x2 v = {lo, hi}; const b2 b = __builtin_convertvector(v, b2); return __builtin_bit_cast(unsigned, b); }
template <int MODE> struct EpiStore {
    static constexpr bool PERM = true, AFTER_DRAIN = false;
    bf16_t* O; int ldc; float* ssq; int which; float inv_n;
    __device__ __forceinline__ void operator()(const f32x4 (&acc)[2][2][4][2], const Unit& u, int wr, int wc, int fr, int fq) const {
        int row0 = u.pm * BM + wr * 64 + fr, col0 = u.pn * BM + wc * 32 + 8 * fq;
        if (MODE == 2) {
#pragma unroll
            for (int bj = 0; bj < 2; ++bj) { float cs[8];
#pragma unroll
                for (int i = 0; i < 8; ++i) { const f32x4 pq = *(const f32x4*)(ssq + 8 * (col0 + bj * HALF + i) + 4 * which); cs[i] = __builtin_amdgcn_rsqf(((pq.x + pq.y) + (pq.z + pq.w)) * inv_n + EPS); }
#pragma unroll
                for (int ai = 0; ai < 2; ++ai)
#pragma unroll
                    for (int m = 0; m < 4; ++m) { bf16_t* rowp = O + (size_t)(row0 + ai * HALF + m * 16) * ldc + col0 + bj * HALF; const f32x4 v0 = acc[ai][bj][m][0], v1 = acc[ai][bj][m][1];
                        u32x4 w; w.x = cvt_pk_bf16(v0[0] * cs[0], v0[1] * cs[1]); w.y = cvt_pk_bf16(v0[2] * cs[2], v0[3] * cs[3]); w.z = cvt_pk_bf16(v1[0] * cs[4], v1[1] * cs[5]); w.w = cvt_pk_bf16(v1[2] * cs[6], v1[3] * cs[7]);
                        *(u32x4*)rowp = w; } }
            return;
        }
#pragma unroll
        for (int ai = 0; ai < 2; ++ai)
#pragma unroll
            for (int m = 0; m < 4; ++m) { const int row = row0 + ai * HALF + m * 16; bf16_t* rowp = O + (size_t)row * ldc + col0;
                float rs = 1.f; if (MODE == 1) { const f32x4 pq = *(const f32x4*)(ssq + 8 * row + 4 * which); rs = __builtin_amdgcn_rsqf(((pq.x + pq.y) + (pq.z + pq.w)) * inv_n + EPS); }
                float sq = 0.f;
#pragma unroll
                for (int bj = 0; bj < 2; ++bj) { f32x4 v0 = acc[ai][bj][m][0], v1 = acc[ai][bj][m][1];
                    if (MODE == 1) { v0 = v0 * rs; v1 = v1 * rs; }
                    if (MODE == 3 && (u.pn == 0 || (u.pn == 1 && bj == 0))) sq += (v0.x * v0.x + v0.y * v0.y) + (v0.z * v0.z + v0.w * v0.w) + (v1.x * v1.x + v1.y * v1.y) + (v1.z * v1.z + v1.w * v1.w);
                    u32x4 w; w.x = cvt_pk_bf16(v0[0], v0[1]); w.y = cvt_pk_bf16(v0[2], v0[3]); w.z = cvt_pk_bf16(v1[0], v1[1]); w.w = cvt_pk_bf16(v1[2], v1[3]);
                    *(u32x4*)(rowp + bj * HALF) = w; }
                if (MODE == 3 && u.pn < 2) { sq += __shfl_xor(sq, 16); sq += __shfl_xor(sq, 32); if (fq == 0) ssq[8 * row + 4 * u.pn + wc] = sq; }
            }
    }
};
struct EpiResid {
    static constexpr bool PERM = true, AFTER_DRAIN = false;
    const float* x; const float* mod; bf16_t* out;
    __device__ __forceinline__ void operator()(const f32x4 (&acc)[2][2][4][2], const Unit& u, int wr, int wc, int fr, int fq) const {
        int row0 = u.pm * BM + wr * 64 + fr, col0 = u.pn * BM + wc * 32 + 8 * fq; const int b = (u.pm * BM) / SEQ;
        f32x4 gv[2][2];
#pragma unroll
        for (int bj = 0; bj < 2; ++bj)
#pragma unroll
            for (int n = 0; n < 2; ++n) gv[bj][n] = *(const f32x4*)(mod + (size_t)b * 6144 + 2 * D + col0 + bj * HALF + n * 4);
#pragma unroll
        for (int ai = 0; ai < 2; ++ai)
#pragma unroll
            for (int m = 0; m < 4; ++m) { const size_t off = (size_t)(row0 + ai * HALF + m * 16) * D + col0;
#pragma unroll
                for (int bj = 0; bj < 2; ++bj) { const f32x4 x0 = *(const f32x4*)(x + off + bj * HALF), x1 = *(const f32x4*)(x + off + bj * HALF + 4);
                    const f32x4 v0 = x0 + gv[bj][0] * acc[ai][bj][m][0], v1 = x1 + gv[bj][1] * acc[ai][bj][m][1];
                    u32x4 w; w.x = cvt_pk_bf16(v0[0], v0[1]); w.y = cvt_pk_bf16(v0[2], v0[3]); w.z = cvt_pk_bf16(v1[0], v1[1]); w.w = cvt_pk_bf16(v1[2], v1[3]);
                    *(u32x4*)(out + off + bj * HALF) = w; } }
    }
};
}

#define LAS __attribute__((address_space(3)))
#define LDSW() asm volatile("s_waitcnt lgkmcnt(0)" ::: "memory")
#define PSEC_WORD ((__attribute__((address_space(3))) volatile unsigned long long*)(unsigned)(131072 + 8192 + 64 + 8 * 16))
#define PSEC_BEGIN(id) unsigned long long psec_t0_##id = 0; do { if (PROBE_SEC == (id) && blockIdx.x == 0 && threadIdx.x == 0) { __builtin_amdgcn_sched_barrier(0); psec_t0_##id = __builtin_amdgcn_s_memrealtime(); __builtin_amdgcn_sched_barrier(0); } } while (0)
#define PSEC_END(id) do { if (PROBE_SEC == (id) && blockIdx.x == 0 && threadIdx.x == 0) { __builtin_amdgcn_sched_barrier(0); *PSEC_WORD += __builtin_amdgcn_s_memrealtime() - psec_t0_##id; __builtin_amdgcn_sched_barrier(0); } } while (0)

typedef short bf16x8 __attribute__((ext_vector_type(8)));
typedef float f32x16 __attribute__((ext_vector_type(16)));
__device__ __forceinline__ int crow(int r, int hi) { return (r & 3) + 8 * (r >> 2) + 4 * hi; }
typedef __bf16 bf16x2_t __attribute__((ext_vector_type(2)));
__device__ __forceinline__ unsigned cvtpk(float lo, float hi) { const f32x2 v = {lo, hi}; const bf16x2_t b = __builtin_convertvector(v, bf16x2_t); return __builtin_bit_cast(unsigned, b); }
__device__ __forceinline__ float bfe(const u32x4& w, int e) { const unsigned d = w[e >> 1]; return (e & 1) ? bfhi(d) : bflo(d); }
__device__ __forceinline__ bf16x8 as_frag(const u32x4& w) { return __builtin_bit_cast(bf16x8, w); }
__device__ __forceinline__ void rope_pair(const u32x4& c1, const u32x4& c2, float pos, const float (&inv)[8], float sc, u32x4& o1, u32x4& o2) {
    float a[8], b[8];
#pragma unroll
    for (int e = 0; e < 8; ++e) { float sn, cs; sincos_rad(pos * inv[e], sn, cs); const float x1 = bfe(c1, e), x2 = bfe(c2, e); a[e] = (x1 * cs - x2 * sn) * sc; b[e] = (x1 * sn + x2 * cs) * sc; }
    o1 = (u32x4){cvtpk(a[0], a[1]), cvtpk(a[2], a[3]), cvtpk(a[4], a[5]), cvtpk(a[6], a[7])};
    o2 = (u32x4){cvtpk(b[0], b[1]), cvtpk(b[2], b[3]), cvtpk(b[4], b[5]), cvtpk(b[6], b[7])};
}
template <int S2> __device__ __forceinline__ void rope_pair_h(const u32x4& c1, const u32x4& c2, float pos, int hi, float sc, u32x4& o1, u32x4& o2) {
    float a[8], b[8];
#pragma unroll
    for (int e = 0; e < 8; ++e) { const float inv = hi ? INV64[16 * S2 + 8 + e] : INV64[16 * S2 + e]; float sn, cs; sincos_rad(pos * inv, sn, cs); const float x1 = bfe(c1, e), x2 = bfe(c2, e); a[e] = (x1 * cs - x2 * sn) * sc; b[e] = (x1 * sn + x2 * cs) * sc; }
    o1 = (u32x4){cvtpk(a[0], a[1]), cvtpk(a[2], a[3]), cvtpk(a[4], a[5]), cvtpk(a[6], a[7])};
    o2 = (u32x4){cvtpk(b[0], b[1]), cvtpk(b[2], b[3]), cvtpk(b[4], b[5]), cvtpk(b[6], b[7])};
}
__device__ __forceinline__ void ret_kvc_item(const Params& P, int item, int lane) {
    const bf16_t* proj = (const bf16_t*)(P.ws + WS_PROJ); const bf16_t* projt = (const bf16_t*)(P.ws + WS_PROJT); float* kvc = (float*)(P.ws + WS_KVC) + (size_t)item * 4096;
    const int h = item & 7, n = (item >> 3) & 63, b = item >> 9;
    const size_t t0 = (size_t)b * SEQ + n * 128;
    const float gamma = 1.0f - exp2f(-5.0f - (float)h), lg = log2f(gamma);
    const int r32 = lane & 31, hi = lane >> 5, f = r32;
    bf16x8 idb[2];
#pragma unroll
    for (int sp = 0; sp < 2; ++sp) { u32x4 w = {0u, 0u, 0u, 0u};
        if ((r32 >> 4) == sp && ((r32 >> 3) & 1) == hi) { const unsigned one = (r32 & 1) ? 0x3f800000u : 0x00003f80u; const int q = (r32 & 7) >> 1; w.x = q == 0 ? one : 0u; w.y = q == 1 ? one : 0u; w.z = q == 2 ? one : 0u; w.w = q == 3 ? one : 0u; }
        idb[sp] = as_frag(w); }
    const unsigned rowoff = (unsigned)(r32 * PLD + 8 * hi) * 2u, voff = (unsigned)(r32 * T + 4 * hi) * 2u, poff = (unsigned)r32 * 4u;
    const char* kbase = (const char*)(proj + t0 * PLD + PC_RK + h * 64); const char* pbase = (const char*)(P.positions + t0); const char* vbase = (const char*)(projt + (size_t)(PT_RV + h * 64) * T + t0);
#define RA_ROW(jb_, c_) (*(const u32x4*)(kbase + (size_t)(jb_) * (32 * PLD * 2) + (c_) * 32 + rowoff))
#define RA_POS(jb_) ((float)*(const int*)(pbase + (size_t)(jb_) * 128 + poff))
#define RA_LOADV(jb_) do { _Pragma("unroll") for (int blk_ = 0; blk_ < 2; ++blk_) _Pragma("unroll") for (int sp_ = 0; sp_ < 2; ++sp_) { const char* vp_ = vbase + (size_t)(32 * blk_) * T * 2 + (32 * (jb_) + 16 * sp_) * 2 + voff; \
        vlo[(jb_) & 1][blk_][sp_] = *(const u32x2*)vp_; vhh[(jb_) & 1][blk_][sp_] = *(const u32x2*)(vp_ + 16); } } while (0)
    u32x4 kn[2][4]; float kpos[2]; u32x2 vlo[2][2][2], vhh[2][2][2];
    kn[0][0] = RA_ROW(0, 0); kn[0][1] = RA_ROW(0, 1); kn[0][2] = RA_ROW(0, 2); kn[0][3] = RA_ROW(0, 3); kpos[0] = RA_POS(0); RA_LOADV(0);
    f32x16 acc[2][2];
#pragma unroll
    for (int i = 0; i < 2; ++i)
#pragma unroll
        for (int j = 0; j < 2; ++j)
#pragma unroll
            for (int r = 0; r < 16; ++r) acc[i][j][r] = 0.f;
#pragma unroll
    for (int jb = 0; jb < 4; ++jb) {
        __builtin_amdgcn_sched_barrier(0);
        if (jb < 3) { kn[(jb + 1) & 1][0] = RA_ROW(jb + 1, 0); kn[(jb + 1) & 1][1] = RA_ROW(jb + 1, 1); kn[(jb + 1) & 1][2] = RA_ROW(jb + 1, 2); kn[(jb + 1) & 1][3] = RA_ROW(jb + 1, 3); kpos[(jb + 1) & 1] = RA_POS(jb + 1);
            if (jb == 0) RA_LOADV(1); else if (jb == 1) RA_LOADV(2); else RA_LOADV(3); }
        __builtin_amdgcn_sched_barrier(0);
        const float scj = 0.125f * __builtin_amdgcn_exp2f(-(float)(32 * jb + r32) * lg);
        u32x4 o[4]; rope_pair_h<0>(kn[jb & 1][0], kn[jb & 1][2], kpos[jb & 1], hi, scj, o[0], o[2]); rope_pair_h<1>(kn[jb & 1][1], kn[jb & 1][3], kpos[jb & 1], hi, scj, o[1], o[3]);
#pragma unroll
        for (int c = 0; c < 2; ++c) {
            f32x16 kc;
#pragma unroll
            for (int r = 0; r < 16; ++r) kc[r] = 0.f;
            kc = __builtin_amdgcn_mfma_f32_32x32x16_bf16(as_frag(o[2 * c]), idb[0], kc, 0, 0, 0);
            kc = __builtin_amdgcn_mfma_f32_32x32x16_bf16(as_frag(o[2 * c + 1]), idb[1], kc, 0, 0, 0);
#pragma unroll
            for (int sp = 0; sp < 2; ++sp) {
                const bf16x8 pb = as_frag((u32x4){cvtpk(kc[8 * sp], kc[8 * sp + 1]), cvtpk(kc[8 * sp + 2], kc[8 * sp + 3]), cvtpk(kc[8 * sp + 4], kc[8 * sp + 5]), cvtpk(kc[8 * sp + 6], kc[8 * sp + 7])});
#pragma unroll
                for (int blk = 0; blk < 2; ++blk)
                    acc[blk][c] = __builtin_amdgcn_mfma_f32_32x32x16_bf16(as_frag((u32x4){vlo[jb & 1][blk][sp].x, vlo[jb & 1][blk][sp].y, vhh[jb & 1][blk][sp].x, vhh[jb & 1][blk][sp].y}), pb, acc[blk][c], 0, 0, 0);
            }
        }
    }
#undef RA_ROW
#undef RA_POS
#undef RA_LOADV
    const float g127 = __builtin_amdgcn_exp2f(127.0f * lg);
#pragma unroll
    for (int blk = 0; blk < 2; ++blk)
#pragma unroll
        for (int c = 0; c < 2; ++c)
#pragma unroll
            for (int r = 0; r < 16; ++r) kvc[(32 * blk + crow(r, hi)) * 64 + 32 * c + f] = acc[blk][c][r] * g127;
}
__device__ __forceinline__ void ret_scan(const Params& P, size_t gt, size_t nt) {
    const float* kvc = (const float*)(P.ws + WS_KVC); bf16_t* prevb = (bf16_t*)(P.ws + WS_PREVB);
    for (size_t i = gt; i < (size_t)NB * NH * 4096; i += nt) {
        const int e = (int)(i & 4095), h = (int)((i >> 12) & 7), b = (int)(i >> 15);
        const float gamma = 1.0f - exp2f(-5.0f - (float)h), decay = exp2f(128.0f * log2f(gamma));
        float st = 0.f;
#pragma unroll 8
        for (int n = 0; n < 64; ++n) { const size_t o = ((size_t)((b * 64 + n) * 8 + h)) * 4096 + e; const float v = kvc[o]; prevb[o] = (bf16_t)f2bf(st * gamma); st = st * decay + v; }
    }
}
__device__ __forceinline__ void ret_out_item(const Params& P, int item, int lane, LAS u32x4* wl) {
    const bf16_t* proj = (const bf16_t*)(P.ws + WS_PROJ); const bf16_t* projt = (const bf16_t*)(P.ws + WS_PROJT); const bf16_t* prevb = (const bf16_t*)(P.ws + WS_PREVB) + (size_t)item * 4096;
    bf16_t* Y = (bf16_t*)(P.ws + WS_XN);
    const int h = item & 7, n = (item >> 3) & 63, b = item >> 9;
    const size_t t0 = (size_t)b * SEQ + n * 128;
    const float gamma = 1.0f - exp2f(-5.0f - (float)h), lg = log2f(gamma);
    const int r32 = lane & 31, hi = lane >> 5;
    const unsigned rowoff = (unsigned)(r32 * PLD + 8 * hi) * 2u, gateoff = (unsigned)(r32 * PLD + 4 * hi) * 2u, voff = (unsigned)(r32 * T + 4 * hi) * 2u, poff = (unsigned)r32 * 4u;
    const unsigned pfoff = (unsigned)(r32 * 64 + 8 * hi) * 2u, yoff = (unsigned)(r32 * D + 4 * hi) * 2u;
    const char* kbase = (const char*)(proj + t0 * PLD + PC_RK + h * 64); const char* qbase = (const char*)(proj + t0 * PLD + PC_RQ + h * 64); const char* gbase = (const char*)(proj + t0 * PLD + PC_RG + h * 64);
    const char* pbase = (const char*)(P.positions + t0); const char* vbase = (const char*)(projt + (size_t)(PT_RV + h * 64) * T + t0); const char* fbase = (const char*)prevb; char* ybase = (char*)(Y + t0 * D + 512 + h * 64);
#define RC_ROW(base_, jb_, c_) (*(const u32x4*)((base_) + (size_t)(jb_) * (32 * PLD * 2) + (c_) * 32 + rowoff))
#define RC_POS(jb_) ((float)*(const int*)(pbase + (size_t)(jb_) * 128 + poff))
    u32x4 kn0 = RC_ROW(kbase, 0, 0), kn1 = RC_ROW(kbase, 0, 1), kn2 = RC_ROW(kbase, 0, 2), kn3 = RC_ROW(kbase, 0, 3); float kposn = RC_POS(0);
    u32x4 qn0 = RC_ROW(qbase, 0, 0), qn1 = RC_ROW(qbase, 0, 1), qn2 = RC_ROW(qbase, 0, 2), qn3 = RC_ROW(qbase, 0, 3); float qposn = kposn;
    u32x2 vlo[4][2][2], vhh[4][2][2];
#define RC_LOADV(jb_) do { _Pragma("unroll") for (int blk_ = 0; blk_ < 2; ++blk_) _Pragma("unroll") for (int sp_ = 0; sp_ < 2; ++sp_) { const char* vp_ = vbase + (size_t)(32 * blk_) * T * 2 + (32 * (jb_) + 16 * sp_) * 2 + voff; \
        vlo[jb_][blk_][sp_] = *(const u32x2*)vp_; vhh[jb_][blk_][sp_] = *(const u32x2*)(vp_ + 16); } } while (0)
    RC_LOADV(0);
#pragma unroll 1
    for (int jb = 0; jb < 4; ++jb) {
        const u32x4 c0 = kn0, c1 = kn1, c2 = kn2, c3 = kn3; const float pos = kposn; const float scj = 0.125f * __builtin_amdgcn_exp2f(-(float)(32 * jb + r32) * lg);
        { const int jn = jb < 3 ? jb + 1 : 3; kn0 = RC_ROW(kbase, jn, 0); kn1 = RC_ROW(kbase, jn, 1); kn2 = RC_ROW(kbase, jn, 2); kn3 = RC_ROW(kbase, jn, 3); kposn = RC_POS(jn); }
        __builtin_amdgcn_sched_barrier(0);
        u32x4 o0, o1, o2, o3; rope_pair_h<0>(c0, c2, pos, hi, scj, o0, o2); rope_pair_h<1>(c1, c3, pos, hi, scj, o1, o3);
        wl[(jb * 4 + 0) * 64 + lane] = o0; wl[(jb * 4 + 1) * 64 + lane] = o1; wl[(jb * 4 + 2) * 64 + lane] = o2; wl[(jb * 4 + 3) * 64 + lane] = o3;
    }
#pragma unroll
    for (int ib = 0; ib < 4; ++ib) {
        __builtin_amdgcn_sched_barrier(0);
        const float sci = __builtin_amdgcn_exp2f((float)(32 * ib + r32) * lg);
        const u32x4 c0 = qn0, c1 = qn1, c2 = qn2, c3 = qn3; const float pos = qposn;
        { const int in = ib < 3 ? ib + 1 : 3; qn0 = RC_ROW(qbase, in, 0); qn1 = RC_ROW(qbase, in, 1); qn2 = RC_ROW(qbase, in, 2); qn3 = RC_ROW(qbase, in, 3); qposn = RC_POS(in); }
        if (ib == 0) RC_LOADV(1); else if (ib == 1) RC_LOADV(2); else if (ib == 2) RC_LOADV(3);
        __builtin_amdgcn_sched_barrier(0);
        bf16x8 qf[4];
        { u32x4 o0, o1, o2, o3; rope_pair_h<0>(c0, c2, pos, hi, sci, o0, o2); rope_pair_h<1>(c1, c3, pos, hi, sci, o1, o3);
          qf[0] = as_frag(o0); qf[1] = as_frag(o1); qf[2] = as_frag(o2); qf[3] = as_frag(o3); }
        __builtin_amdgcn_sched_barrier(0);
        bf16x8 pf[2][4];
#pragma unroll
        for (int blk = 0; blk < 2; ++blk)
#pragma unroll
            for (int s = 0; s < 4; ++s) pf[blk][s] = *(const bf16x8*)(fbase + (size_t)(32 * blk * 64 + 16 * s) * 2 + pfoff);
        u32x2 gt2[2][4];
#pragma unroll
        for (int blk = 0; blk < 2; ++blk)
#pragma unroll
            for (int g4 = 0; g4 < 4; ++g4) gt2[blk][g4] = *(const u32x2*)(gbase + (size_t)ib * (32 * PLD * 2) + (32 * blk + 8 * g4) * 2 + gateoff);
        __builtin_amdgcn_sched_barrier(0);
        f32x16 y[2];
#pragma unroll
        for (int blk = 0; blk < 2; ++blk)
#pragma unroll
            for (int r = 0; r < 16; ++r) y[blk][r] = 0.f;
#pragma unroll
        for (int jb = 0; jb < 4; ++jb) if (jb <= ib) {
            f32x16 st;
#pragma unroll
            for (int r = 0; r < 16; ++r) st[r] = 0.f;
#pragma unroll
            for (int s = 0; s < 4; ++s) { const u32x4 kf = wl[(jb * 4 + s) * 64 + lane]; st = __builtin_amdgcn_mfma_f32_32x32x16_bf16(as_frag(kf), qf[s], st, 0, 0, 0); }
            if (jb == ib) {
#pragma unroll
                for (int r = 0; r < 16; ++r) if (crow(r, hi) > r32) st[r] = 0.f;
            }
#pragma unroll
            for (int sp = 0; sp < 2; ++sp) {
                const bf16x8 pb = as_frag((u32x4){cvtpk(st[8 * sp], st[8 * sp + 1]), cvtpk(st[8 * sp + 2], st[8 * sp + 3]), cvtpk(st[8 * sp + 4], st[8 * sp + 5]), cvtpk(st[8 * sp + 6], st[8 * sp + 7])});
#pragma unroll
                for (int blk = 0; blk < 2; ++blk)
                    y[blk] = __builtin_amdgcn_mfma_f32_32x32x16_bf16(as_frag((u32x4){vlo[jb][blk][sp].x, vlo[jb][blk][sp].y, vhh[jb][blk][sp].x, vhh[jb][blk][sp].y}), pb, y[blk], 0, 0, 0);
            }
        }
#pragma unroll
        for (int blk = 0; blk < 2; ++blk)
#pragma unroll
            for (int s = 0; s < 4; ++s) y[blk] = __builtin_amdgcn_mfma_f32_32x32x16_bf16(pf[blk][s], qf[s], y[blk], 0, 0, 0);
        float sum = 0.f;
#pragma unroll
        for (int blk = 0; blk < 2; ++blk)
#pragma unroll
            for (int r = 0; r < 16; ++r) sum += y[blk][r];
        sum += __shfl_xor(sum, 32); const float mu = sum * (1.f / 64.f);
        float var = 0.f;
#pragma unroll
        for (int blk = 0; blk < 2; ++blk)
#pragma unroll
            for (int r = 0; r < 16; ++r) { const float d = y[blk][r] - mu; var += d * d; }
        var += __shfl_xor(var, 32); const float rstd = 1.0f / sqrtf(var * (1.f / 64.f) + EPS);
#pragma unroll
        for (int blk = 0; blk < 2; ++blk)
#pragma unroll
            for (int g4 = 0; g4 < 4; ++g4) { const int dv0 = 32 * blk + 8 * g4 + 4 * hi;
                const u32x2 g2 = gt2[blk][g4]; const f32x4 gr = *(const f32x4*)(P.g_ret_norm + h * 64 + dv0);
                const float o0 = silu_f(bflo(g2.x)) * (y[blk][4 * g4] - mu) * rstd * gr.x, o1 = silu_f(bfhi(g2.x)) * (y[blk][4 * g4 + 1] - mu) * rstd * gr.y;
                const float o2 = silu_f(bflo(g2.y)) * (y[blk][4 * g4 + 2] - mu) * rstd * gr.z, o3 = silu_f(bfhi(g2.y)) * (y[blk][4 * g4 + 3] - mu) * rstd * gr.w;
                *(u32x2*)(ybase + (size_t)ib * (32 * D * 2) + (32 * blk + 8 * g4) * 2 + yoff) = (u32x2){cvtpk(o0, o1), cvtpk(o2, o3)}; }
    }
#undef RC_LOADV
#undef RC_ROW
#undef RC_POS
}
constexpr int AT_KSTR = 104, AT_VSTR = 68;
constexpr int AT_KBYTES = 64 * AT_KSTR * 2, AT_VBYTES = 64 * AT_VSTR * 2, AT_BUF = AT_KBYTES + AT_VBYTES;
__device__ __forceinline__ void attn_unit(const Params& P, int b, int h, int qb, LAS unsigned char* lds, int tid) {
    const bf16_t* Q = (const bf16_t*)(P.ws + WS_Q); const bf16_t* KN = (const bf16_t*)(P.ws + WS_KN); const bf16_t* KR = (const bf16_t*)(P.ws + WS_KR);
    const bf16_t* VT = (const bf16_t*)(P.ws + WS_VT); bf16_t* Y = (bf16_t*)(P.ws + WS_XN);
    const int lane = tid & 63, wave = __builtin_amdgcn_readfirstlane(tid >> 6), r32 = lane & 31, hi = lane >> 5;
    const int qfirst = qb * 256 + wave * 32, qrow = qfirst + r32; const size_t tq = (size_t)b * SEQ + qrow;
    bf16x8 qf[6];
    { const bf16_t* qp = Q + tq * 768 + h * 96 + 8 * hi;
#pragma unroll
      for (int s = 0; s < 4; ++s) qf[s] = *(const bf16x8*)(qp + 16 * s);
      const u32x4 c4 = *(const u32x4*)(qp + 64), c5 = *(const u32x4*)(qp + 80);
      float inv[8];
#pragma unroll
      for (int e = 0; e < 8; ++e) inv[e] = INV64[2 * (8 * hi + e)];
      u32x4 o4, o5; rope_pair(c4, c5, (float)P.positions[tq], inv, 1.0f, o4, o5); qf[4] = as_frag(o4); qf[5] = as_frag(o5); }
    f32x16 o[2];
#pragma unroll
    for (int r = 0; r < 16; ++r) { o[0][r] = 0.f; o[1][r] = 0.f; }
    float l_part = 0.f;
    f32x16 negm;
#pragma unroll
    for (int r = 0; r < 16; ++r) negm[r] = 0.f;
    const int ntiles = 4 * qb + 4;
    const int kr = tid >> 3, kc = tid & 7, rr = tid >> 2, rc = tid & 3;
    const bf16_t* ksrc = KN + ((size_t)b * SEQ + kr) * 512 + h * 64 + kc * 8;
    const bf16_t* rsrc = KR + ((size_t)b * SEQ + rr) * 32 + rc * 8;
    const bf16_t* vsrc = VT + (size_t)(h * 64 + kr) * T + (size_t)b * SEQ + kc * 8;
    const int kdst = (kr * AT_KSTR + kc * 8) * 2, rdst = (rr * AT_KSTR + 64 + rc * 8) * 2, vdst = AT_KBYTES + (kr * AT_VSTR + kc * 8) * 2;
    u32x4 sk, sr, sv;
    sk = *(const u32x4*)ksrc; if (tid < 256) sr = *(const u32x4*)rsrc; sv = *(const u32x4*)vsrc;
    *(LAS u32x4*)(lds + kdst) = sk; if (tid < 256) *(LAS u32x4*)(lds + rdst) = sr;
    *(LAS u32x2*)(lds + vdst) = (u32x2){sv.x, sv.y}; *(LAS u32x2*)(lds + vdst + 8) = (u32x2){sv.z, sv.w};
    __syncthreads();
    for (int t = 0; t < ntiles; ++t) {
        const bool more = (t + 1 < ntiles);
        if (more) { sk = *(const u32x4*)(ksrc + (size_t)(t + 1) * 64 * 512); if (tid < 256) sr = *(const u32x4*)(rsrc + (size_t)(t + 1) * 64 * 32); sv = *(const u32x4*)(vsrc + (t + 1) * 64); }
        if (64 * t <= qfirst + 31) {
            LAS unsigned char* Kb = lds + (t & 1) * AT_BUF; LAS unsigned char* Vb = Kb + AT_KBYTES;
            f32x16 st[2];
#define AT_QK() do { _Pragma("unroll") for (int blk = 0; blk < 2; ++blk) { _Pragma("unroll") for (int s = 0; s < 6; ++s) { const bf16x8 kf = *(const LAS bf16x8*)(Kb + ((32 * blk + r32) * AT_KSTR + 16 * s + 8 * hi) * 2); \
                    st[blk] = __builtin_amdgcn_mfma_f32_32x32x16_bf16(kf, qf[s], s == 0 ? negm : st[blk], 0, 0, 0); } } \
                if (64 * t + 63 > qfirst) { _Pragma("unroll") for (int blk = 0; blk < 2; ++blk) _Pragma("unroll") for (int r = 0; r < 16; ++r) if (64 * t + 32 * blk + crow(r, hi) > qrow) st[blk][r] = -INFINITY; } } while (0)
            AT_QK();
            float ps = 0.f;
#pragma unroll
            for (int blk = 0; blk < 2; ++blk)
#pragma unroll
                for (int r = 0; r < 16; ++r) { const float p = __builtin_amdgcn_exp2f(st[blk][r]); st[blk][r] = p; ps += p; }
            if (t == 0 || __any(!(ps <= 4096.0f))) {
                AT_QK();
                float mx = fmaxf(st[0][0], st[1][0]);
#pragma unroll
                for (int r = 1; r < 16; ++r) mx = fmaxf(mx, fmaxf(st[0][r], st[1][r]));
                mx = fmaxf(mx, __shfl_xor(mx, 32));
                const float dl = (t == 0) ? mx : fmaxf(mx, 0.f), f = (t == 0) ? 1.f : __builtin_amdgcn_exp2f(-dl); l_part *= f; const float nm = negm[0] - dl;
#pragma unroll
                for (int r = 0; r < 16; ++r) { o[0][r] *= f; o[1][r] *= f; st[0][r] -= dl; st[1][r] -= dl; negm[r] = nm; }
                ps = 0.f;
#pragma unroll
                for (int blk = 0; blk < 2; ++blk)
#pragma unroll
                    for (int r = 0; r < 16; ++r) { const float p = __builtin_amdgcn_exp2f(st[blk][r]); st[blk][r] = p; ps += p; }
            }
#undef AT_QK
            l_part += ps;
#pragma unroll
            for (int jb = 0; jb < 2; ++jb)
#pragma unroll
                for (int sp = 0; sp < 2; ++sp) {
                    const bf16x8 pb = as_frag((u32x4){cvtpk(st[jb][8 * sp], st[jb][8 * sp + 1]), cvtpk(st[jb][8 * sp + 2], st[jb][8 * sp + 3]), cvtpk(st[jb][8 * sp + 4], st[jb][8 * sp + 5]), cvtpk(st[jb][8 * sp + 6], st[jb][8 * sp + 7])});
#pragma unroll
                    for (int dblk = 0; dblk < 2; ++dblk) { const LAS unsigned char* vp = Vb + ((32 * dblk + r32) * AT_VSTR + 32 * jb + 16 * sp + 4 * hi) * 2;
                        const u32x2 lo = *(const LAS u32x2*)vp, hh = *(const LAS u32x2*)(vp + 16);
                        o[dblk] = __builtin_amdgcn_mfma_f32_32x32x16_bf16(as_frag((u32x4){lo.x, lo.y, hh.x, hh.y}), pb, o[dblk], 0, 0, 0); }
                }
        }
        if (more) { LAS unsigned char* nb = lds + ((t + 1) & 1) * AT_BUF;
            *(LAS u32x4*)(nb + kdst) = sk; if (tid < 256) *(LAS u32x4*)(nb + rdst) = sr;
            *(LAS u32x2*)(nb + vdst) = (u32x2){sv.x, sv.y}; *(LAS u32x2*)(nb + vdst + 8) = (u32x2){sv.z, sv.w}; }
        __syncthreads();
    }
    const float l = l_part + __shfl_xor(l_part, 32), il = 1.0f / l;
#pragma unroll
    for (int dblk = 0; dblk < 2; ++dblk)
#pragma unroll
        for (int g4 = 0; g4 < 4; ++g4) { const int dv0 = 32 * dblk + 8 * g4 + 4 * hi;
            *(u32x2*)(Y + tq * D + h * 64 + dv0) = (u32x2){cvtpk(o[dblk][4 * g4] * il, o[dblk][4 * g4 + 1] * il), cvtpk(o[dblk][4 * g4 + 2] * il, o[dblk][4 * g4 + 3] * il)}; }
}
__device__ __forceinline__ void attn_phase(const Params& P, LAS unsigned char* lds, int tid) {
    const int G = gridDim.x, bx = blockIdx.x;
    if (G == 256) { const int vcu = (bx & 7) * 32 + (bx >> 3), bh = vcu >> 3, s = vcu & 7;
#pragma unroll 1
        for (int i = 0; i < 4; ++i) { const int qb = (i == 0) ? s : (i == 1) ? 15 - s : (i == 2) ? 16 + s : 31 - s; attn_unit(P, bh >> 3, bh & 7, qb, lds, tid); }
    } else {
#pragma unroll 1
        for (int u = bx; u < 1024; u += G) attn_unit(P, u >> 8, (u >> 5) & 7, 31 - (u & 31), lds, tid);
    }
}
struct UE { u32x4 e0, e1; };
struct UB { u32x4 b0, b1; int t; };
__device__ __forceinline__ unsigned u_load_raw(const Params& P, int t, int half, int lane) { return ((const unsigned*)(P.ws + WS_EIDX))[(size_t)t * 128 + 64 * half + lane]; }
__device__ __forceinline__ void u_expand(int lane, unsigned r, UE& E) {
    const int base = (lane >> 3) * 4;
#pragma unroll
    for (int i = 0; i < 4; ++i) { E.e0[i] = (unsigned)__builtin_amdgcn_ds_bpermute(base + 32 * i, (int)r); E.e1[i] = (unsigned)__builtin_amdgcn_ds_bpermute(base + 128 + 32 * i, (int)r); }
}
__device__ __forceinline__ void u_load_b(const Params& P, int t, int x, int lane, UB& I) {
    const int c = lane & 15, g = lane >> 4;
    I.b0 = (u32x4){0u, 0u, 0u, 0u}; I.b1 = I.b0; I.t = t;
    if (c < 2) { const unsigned char* hp = P.ws + WS_H2Q + (size_t)t * 2048 + c * 1024 + x * 128 + 32 * g; I.b0 = *(const u32x4*)hp; I.b1 = *(const u32x4*)(hp + 16); }
}
struct URing { u32x4 rv[8]; };
template <bool WRITE> __device__ __forceinline__ void u_step(const unsigned char* eu8, int lane, URing& R, const UE& En, LAS unsigned char* img) {
    const unsigned r8 = (unsigned)lane >> 3, p = (unsigned)lane & 7u;
#pragma unroll
    for (int i = 0; i < 8; ++i) { const unsigned e = (i < 4) ? En.e0[i] : En.e1[i - 4]; const unsigned swz = 4u * (unsigned)(i & 1) + (r8 >> 1);
        if (WRITE) *(LAS u32x4*)(img + 1024 * i + lane * 16) = R.rv[i];
        R.rv[i] = *(const u32x4*)(eu8 + (e * 128u + 16u * (p ^ swz)));
        __builtin_amdgcn_sched_barrier(0); }
}
__device__ __forceinline__ float quad_swap1(float v) { return __builtin_bit_cast(float, __builtin_amdgcn_update_dpp(0, __builtin_bit_cast(int, v), 0xB1, 0xf, 0xf, true)); }
__device__ __forceinline__ long mk64(unsigned lo, unsigned hi) { return (long)(((unsigned long long)hi << 32) | lo); }
__device__ __forceinline__ void u_compute(const Params& P, int x, int half, int lane, const UB& I, const LAS unsigned char* const (&ra)[4]) {
    unsigned short* ap = (unsigned short*)(P.ws + WS_APART) + ((size_t)x * T + I.t) * 128 + 64 * half; const int c = lane & 15, g = lane >> 4;
    const long B0 = mk64(I.b0.x, I.b0.y), B1 = mk64(I.b0.z, I.b0.w), B2 = mk64(I.b1.x, I.b1.y), B3 = mk64(I.b1.z, I.b1.w);
    f32x4 acc[4];
#pragma unroll
    for (int rb = 0; rb < 4; ++rb) {
        const long A0 = *(const LAS long*)(ra[0] + rb * 2048), A1 = *(const LAS long*)(ra[1] + rb * 2048), A2 = *(const LAS long*)(ra[2] + rb * 2048), A3 = *(const LAS long*)(ra[3] + rb * 2048);
        f32x4 a = {0.f, 0.f, 0.f, 0.f};
        a = __builtin_amdgcn_mfma_f32_16x16x32_fp8_fp8(A0, B0, a, 0, 0, 0);
        a = __builtin_amdgcn_mfma_f32_16x16x32_fp8_fp8(A1, B1, a, 0, 0, 0);
        a = __builtin_amdgcn_mfma_f32_16x16x32_fp8_fp8(A2, B2, a, 0, 0, 0);
        a = __builtin_amdgcn_mfma_f32_16x16x32_fp8_fp8(A3, B3, a, 0, 0, 0);
        acc[rb] = a;
    }
    float lo[4][4];
#pragma unroll
    for (int rb = 0; rb < 4; ++rb) { lo[rb][0] = quad_swap1(acc[rb].x); lo[rb][1] = quad_swap1(acc[rb].y); lo[rb][2] = quad_swap1(acc[rb].z); lo[rb][3] = quad_swap1(acc[rb].w); }
    if (c == 0) {
#pragma unroll
        for (int rb = 0; rb < 4; ++rb) {
            const h2_t p0 = {(_Float16)((acc[rb].x + lo[rb][0] * 0.0625f) * 0.0625f), (_Float16)((acc[rb].y + lo[rb][1] * 0.0625f) * 0.0625f)}, p1 = {(_Float16)((acc[rb].z + lo[rb][2] * 0.0625f) * 0.0625f), (_Float16)((acc[rb].w + lo[rb][3] * 0.0625f) * 0.0625f)};
            *(u32x2*)(ap + rb * 16 + 4 * g) = (u32x2){__builtin_bit_cast(unsigned, p0), __builtin_bit_cast(unsigned, p1)}; }
    }
}
__device__ __forceinline__ void peer_u_phase(const Params& P, int vw, int nw, int lane, LAS unsigned char* wl) {
    const int n = (T * 8 - vw + nw - 1) / nw, x = vw & 7;
    if (n <= 0) return;
    const unsigned char* eu8 = P.ws + WS_EU8 + (size_t)x * NEXP * 128;
    const int nu = 2 * n;
#define UTOK(u) ((((u) >> 1) < n ? vw + ((u) >> 1) * nw : vw) >> 3)
    const LAS unsigned char* ra[4];
    { const unsigned c = (unsigned)lane & 15u, g = (unsigned)lane >> 4, swz = (c >> 1) & 7u, hf0 = g & 1u; const LAS unsigned char* rowp = wl + c * 128;
      ra[0] = rowp + (((2u * g) ^ swz) * 16u + hf0 * 8u); ra[1] = rowp + (((2u * g) ^ swz) * 16u + (hf0 ^ 1u) * 8u); ra[2] = rowp + (((2u * g + 1u) ^ swz) * 16u + hf0 * 8u); ra[3] = rowp + (((2u * g + 1u) ^ swz) * 16u + (hf0 ^ 1u) * 8u); }
    UE E0, E1; UB B0, B1; URing R; unsigned r0, r1;
    r0 = u_load_raw(P, UTOK(0), 0, lane); r1 = u_load_raw(P, UTOK(1), 1, lane); u_load_b(P, UTOK(0), x, lane, B0);
    u_expand(lane, r0, E0); u_expand(lane, r1, E1);
    r0 = u_load_raw(P, UTOK(2), 0, lane); r1 = u_load_raw(P, UTOK(3), 1, lane);
    u_step<false>(eu8, lane, R, E0, wl);
    for (int u = 0; u < nu; u += 2) {
        u_load_b(P, UTOK(u + 1), x, lane, B1);
        u_expand(lane, r0, E0); r0 = u_load_raw(P, UTOK(u + 4), 0, lane);
        __builtin_amdgcn_sched_barrier(0);
        u_step<true>(eu8, lane, R, E1, wl);
        __builtin_amdgcn_sched_barrier(0);
        u_compute(P, x, 0, lane, B0, ra);
        __builtin_amdgcn_sched_barrier(0);
        u_load_b(P, UTOK(u + 2), x, lane, B0);
        u_expand(lane, r1, E1); r1 = u_load_raw(P, UTOK(u + 5), 1, lane);
        __builtin_amdgcn_sched_barrier(0);
        u_step<true>(eu8, lane, R, E0, wl);
        __builtin_amdgcn_sched_barrier(0);
        u_compute(P, x, 1, lane, B1, ra);
        __builtin_amdgcn_sched_barrier(0);
    }
#undef UTOK
}
__device__ __forceinline__ void peer_w_phase(const Params& P, size_t gt, size_t nt) {
    unsigned* eidx = (unsigned*)(P.ws + WS_EIDX); unsigned* gate = (unsigned*)(P.ws + WS_GATE); const unsigned short* ap = (const unsigned short*)(P.ws + WS_APART);
    const float* sui = (const float*)(P.ws + WS_SUI); const float* svi = (const float*)(P.ws + WS_SVI);
    const size_t N = (size_t)T * 32;
    u32x2 wn[8]; u32x4 en, gn;
#define W_LOAD(i_) do { _Pragma("unroll") for (int xx_ = 0; xx_ < 8; ++xx_) wn[xx_] = *(const u32x2*)(ap + (size_t)xx_ * T * 128 + (i_) * 4); en = *(const u32x4*)(eidx + (i_) * 4); gn = *(const u32x4*)(gate + (i_) * 4); } while (0)
    if (gt < N) W_LOAD(gt);
    for (size_t i = gt; i < N; i += nt) {
        f32x4 a = {0.f, 0.f, 0.f, 0.f};
#pragma unroll
        for (int xx = 0; xx < 8; ++xx) { const unsigned wx = wn[xx].x, wy = wn[xx].y;
            const h2_t f0 = __builtin_bit_cast(h2_t, wx), f1 = __builtin_bit_cast(h2_t, wy);
            a.x += (float)f0.x; a.y += (float)f0.y; a.z += (float)f1.x; a.w += (float)f1.y; }
        const u32x4 e = en; const u32x4 g = gn;
        float su[4], sv[4];
#pragma unroll
        for (int k = 0; k < 4; ++k) { su[k] = sui[e[k]]; sv[k] = svi[e[k]]; }
        { const size_t in = i + nt < N ? i + nt : i; W_LOAD(in); }
        a = a * 16.0f;
        u32x4 wo, eo;
#pragma unroll
        for (int k = 0; k < 4; ++k) { const unsigned gk = g[k]; const float w = __builtin_bit_cast(float, gk) * gelu_exact(a[k] * su[k]);
            const unsigned h = (unsigned)__builtin_bit_cast(unsigned short, (_Float16)w); wo[k] = h | (h << 16);
            eo[k] = ((unsigned)e[k] << 7) | __builtin_bit_cast(unsigned, sv[k]); }
        *(u32x4*)(gate + i * 4) = wo; *(u32x4*)(eidx + i * 4) = eo; }
#undef W_LOAD
}
#ifndef V_SCALE_MASK
#define V_SCALE_MASK 0
#endif
struct VHalf { u32x4 e0, e1, w0, w1; };
struct VRaw { unsigned e, w; };
struct VRing { u32x4 rv[8]; };
__device__ __forceinline__ void v_load_raw(const Params& P, int t, int half, int lane, VRaw& r) {
    r.e = ((const unsigned*)(P.ws + WS_EIDX))[(size_t)t * 128 + 64 * half + lane]; r.w = ((const unsigned*)(P.ws + WS_GATE))[(size_t)t * 128 + 64 * half + lane];
}
__device__ __forceinline__ void v_expand(int lane, const VRaw& r, VHalf& H) {
    const int base = (lane & 56) * 4;
#pragma unroll
    for (int i = 0; i < 4; ++i) { H.e0[i] = (unsigned)__builtin_amdgcn_ds_bpermute(base + 4 * i, (int)r.e); H.e1[i] = (unsigned)__builtin_amdgcn_ds_bpermute(base + 16 + 4 * i, (int)r.e);
        H.w0[i] = (unsigned)__builtin_amdgcn_ds_bpermute(base + 4 * i, (int)r.w); H.w1[i] = (unsigned)__builtin_amdgcn_ds_bpermute(base + 16 + 4 * i, (int)r.w); }
}
template <bool COMPUTE> __device__ __forceinline__ void v_step(const unsigned char* ev8, int lane, VRing& R, const VHalf& Hc, const VHalf& Hn, h2_t (&acc)[8]) {
    const unsigned sub16 = (unsigned)(lane & 7) * 16u;
#pragma unroll
    for (int i = 0; i < 8; ++i) {
        if (COMPUTE) { const unsigned ec = i < 4 ? Hc.e0[i & 3] : Hc.e1[i & 3], wc = i < 4 ? Hc.w0[i & 3] : Hc.w1[i & 3]; const h2_t w2 = __builtin_bit_cast(h2_t, wc);
            const float sc = __builtin_bit_cast(float, V_SCALE_MASK ? (ec & 0x7f800000u) : ec);
#pragma unroll
            for (int q = 0; q < 4; ++q) { const h2_t lo = __builtin_amdgcn_cvt_scalef32_pk_f16_fp8((int)R.rv[i][q], sc, false), hi = __builtin_amdgcn_cvt_scalef32_pk_f16_fp8((int)R.rv[i][q], sc, true);
                acc[2 * q] = __builtin_elementwise_fma(lo, w2, acc[2 * q]); acc[2 * q + 1] = __builtin_elementwise_fma(hi, w2, acc[2 * q + 1]); } }
        const unsigned en = i < 4 ? Hn.e0[i & 3] : Hn.e1[i & 3];
        R.rv[i] = *(const u32x4*)(ev8 + ((en & 0x1fff80u) | sub16));
        __builtin_amdgcn_sched_barrier(0);
    }
}
__device__ __forceinline__ h2_t h2_xor8(h2_t v) { return v + __builtin_bit_cast(h2_t, __builtin_amdgcn_update_dpp(0, __builtin_bit_cast(int, v), 0x128, 0xf, 0xf, false)); }
__device__ __forceinline__ h2_t h2_xor16(h2_t v) { return v + __builtin_bit_cast(h2_t, __builtin_amdgcn_ds_swizzle(__builtin_bit_cast(int, v), 0x401F)); }
__device__ __forceinline__ h2_t h2_xor32(h2_t v) { return v + __builtin_bit_cast(h2_t, __builtin_amdgcn_ds_bpermute((lane_now() ^ 32) * 4, __builtin_bit_cast(int, v))); }
__device__ __forceinline__ void v_finish(const Params& P, int x, int lane, int t, h2_t (&acc)[8]) {
    const int sub = lane & 7, gl = lane >> 3;
    unsigned w[8];
#pragma unroll
    for (int k = 0; k < 8; ++k) { const h2_t v = h2_xor32(h2_xor16(h2_xor8(acc[k]))); w[k] = __builtin_bit_cast(unsigned, v); acc[k] = (h2_t){(_Float16)0.f, (_Float16)0.f}; }
    if (gl == 0) { unsigned short* op = (unsigned short*)(P.ws + WS_PEER) + (size_t)t * D + x * 128 + sub * 16;
        *(u32x4*)op = (u32x4){w[0], w[1], w[2], w[3]}; *(u32x4*)(op + 8) = (u32x4){w[4], w[5], w[6], w[7]}; }
}
__device__ __forceinline__ void peer_v_phase(const Params& P, int vw, int nw, int lane) {
    const int n = (T * 8 - vw + nw - 1) / nw, x = vw & 7;
    if (n <= 0) return;
    const unsigned char* ev8 = P.ws + WS_EV8 + (size_t)x * NEXP * 128;
#define VTOK(u) ((((u) >> 1) < n ? vw + ((u) >> 1) * nw : vw) >> 3)
    VHalf A0, A1, B0, B1; VRaw ra, rb; VRing R0, R1; h2_t acc[8];
#pragma unroll
    for (int k = 0; k < 8; ++k) acc[k] = (h2_t){(_Float16)0.f, (_Float16)0.f};
    v_load_raw(P, VTOK(0), 0, lane, ra); v_load_raw(P, VTOK(1), 1, lane, rb); v_expand(lane, ra, A0); v_expand(lane, rb, B0);
    v_load_raw(P, VTOK(2), 0, lane, ra); v_load_raw(P, VTOK(3), 1, lane, rb);
    v_step<false>(ev8, lane, R0, A0, A0, acc); v_step<false>(ev8, lane, R1, B0, B0, acc);
    v_expand(lane, ra, A1); v_expand(lane, rb, B1);
    v_load_raw(P, VTOK(4), 0, lane, ra); v_load_raw(P, VTOK(5), 1, lane, rb);
#define V_PAIR(Ac, An, Bc, Bn, u_) do { \
        v_step<true>(ev8, lane, R0, Ac, An, acc); v_expand(lane, ra, Ac); v_load_raw(P, VTOK((u_) + 6), 0, lane, ra); __builtin_amdgcn_sched_barrier(0); \
        v_step<true>(ev8, lane, R1, Bc, Bn, acc); v_expand(lane, rb, Bc); v_load_raw(P, VTOK((u_) + 7), 1, lane, rb); __builtin_amdgcn_sched_barrier(0); \
        v_finish(P, x, lane, VTOK(u_), acc); } while (0)
    int u = 0;
    for (; u + 4 <= 2 * n; u += 4) { V_PAIR(A0, A1, B0, B1, u); V_PAIR(A1, A0, B1, B0, u + 2); }
    if (u < 2 * n) V_PAIR(A0, A1, B0, B1, u);
#undef V_PAIR
#undef VTOK
}
__device__ __forceinline__ void final_norm(const Params& P, int gw, int nw, int lane) {
    const unsigned short* peer = (const unsigned short*)(P.ws + WS_PEER); const float* mod = (const float*)(P.ws + WS_MOD);
    f32x4 gf[4];
#pragma unroll
    for (int j = 0; j < 4; ++j) gf[j] = *(const f32x4*)(P.g_final + lane * 4 + 256 * j);
    const bf16_t* x2b = (const bf16_t*)(P.ws + WS_X2B);
    f32x4 gn[4]; u32x2 xn[4], pn[4];
    auto load_row = [&](int row) { const u32x2* xr = (const u32x2*)(x2b + (size_t)row * D) + lane; const u32x2* pr = (const u32x2*)(peer + (size_t)row * D) + lane; const f32x4* gr = (const f32x4*)(mod + (size_t)(row / SEQ) * 6144 + 5 * D) + lane;
#pragma unroll
        for (int j = 0; j < 4; ++j) { xn[j] = xr[64 * j]; pn[j] = pr[64 * j]; gn[j] = gr[64 * j]; } };
    if (gw < T) load_row(gw);
    for (int row = gw; row < T; row += nw) { f32x4 v[4]; float ss = 0.f;
#pragma unroll
        for (int j = 0; j < 4; ++j) { const unsigned px = pn[j].x, py = pn[j].y; const h2_t p01 = __builtin_bit_cast(h2_t, px), p23 = __builtin_bit_cast(h2_t, py);
            v[j].x = bflo(xn[j].x) + gn[j].x * (float)p01.x; v[j].y = bfhi(xn[j].x) + gn[j].y * (float)p01.y; v[j].z = bflo(xn[j].y) + gn[j].z * (float)p23.x; v[j].w = bfhi(xn[j].y) + gn[j].w * (float)p23.y; }
        load_row(row + nw < T ? row + nw : row);
#pragma unroll
        for (int j = 0; j < 4; ++j) ss += (v[j].x * v[j].x + v[j].y * v[j].y) + (v[j].z * v[j].z + v[j].w * v[j].w);
        const float rstd = 1.0f / sqrtf(wave_sum(ss) * (1.f / D) + EPS);
        f32x4* xo = (f32x4*)(P.out + (size_t)row * D) + lane;
#pragma unroll
        for (int j = 0; j < 4; ++j) xo[64 * j] = v[j] * rstd * gf[j]; }
}

constexpr int RT_SKSTR = 136;
constexpr int RT_LDS = 2 * 128 * RT_SKSTR * 2;
__device__ __forceinline__ void ce_desc(float& a, float& b) { const float hi = fmaxf(a, b), lo = fminf(a, b); a = hi; b = lo; }
template <int K, int J> __device__ __forceinline__ void bstep(float (&a)[16]) {
#pragma unroll
    for (int i = 0; i < 16; ++i) { const int l = i ^ J; if (l > i) { if ((i & K) == 0) ce_desc(a[i], a[l]); else ce_desc(a[l], a[i]); } }
}
__device__ __forceinline__ void sort16_desc(float (&a)[16]) {
    ce_desc(a[0], a[13]); ce_desc(a[1], a[12]); ce_desc(a[2], a[15]); ce_desc(a[3], a[14]); ce_desc(a[4], a[8]); ce_desc(a[5], a[6]); ce_desc(a[7], a[11]); ce_desc(a[9], a[10]);
    ce_desc(a[0], a[5]); ce_desc(a[1], a[7]); ce_desc(a[2], a[9]); ce_desc(a[3], a[4]); ce_desc(a[6], a[13]); ce_desc(a[8], a[14]); ce_desc(a[10], a[15]); ce_desc(a[11], a[12]);
    ce_desc(a[0], a[1]); ce_desc(a[2], a[3]); ce_desc(a[4], a[5]); ce_desc(a[6], a[8]); ce_desc(a[7], a[9]); ce_desc(a[10], a[11]); ce_desc(a[12], a[13]); ce_desc(a[14], a[15]);
    ce_desc(a[0], a[2]); ce_desc(a[1], a[3]); ce_desc(a[4], a[10]); ce_desc(a[5], a[11]); ce_desc(a[6], a[7]); ce_desc(a[8], a[9]); ce_desc(a[12], a[14]); ce_desc(a[13], a[15]);
    ce_desc(a[1], a[2]); ce_desc(a[3], a[12]); ce_desc(a[4], a[6]); ce_desc(a[5], a[7]); ce_desc(a[8], a[10]); ce_desc(a[9], a[11]); ce_desc(a[13], a[14]);
    ce_desc(a[1], a[4]); ce_desc(a[2], a[6]); ce_desc(a[5], a[8]); ce_desc(a[7], a[10]); ce_desc(a[9], a[13]); ce_desc(a[11], a[14]);
    ce_desc(a[2], a[4]); ce_desc(a[3], a[6]); ce_desc(a[9], a[12]); ce_desc(a[11], a[13]);
    ce_desc(a[3], a[5]); ce_desc(a[6], a[8]); ce_desc(a[7], a[9]); ce_desc(a[10], a[12]);
    ce_desc(a[3], a[4]); ce_desc(a[5], a[6]); ce_desc(a[7], a[8]); ce_desc(a[9], a[10]); ce_desc(a[11], a[12]);
    ce_desc(a[6], a[7]); ce_desc(a[8], a[9]);
}
__device__ __forceinline__ void bitonic_merge16_desc(float (&a)[16]) { bstep<16, 8>(a); bstep<16, 4>(a); bstep<16, 2>(a); bstep<16, 1>(a); }
__device__ __forceinline__ void merge_top16(float (&a)[16], const float (&b)[16]) {
#pragma unroll
    for (int i = 0; i < 16; ++i) a[i] = fmaxf(a[i], b[15 - i]);
    bitonic_merge16_desc(a);
}
__device__ __forceinline__ float pack_key1(float v, unsigned cst) { return __builtin_bit_cast(float, (__builtin_bit_cast(unsigned, v) & 0xffffff80u) | cst); }
__device__ __forceinline__ void route_side(const bf16_t* qrow, const LAS unsigned char* sk, int lane, float (&top)[16]) {
    const int r32 = lane & 31, hi = lane >> 5;
    bf16x8 qf[8];
#pragma unroll
    for (int s = 0; s < 8; ++s) qf[s] = *(const bf16x8*)(qrow + 16 * s + 8 * hi);
    const unsigned hi4 = 4u * (unsigned)hi;
    float run[16];
#pragma unroll
    for (int kb = 0; kb < 4; ++kb) { f32x16 acc; float g[16];
#pragma unroll
        for (int r = 0; r < 16; ++r) acc[r] = 0.f;
#pragma unroll
        for (int s = 0; s < 8; ++s) { const bf16x8 kf = *(const LAS bf16x8*)(sk + ((32 * kb + r32) * RT_SKSTR + 16 * s + 8 * hi) * 2); acc = __builtin_amdgcn_mfma_f32_32x32x16_bf16(kf, qf[s], acc, 0, 0, 0); }
#pragma unroll
        for (int r = 0; r < 16; ++r) g[r] = pack_key1(acc[r], (unsigned)(32 * kb + crow(r, 0)));
        sort16_desc(g);
        if (kb == 0) {
#pragma unroll
            for (int r = 0; r < 16; ++r) run[r] = g[r];
        } else merge_top16(run, g);
        __builtin_amdgcn_sched_barrier(0);
    }
#pragma unroll
    for (int i = 0; i < 16; ++i) run[i] = __builtin_bit_cast(float, __builtin_bit_cast(unsigned, run[i]) | hi4);
    float pb[16]; const int pa = (lane ^ 32) * 4;
#pragma unroll
    for (int i = 0; i < 16; ++i) pb[i] = __builtin_bit_cast(float, __builtin_amdgcn_ds_bpermute(pa, __builtin_bit_cast(int, run[i])));
#pragma unroll
    for (int i = 0; i < 16; ++i) top[i] = run[i];
    merge_top16(top, pb);
}
__device__ __forceinline__ void route_unit(const Params& P, int unit, int lane, const LAS unsigned char* sklds, LAS unsigned char* keylds) {
    const bf16_t* QP = (const bf16_t*)(P.ws + WS_PROJ); int* eidx = (int*)(P.ws + WS_EIDX); float* gate = (float*)(P.ws + WS_GATE);
    const int tile = unit >> 2, hp = unit & 3, r32 = lane & 31, hi = lane >> 5;
    const size_t t = (size_t)tile * 32 + r32; const bf16_t* qt = QP + t * 2048;
    float A0[16], A1[16], B0[16], B1[16];
    PSEC_BEGIN(1);
    route_side(qt + (2 * hp) * 256, sklds, lane, A0); __builtin_amdgcn_sched_barrier(0); route_side(qt + (2 * hp) * 256 + 128, sklds + 128 * RT_SKSTR * 2, lane, A1); __builtin_amdgcn_sched_barrier(0);
    route_side(qt + (2 * hp + 1) * 256, sklds, lane, B0); __builtin_amdgcn_sched_barrier(0); route_side(qt + (2 * hp + 1) * 256 + 128, sklds + 128 * RT_SKSTR * 2, lane, B1); __builtin_amdgcn_sched_barrier(0);
    PSEC_END(1);
    PSEC_BEGIN(2);
    float L0[16], L1[16];
#pragma unroll
    for (int i = 0; i < 16; ++i) { L0[i] = hi ? B0[i] : A0[i]; L1[i] = hi ? B1[i] : A1[i]; }
    const int h = 2 * hp + hi;
#define RT_CAND(i_, j_) __builtin_bit_cast(float, (__builtin_bit_cast(unsigned, L0[i_] + L1[j_]) & 0xffffff00u) | (unsigned)(255 - ((i_) * 16 + (j_))))
    float best[16], x1[16], x2[16], x3[16];
#pragma unroll
    for (int j = 0; j < 16; ++j) best[j] = RT_CAND(0, j);
#pragma unroll
    for (int j = 0; j < 8; ++j) { x1[j] = RT_CAND(1, j); x1[15 - j] = RT_CAND(8 + j, 0); }
    bitonic_merge16_desc(x1);
    x2[0] = RT_CAND(2, 0); x2[1] = RT_CAND(2, 1); x2[2] = RT_CAND(2, 2); x2[3] = RT_CAND(2, 3); x2[4] = RT_CAND(2, 4); x2[5] = RT_CAND(3, 0); x2[6] = RT_CAND(3, 1); x2[7] = RT_CAND(3, 2);
    x2[8] = RT_CAND(3, 3); x2[9] = RT_CAND(4, 0); x2[10] = RT_CAND(4, 1); x2[11] = RT_CAND(4, 2); x2[12] = RT_CAND(5, 0); x2[13] = RT_CAND(5, 1); x2[14] = RT_CAND(6, 0); x2[15] = RT_CAND(6, 1);
    sort16_desc(x2);
    x3[0] = RT_CAND(7, 0); x3[1] = RT_CAND(7, 1);
#pragma unroll
    for (int j = 2; j < 16; ++j) x3[j] = -INFINITY;
    merge_top16(best, x1); merge_top16(best, x2); merge_top16(best, x3);
#undef RT_CAND
    { unsigned w[8];
#pragma unroll
      for (int q = 0; q < 4; ++q) { w[q] = (__builtin_bit_cast(unsigned, L0[4 * q]) & 0x7fu) | ((__builtin_bit_cast(unsigned, L0[4 * q + 1]) & 0x7fu) << 8) | ((__builtin_bit_cast(unsigned, L0[4 * q + 2]) & 0x7fu) << 16) | ((__builtin_bit_cast(unsigned, L0[4 * q + 3]) & 0x7fu) << 24);
          w[4 + q] = (__builtin_bit_cast(unsigned, L1[4 * q]) & 0x7fu) | ((__builtin_bit_cast(unsigned, L1[4 * q + 1]) & 0x7fu) << 8) | ((__builtin_bit_cast(unsigned, L1[4 * q + 2]) & 0x7fu) << 16) | ((__builtin_bit_cast(unsigned, L1[4 * q + 3]) & 0x7fu) << 24); }
      *(LAS u32x4*)(keylds) = (u32x4){w[0], w[1], w[2], w[3]}; *(LAS u32x4*)(keylds + 16) = (u32x4){w[4], w[5], w[6], w[7]}; }
    float e[16]; int ids[16]; float ssum = 0.f;
#pragma unroll
    for (int r = 0; r < 16; ++r) { const unsigned code = 255u - (__builtin_bit_cast(unsigned, best[r]) & 0xffu);
        ids[r] = (int)((unsigned)keylds[code >> 4] * 128u + (unsigned)keylds[16 + (code & 15u)]);
        e[r] = __expf(best[r] - best[0]); ssum += e[r]; }
    const float inv = 1.f / ssum;
#pragma unroll
    for (int r4 = 0; r4 < 4; ++r4) {
        *(u32x4*)(eidx + t * 128 + 16 * h + 4 * r4) = (u32x4){(unsigned)ids[4 * r4], (unsigned)ids[4 * r4 + 1], (unsigned)ids[4 * r4 + 2], (unsigned)ids[4 * r4 + 3]};
        *(f32x4*)(gate + t * 128 + 16 * h + 4 * r4) = (f32x4){e[4 * r4] * inv, e[4 * r4 + 1] * inv, e[4 * r4 + 2] * inv, e[4 * r4 + 3] * inv}; }
    PSEC_END(2);
}
__device__ __forceinline__ void route_phase(const Params& P, LAS unsigned char* lds, int tid, int gw, int nw) {
    const bf16_t* SK = (const bf16_t*)(P.ws + WS_SK);
    for (int i = tid; i < 2 * 128 * 16; i += 512) { const int row = i >> 4, ch = i & 15; *(LAS u32x4*)(lds + (row * RT_SKSTR + ch * 8) * 2) = *(const u32x4*)(SK + row * 128 + ch * 8); }
    __syncthreads();
    for (int u = gw; u < (T / 32) * 4; u += nw) route_unit(P, u, tid & 63, lds, lds + RT_LDS + (tid >> 6) * 2048 + (tid & 63) * 32);
}

#define XB_TMO      128
#define XB_XCNT(j)  (256  + 64 * (j))
#define XB_XSUB(j)  (1280 + 64 * (j))
#define XB_XGEN(j)  (2304 + 64 * (j))
#define XB_TOP      3328
#define XB_TOPGEN   3392
#define XCD_BAR_WORDS 3456
#define XB_SPIN_CAP (1u << 18)

__device__ __forceinline__ unsigned xb_ld(unsigned* p)              { return __hip_atomic_load(p, __ATOMIC_RELAXED, __HIP_MEMORY_SCOPE_AGENT); }
__device__ __forceinline__ unsigned xb_add(unsigned* p, unsigned v) { return __hip_atomic_fetch_add(p, v, __ATOMIC_RELAXED, __HIP_MEMORY_SCOPE_AGENT); }
__device__ __forceinline__ unsigned xb_xcc_id() { return (unsigned)__builtin_amdgcn_s_getreg((3 << 11) | 20) & 0xFu; }
#define XB_SPIN(cond, bar) do { unsigned _sp = 0; while (cond) { __builtin_amdgcn_s_sleep(1); \
    if ((++_sp & 255u) == 0u) { if (xb_ld(&(bar)[XB_TMO])) break; if (_sp > XB_SPIN_CAP) { atomicAdd(&(bar)[XB_TMO], 1u); break; } } } } while (0)

struct XcdBarrier {
    unsigned* bar; unsigned x;
    volatile PG8_LAS unsigned* st;
};

__device__ __forceinline__ XcdBarrier xcd_barrier_post(unsigned* bar, volatile PG8_LAS unsigned* st) {
    XcdBarrier b; b.bar = bar; b.x = xb_xcc_id(); b.st = st;
    if (threadIdx.x == 0) st[2] = xb_add(&bar[XB_XCNT(b.x)], 1u);
    return b;
}
__device__ __forceinline__ void xcd_barrier_complete(unsigned* bar, unsigned x, unsigned& nloc, unsigned& nx) {
    const unsigned G = gridDim.x * gridDim.y * gridDim.z;
    unsigned sum, cnt, mine, sp = 0u;
    for (;;) {
        sum = 0u; cnt = 0u; mine = 0u;
#pragma unroll
        for (unsigned j = 0; j < 16; ++j) { const unsigned c = xb_ld(&bar[XB_XCNT(j)]); sum += c; cnt += (c > 0u) ? 1u : 0u; mine = (j == x) ? c : mine; }
        if (sum == G) break;
        __builtin_amdgcn_s_sleep(1);
        if ((++sp & 255u) == 0u) { if (xb_ld(&bar[XB_TMO])) break; if (sp > XB_SPIN_CAP) { atomicAdd(&bar[XB_TMO], 1u); break; } }
    }
    nloc = mine > 0u ? mine : 1u; nx = cnt > 0u ? cnt : 1u;
}

__device__ __forceinline__ void xcd_barrier(const XcdBarrier& b) {
    asm volatile("s_waitcnt vmcnt(0)" ::: "memory");
    __syncthreads();
    if (tid_now() == 0) {
        unsigned* bar = b.bar;
        __builtin_amdgcn_s_waitcnt(0);
        unsigned nloc = b.st[0], nx = b.st[1];
        if (nloc == 0u) { xcd_barrier_complete(bar, b.x, nloc, nx); b.st[0] = nloc; b.st[1] = nx; }
        const unsigned old = xb_add(&bar[XB_XSUB(b.x)], 1u);
        const unsigned gen = old / nloc;
        if (old + 1u == (gen + 1u) * nloc) {
            __builtin_amdgcn_fence(__ATOMIC_RELEASE, "agent");
            asm volatile("s_waitcnt vmcnt(0)" ::: "memory");
            const unsigned og = xb_add(&bar[XB_TOP], 1u);
            const unsigned tg = og / nx;
            if (og + 1u == (tg + 1u) * nx) xb_add(&bar[XB_TOPGEN], 1u);
            else XB_SPIN(xb_ld(&bar[XB_TOPGEN]) == tg, bar);
            __builtin_amdgcn_fence(__ATOMIC_ACQUIRE, "agent");
            xb_add(&bar[XB_XGEN(b.x)], 1u);
            asm volatile("s_waitcnt vmcnt(0)" ::: "memory");
        } else {
            XB_SPIN(xb_ld(&bar[XB_XGEN(b.x)]) == gen, bar);
            __builtin_amdgcn_fence(__ATOMIC_ACQUIRE, "agent");
            asm volatile("s_waitcnt vmcnt(0)" ::: "memory");
        }
    }
    __syncthreads();
}

namespace cg = cooperative_groups;
constexpr int LDS_BYTES = 147456;
constexpr int CENSUS_OFF = 131072 + 8192;
struct KArgs { Params P; int ph_lo, ph_hi; };
__global__ void __launch_bounds__(512, 2) mk_fwd(KArgs ka) {
    extern __shared__ __attribute__((aligned(16))) unsigned char lds[];
    const Params& P = ka.P;
    cg::grid_group grid = cg::this_grid();
    PG8_LAS unsigned char* glds = (PG8_LAS unsigned char*)lds;
    if (threadIdx.x < 16) ((PG8_LAS volatile unsigned*)(glds + CENSUS_OFF))[threadIdx.x] = 0u;
    if ((threadIdx.x & 63u) == 0u) ((PG8_LAS volatile unsigned*)(glds + WAVE_TAB_OFF))[hw_slot()] = threadIdx.x >> 6;
    if (PROBE_SEC != 0 && threadIdx.x == 0) *PSEC_WORD = 0ull;
    __syncthreads();
    const XcdBarrier xbar = xcd_barrier_post((unsigned*)(ka.P.ws + WS_CTL), (PG8_LAS volatile unsigned*)(glds + CENSUS_OFF));
#define IDS() int tid_ = tid_now(); asm volatile("" : "+v"(tid_)); const int lane = tid_ & 63, wave = __builtin_amdgcn_readfirstlane(tid_ >> 6); \
    const int G = gridDim.x, gw = blockIdx.x * 8 + wave, nw = G * 8; const size_t gt = (size_t)blockIdx.x * 512 + tid_, nt = (size_t)G * 512; (void)lane; (void)gw; (void)nw; (void)gt; (void)nt;
#define IN(k) (ka.ph_lo <= (k) && (k) < ka.ph_hi)
#define STAMP(k) do { if (PROBE_MASK != 0u && blockIdx.x == 0 && threadIdx.x == 0) ((PG8_LAS volatile unsigned long long*)(glds + CENSUS_OFF + 64))[k] = PROBE_CLK ? __builtin_amdgcn_s_memtime() : __builtin_amdgcn_s_memrealtime(); } while (0)
    STAMP(0);
#define SYNC(k) do { if (IN(k) && IN((k) + 1)) { if ((k) == 0) grid.sync(); else xcd_barrier(xbar); } STAMP((k) + 1); } while (0)
#define WSP(T_, off) ((T_*)(P.ws + (off)))
    if (IN(0)) { IDS(); for (int nc = (int)blockIdx.x; nc < 24; nc += G) p0_mod_block(P, nc, wave, lane, tid_, (float*)lds); p0_prologue(P, wave * G + (int)blockIdx.x, nw, lane, (float*)(lds + wave * 8448)); }
    SYNC(0);
    if (IN(1)) { IDS(); rownorm_pass<false, false, false>(P, P.x, P.g_norm1, 0, 1, WSP(bf16_t, WS_XN), gw, nw, lane); }
    SYNC(1);
    if (IN(2)) {
        { pg8::Gemm g{WSP(const bf16_t, WS_XN), WSP(const bf16_t, WS_W1T), T, 2048, D, D, D}; pg8::StaticOrder S; S.init(T, 2048, gridDim.x, (int)blockIdx.x);
          epi::EpiStore<3> E{WSP(bf16_t, WS_PROJ), PLD, WSP(float, WS_SSQ), 0, 0.f}; pg8::gemm_phase<epi::EpiStore<3>, pg8::StaticOrder, true, true>(glds, g, S, E); }
        { pg8::Gemm g{WSP(const bf16_t, WS_W1TT), WSP(const bf16_t, WS_XN), 512, T, D, D, D}; pg8::StaticOrder S; S.init(512, T, gridDim.x, (int)blockIdx.x);
          epi::EpiStore<0> E{WSP(bf16_t, WS_PROJT), T, nullptr, 0, 0.f}; pg8::gemm_phase<epi::EpiStore<0>, pg8::StaticOrder, true, true>(glds, g, S, E); }
    }
    SYNC(2);
    if (IN(3)) {
        { pg8::Gemm g{WSP(const bf16_t, WS_PROJ) + PC_QL, WSP(const bf16_t, WS_WUQ), T, 768, 256, PLD, 256}; pg8::StaticOrder S; S.init(T, 768, gridDim.x, (int)blockIdx.x);
          epi::EpiStore<1> E{WSP(bf16_t, WS_Q), 768, WSP(float, WS_SSQ), 0, 1.f / 256.f}; pg8::gemm_phase<epi::EpiStore<1>, pg8::StaticOrder, true, true>(glds, g, S, E); }
        { pg8::Gemm g{WSP(const bf16_t, WS_PROJ) + PC_KVL, WSP(const bf16_t, WS_WK), T, 512, 256, PLD, 256}; pg8::StaticOrder S; S.init(T, 512, gridDim.x, (int)blockIdx.x);
          epi::EpiStore<1> E{WSP(bf16_t, WS_KN), 512, WSP(float, WS_SSQ), 1, 1.f / 128.f}; pg8::gemm_phase<epi::EpiStore<1>, pg8::StaticOrder, true, true>(glds, g, S, E); }
        { pg8::Gemm g{WSP(const bf16_t, WS_WV), WSP(const bf16_t, WS_PROJ) + PC_KVL, 512, T, 256, 256, PLD}; pg8::StaticOrder S; S.init(512, T, gridDim.x, (int)blockIdx.x);
          epi::EpiStore<2> E{WSP(bf16_t, WS_VT), T, WSP(float, WS_SSQ), 1, 1.f / 128.f}; pg8::gemm_phase<epi::EpiStore<2>, pg8::StaticOrder, true, true>(glds, g, S, E); }
        { IDS(); kr_pass(P, gt, nt); for (int i = gw; i < NB * 64 * NH; i += nw) ret_kvc_item(P, i, lane); }
    }
    SYNC(3);
    if (IN(4)) { IDS();
        ret_scan(P, gt, nt);
        __syncthreads();
        attn_phase(P, glds, tid_);
    }
    SYNC(4);
    if (IN(5)) { IDS(); for (int i = gw; i < NB * 64 * NH; i += nw) ret_out_item(P, i, lane, (LAS u32x4*)(glds + wave * 16384)); }
    SYNC(5);
    if (IN(6)) { pg8::Gemm g{WSP(const bf16_t, WS_XN), WSP(const bf16_t, WS_WOUT), T, D, D, D, D}; pg8::StaticOrder S; S.init(T, D, gridDim.x, (int)blockIdx.x);
        epi::EpiResid E{P.x, WSP(const float, WS_MOD), WSP(bf16_t, WS_X2B)}; pg8::gemm_phase<epi::EpiResid, pg8::StaticOrder, true, true>(glds, g, S, E); }
    SYNC(6);
    if (IN(7)) { IDS(); rownorm_pass<false, true, true>(P, WSP(const bf16_t, WS_X2B), P.g_norm2, 3, 4, WSP(bf16_t, WS_XN), gw, nw, lane); }
    SYNC(7);
    if (IN(8)) { pg8::Gemm g{WSP(const bf16_t, WS_XN), WSP(const bf16_t, WS_WQ), T, 2048, D, D, D}; pg8::StaticOrder S; S.init(T, 2048, gridDim.x, (int)blockIdx.x);
        epi::EpiStore<0> E{WSP(bf16_t, WS_PROJ), 2048, nullptr, 0, 0.f}; pg8::gemm_phase<epi::EpiStore<0>, pg8::StaticOrder, true, true>(glds, g, S, E); }
    SYNC(8);
    if (IN(9)) { IDS(); route_phase(P, glds, tid_, gw, nw); }
    SYNC(9);
#define SLICE_MAP() int vb = (int)blockIdx.x; { bool even = (G % 8) == 0; for (int j = 0; j < 8; ++j) even = even && (xb_ld((unsigned*)(P.ws + WS_CTL) + XB_XCNT(j)) == (unsigned)(G / 8)); \
        if (even) vb = (int)(((PG8_LAS volatile unsigned*)(glds + CENSUS_OFF))[2] * 8u + (xbar.x & 7u)); } const int vw = wave * G + vb;
    if (IN(10)) { IDS(); SLICE_MAP(); peer_u_phase(P, vw, nw, lane, glds + wave * 8192); }
    SYNC(10);
    if (IN(11)) { IDS(); peer_w_phase(P, gt, nt); }
    SYNC(11);
    if (IN(12)) { IDS(); SLICE_MAP(); peer_v_phase(P, vw, nw, lane); }
    SYNC(12);
    if (IN(13)) { IDS(); final_norm(P, gw, nw, lane); }
    if (PROBE_MASK != 0u && blockIdx.x == 0 && threadIdx.x == 0) {
        const unsigned long long tend = __builtin_amdgcn_s_memrealtime(); ((PG8_LAS volatile unsigned long long*)(glds + CENSUS_OFF + 64))[14] = PROBE_CLK ? __builtin_amdgcn_s_memtime() : tend;
        unsigned long long extra = 0;
        for (int k = 0; k < 14; ++k) if ((PROBE_MASK >> k) & 1u) extra += ((PG8_LAS volatile unsigned long long*)(glds + CENSUS_OFF + 64))[k + 1] - ((PG8_LAS volatile unsigned long long*)(glds + CENSUS_OFF + 64))[k];
        extra = PROBE_CLK ? extra * PROBE_MULT / 100 : extra * PROBE_MULT;
        if (PROBE_SEC != 0) extra = *PSEC_WORD * PROBE_MULT;
        while (__builtin_amdgcn_s_memrealtime() - tend < extra) __builtin_amdgcn_s_sleep(8);
    }
#undef IN
#undef SYNC
#undef IDS
#undef WSP
}

extern "C" void kernel_launch(void* const* d_in, const int* in_sizes, int n_in, void* d_out, int out_size, void* d_ws, size_t ws_size, hipStream_t stream) {
    if (n_in != 19 || out_size != T * D || ws_size < WS_END) { fprintf(stderr, "kernel_launch: unexpected shapes (n_in %d out %d ws %zu)\n", n_in, out_size, ws_size); return; }
    static int grid = 0;
    if (grid == 0) {
        int dev = 0, cus = 0, per_cu = 0;
        if (hipGetDevice(&dev) != hipSuccess || hipDeviceGetAttribute(&cus, hipDeviceAttributeMultiprocessorCount, dev) != hipSuccess) { fprintf(stderr, "kernel_launch: device query failed\n"); grid = -1; return; }
        if (hipFuncSetAttribute((const void*)mk_fwd, hipFuncAttributeMaxDynamicSharedMemorySize, LDS_BYTES) != hipSuccess) { fprintf(stderr, "kernel_launch: hipFuncSetAttribute failed\n"); grid = -1; return; }
        if (hipOccupancyMaxActiveBlocksPerMultiprocessor(&per_cu, (const void*)mk_fwd, 512, LDS_BYTES) != hipSuccess || per_cu < 1) { fprintf(stderr, "kernel_launch: occupancy query failed (%d)\n", per_cu); (void)hipGetLastError(); per_cu = 1; }
        grid = cus * (per_cu > 1 ? 1 : per_cu);
    }
    if (grid < 0) return;
    KArgs ka{};
    Params& P = ka.P;
    P.x = (const float*)d_in[0]; P.c = (const float*)d_in[1]; P.positions = (const int*)d_in[2]; P.w_ada = (const float*)d_in[3]; P.b_ada = (const float*)d_in[4];
    P.g_norm1 = (const float*)d_in[5]; P.w_in = (const float*)d_in[6]; P.g_q_norm = (const float*)d_in[7]; P.w_uq = (const float*)d_in[8]; P.g_kv_norm = (const float*)d_in[9];
    P.w_ukv = (const float*)d_in[10]; P.g_ret_norm = (const float*)d_in[11]; P.w_out = (const float*)d_in[12]; P.g_norm2 = (const float*)d_in[13]; P.w_query = (const float*)d_in[14];
    P.sub_keys = (const float*)d_in[15]; P.expert_u = (const float*)d_in[16]; P.expert_v = (const float*)d_in[17]; P.g_final = (const float*)d_in[18];
    P.out = (float*)d_out; P.ws = (unsigned char*)d_ws;
    ka.ph_lo = 0; ka.ph_hi = 14;
    if (hipMemsetAsync((char*)d_ws + WS_CTL, 0, 65536, stream) != hipSuccess) { fprintf(stderr, "kernel_launch: memset failed\n"); return; }
    void* args[] = {&ka};
    const hipError_t e = hipLaunchCooperativeKernel((const void*)mk_fwd, dim3(grid), dim3(512), args, LDS_BYTES, stream);
    if (e != hipSuccess) fprintf(stderr, "kernel_launch: cooperative launch failed: %s (grid %d)\n", hipGetErrorString(e), grid);
}
```

```cpp
#include <hip/hip_runtime.h>
#include <hip/hip_cooperative_groups.h>
#include <cstdint>
#include <cstdio>

#define PROBE_MASK 0u
#define PROBE_CLK 0
#define PROBE_MULT 1
#define PROBE_SEC 0
#define WAVE_TAB_OFF (131072 + 8192 + 512)
__device__ __forceinline__ unsigned hw_slot() { return (unsigned)__builtin_amdgcn_s_getreg((5 << 11) | 4) & 63u; }
__device__ __forceinline__ int wave_now() { return __builtin_amdgcn_readfirstlane((int)*((__attribute__((address_space(3))) volatile unsigned*)(unsigned)WAVE_TAB_OFF + hw_slot())); }
__device__ __forceinline__ int lane_now() { unsigned z = 0u; asm volatile("" : "+v"(z)); return (int)__builtin_amdgcn_mbcnt_hi(~0u, __builtin_amdgcn_mbcnt_lo(~0u, z)); }
__device__ __forceinline__ int tid_now() { return wave_now() * 64 + lane_now(); }
typedef unsigned short bf16_t;
typedef float f32x4 __attribute__((ext_vector_type(4)));
typedef unsigned u32x4 __attribute__((ext_vector_type(4)));
typedef unsigned u32x2 __attribute__((ext_vector_type(2)));
typedef float f32x2 __attribute__((ext_vector_type(2)));
typedef _Float16 h2_t __attribute__((ext_vector_type(2)));

constexpr int NB = 4, SEQ = 8192, T = NB * SEQ, D = 1024;
constexpr int IN_COLS = 2464;
constexpr int NH = 8;
constexpr int QK = 96, NOPE = 64, ROPE = 32, DV = 64;
constexpr int QR = 256, KVR = 128;
constexpr int NEXP = 16384, PK = 16, NKEYS = 128;
constexpr float EPS = 1e-6f;
constexpr float LOG2E = 1.4426950408889634f;
constexpr float QSCALE = 0.10206207261596575f * LOG2E;

constexpr size_t MiB = 1u << 20;
constexpr size_t WS_CTL = 0;
constexpr size_t WS_MOD = 3 * MiB - 128 * 1024;
constexpr size_t WS_SSQ = 3 * MiB;
constexpr size_t WS_W1T = 4 * MiB;
constexpr size_t WS_W1TT = 8 * MiB;
constexpr size_t WS_WUQ = 10 * MiB;
constexpr size_t WS_WK = 10 * MiB + 768 * 256 * 2;
constexpr size_t WS_WV = WS_WK + 512 * 256 * 2;
constexpr size_t WS_WOUT = 11 * MiB;
constexpr size_t WS_WQ = 13 * MiB;
constexpr size_t WS_SK = 17 * MiB;
constexpr size_t WS_EU8 = 18 * MiB;
constexpr size_t WS_EV8 = 34 * MiB;
constexpr size_t WS_SUI = 50 * MiB;
constexpr size_t WS_SVI = 50 * MiB + 65536;
constexpr size_t WS_XN = 82 * MiB;
constexpr size_t WS_PROJ = 146 * MiB;
constexpr size_t WS_PROJT = 274 * MiB;
constexpr size_t WS_Q = 338 * MiB;
constexpr size_t WS_KN = 386 * MiB;
constexpr size_t WS_KR = 418 * MiB;
constexpr size_t WS_VT = 420 * MiB;
constexpr size_t WS_KVC = 452 * MiB;
constexpr size_t WS_END = 484 * MiB;
constexpr size_t WS_PREVB = WS_PROJT + 32 * MiB;
constexpr size_t WS_EIDX = WS_PROJT;
constexpr size_t WS_GATE = WS_PROJT + 16 * MiB;
constexpr size_t WS_H2Q = WS_Q;
constexpr size_t WS_PEER = WS_Q;
constexpr size_t WS_X2B = WS_VT;
constexpr size_t WS_APART = WS_PROJ;

constexpr int PC_QL = 0, PC_KVL = 256, PC_KR = 384, PC_RQ = 512, PC_RK = 1024, PC_RG = 1536, PLD = 2048;
constexpr int PT_RV = 0;

__constant__ float INV64[32] = {1.0f, 0.749894261f, 0.562341332f, 0.421696514f, 0.316227764f, 0.237137377f, 0.177827939f, 0.133352131f, 0.100000001f, 0.0749894157f, 0.0562341325f, 0.0421696529f, 0.0316227749f, 0.0237137377f, 0.0177827943f, 0.0133352149f, 0.00999999978f, 0.00749894185f, 0.00562341325f, 0.00421696482f, 0.00316227763f, 0.00237137359f, 0.00177827943f, 0.00133352145f, 0.00100000005f, 0.000749894243f, 0.000562341302f, 0.000421696517f, 0.000316227757f, 0.00023713737f, 0.00017782794f, 0.00013335215f};

struct Params {
    const float *x, *c; const int* positions; const float *w_ada, *b_ada, *g_norm1, *w_in, *g_q_norm, *w_uq, *g_kv_norm, *w_ukv, *g_ret_norm, *w_out, *g_norm2, *w_query, *sub_keys, *expert_u, *expert_v, *g_final;
    float* out; unsigned char* ws;
};

__device__ __forceinline__ unsigned f2bf(float f) { unsigned u = __builtin_bit_cast(unsigned, f); return (u + 0x7fffu + ((u >> 16) & 1u)) >> 16; }
__device__ __forceinline__ unsigned pk2(float lo, float hi) { typedef __bf16 b2_t __attribute__((ext_vector_type(2))); const f32x2 v = {lo, hi}; const b2_t b = __builtin_convertvector(v, b2_t); return __builtin_bit_cast(unsigned, b); }
__device__ __forceinline__ float bf2f(unsigned short b) { return __builtin_bit_cast(float, (unsigned)b << 16); }
__device__ __forceinline__ float bflo(unsigned w) { return __builtin_bit_cast(float, w << 16); }
__device__ __forceinline__ float bfhi(unsigned w) { return __builtin_bit_cast(float, w & 0xffff0000u); }
__device__ __forceinline__ float wave_sum(float v) {
#pragma unroll
    for (int o = 1; o < 64; o <<= 1) v += __shfl_xor(v, o);
    return v;
}
__device__ __forceinline__ float silu_f(float v) { return v / (1.f + __expf(-v)); }
__device__ __forceinline__ float silu_fast(float v) { return v * __builtin_amdgcn_rcpf(1.f + __builtin_amdgcn_exp2f(-1.4426950408889634f * v)); }
__device__ __forceinline__ void sincos_rad(float ang, float& s, float& c) {
    const float CH = 0.15915494f, CL = 3.0918913e-09f;
    const float rh = ang * CH, rl = __builtin_fmaf(ang, CH, -rh) + ang * CL;
    const float fr = (rh - __builtin_floorf(rh)) + rl;
    s = __builtin_amdgcn_sinf(fr); c = __builtin_amdgcn_cosf(fr);
}
__device__ __forceinline__ float gelu_exact(float v) { return 0.5f * v * (1.f + erff(v * 0.70710678118654752f)); }

constexpr int MOD_CHUNKS = 192;
__device__ __forceinline__ void p0_mod_block(const Params& P, int nc, int wave, int lane, int tid, float* scr) {
    const int cq = lane & 7, rg = lane >> 3, n = nc * 32 + cq * 4, kb = wave * 128 + rg * 16;
    f32x4 cv[4][4], w[16];
#pragma unroll
    for (int b = 0; b < 4; ++b)
#pragma unroll
        for (int q = 0; q < 4; ++q) cv[b][q] = *(const f32x4*)(P.c + b * D + kb + 4 * q);
#pragma unroll
    for (int j = 0; j < 16; ++j) w[j] = __builtin_nontemporal_load((const f32x4*)(P.w_ada + (size_t)(kb + j) * 6144 + n));
#pragma unroll
    for (int b = 0; b < 4; ++b) { f32x4 a = {0.f, 0.f, 0.f, 0.f};
#pragma unroll
        for (int j = 0; j < 16; ++j) { const float cs = cv[b][j >> 2][j & 3]; a += w[j] * silu_f(cs); }
        *(f32x4*)(scr + ((wave * 8 + rg) * 4 + b) * 32 + cq * 4) = a; }
    __syncthreads();
    float* mod = (float*)(P.ws + WS_MOD);
    if (tid < 128) { const int b = tid >> 5, c = tid & 31; float sum = P.b_ada[nc * 32 + c];
#pragma unroll 8
        for (int p = 0; p < 64; ++p) sum += scr[(p * 4 + b) * 32 + c];
        mod[(size_t)b * 6144 + nc * 32 + c] = sum; }
    __syncthreads();
}
__device__ __forceinline__ void p0_mod_partial(const Params& P, int nc, int wave, int lane, float* scr) {
    const int cq = lane & 7, rg = lane >> 3, n = nc * 32 + cq * 4, kb = wave * 128 + rg * 16;
    f32x4 cv[4][4], w[16];
#pragma unroll
    for (int b = 0; b < 4; ++b)
#pragma unroll
        for (int q = 0; q < 4; ++q) cv[b][q] = *(const f32x4*)(P.c + b * D + kb + 4 * q);
#pragma unroll
    for (int j = 0; j < 16; ++j) w[j] = __builtin_nontemporal_load((const f32x4*)(P.w_ada + (size_t)(kb + j) * 6144 + n));
#pragma unroll
    for (int b = 0; b < 4; ++b) { f32x4 a = {0.f, 0.f, 0.f, 0.f};
#pragma unroll
        for (int j = 0; j < 16; ++j) { const float cs = cv[b][j >> 2][j & 3]; a += w[j] * silu_f(cs); }
        *(f32x4*)(scr + ((wave * 8 + rg) * 4 + b) * 32 + cq * 4) = a; }
}
__device__ __forceinline__ void p0_mod_final(const Params& P, int nc, int tid, const float* scr) {
    float* mod = (float*)(P.ws + WS_MOD);
    if (tid < 128) { const int b = tid >> 5, c = tid & 31; float sum = P.b_ada[nc * 32 + c];
#pragma unroll 8
        for (int p = 0; p < 64; ++p) sum += scr[(p * 4 + b) * 32 + c];
        mod[(size_t)b * 6144 + nc * 32 + c] = sum; }
}
constexpr int MOD_SCR_OFF = 8 * 8448;
__device__ __forceinline__ void p0_transpose_block(const float* W, int ldw, int k0, int n0, bf16_t* dst, int row0, int ldd, const float* kscale, float scale, float* scr, int lane) {
    float wv[32];
#pragma unroll
    for (int i = 0; i < 32; ++i) { const int kk = 2 * i + (lane >> 5); wv[i] = __builtin_nontemporal_load(W + (size_t)(k0 + kk) * ldw + n0 + (lane & 31)); }
#pragma unroll
    for (int i = 0; i < 32; ++i) { const int kk = 2 * i + (lane >> 5); const float ks = kscale ? kscale[k0 + kk] * scale : scale; scr[kk * 33 + (lane & 31)] = wv[i] * ks; }
    asm volatile("s_waitcnt vmcnt(0) lgkmcnt(0)" ::: "memory");
    const int c = lane & 7;
#pragma unroll
    for (int j = 0; j < 4; ++j) { const int n = (lane >> 3) + 8 * j; const float* s = scr + (8 * c) * 33 + n;
        u32x4 o; o.x = pk2(s[0 * 33], s[1 * 33]); o.y = pk2(s[2 * 33], s[3 * 33]); o.z = pk2(s[4 * 33], s[5 * 33]); o.w = pk2(s[6 * 33], s[7 * 33]);
        *(u32x4*)(dst + (size_t)(row0 + n) * ldd + k0 + 8 * c) = o; }
    asm volatile("s_waitcnt lgkmcnt(0)" ::: "memory");
}
__device__ __forceinline__ void cvt8(const float* src, bf16_t* dst, size_t n8, size_t gt, size_t nt) {
    for (size_t i = gt; i < n8; i += nt) { const f32x4 a = *(const f32x4*)(src + i * 8), b = *(const f32x4*)(src + i * 8 + 4);
        u32x4 o; o.x = pk2(a.x, a.y); o.y = pk2(a.z, a.w); o.z = pk2(b.x, b.y); o.w = pk2(b.z, b.w); *(u32x4*)(dst + i * 8) = o; }
}
__device__ __forceinline__ float wave_max(float v) {
#pragma unroll
    for (int o = 1; o < 64; o <<= 1) v = fmaxf(v, __shfl_xor(v, o));
    return v;
}
__device__ __forceinline__ unsigned pk_fp8x4(float a, float b, float c, float d) { int w = __builtin_amdgcn_cvt_pk_fp8_f32(a, b, 0, false); w = __builtin_amdgcn_cvt_pk_fp8_f32(c, d, w, true); return (unsigned)w; }
struct XPre { f32x4 n0, n1, n2, n3, m0, m1, m2, m3, q0, q1, q2, q3; };
#define XROW(s_) (gw + (s_) * nw)
#define XLOAD(a0_, a1_, a2_, a3_, s_) do { const int nr_ = XROW((s_) < n ? (s_) : n - 1); const float* src_ = (nr_ >= NEXP ? P.expert_v + (size_t)(nr_ - NEXP) * D : P.expert_u + (size_t)nr_ * D) + lane * 4; \
        a0_ = __builtin_nontemporal_load((const f32x4*)src_); a1_ = __builtin_nontemporal_load((const f32x4*)(src_ + 256)); a2_ = __builtin_nontemporal_load((const f32x4*)(src_ + 512)); a3_ = __builtin_nontemporal_load((const f32x4*)(src_ + 768)); } while (0)
__device__ __forceinline__ void p0_expert_preload(const Params& P, int gw, int nw, int lane, XPre& x) {
    const int N2 = 2 * NEXP, n = gw < N2 ? (N2 - gw + nw - 1) / nw : 0;
    if (n > 0) { XLOAD(x.n0, x.n1, x.n2, x.n3, 0); XLOAD(x.m0, x.m1, x.m2, x.m3, 1); XLOAD(x.q0, x.q1, x.q2, x.q3, 2); }
}
__device__ __forceinline__ void p0_expert_fp8(const Params& P, int gw, int nw, int lane, XPre& x) {
    const int N2 = 2 * NEXP, n = gw < N2 ? (N2 - gw + nw - 1) / nw : 0;
    for (int si = 0; si < n; ++si) {
        const int row = XROW(si); const bool isv = row >= NEXP; const int e = isv ? row - NEXP : row;
        const f32x4 v0 = x.n0, v1 = x.n1, v2 = x.n2, v3 = x.n3;
        x.n0 = x.m0; x.n1 = x.m1; x.n2 = x.m2; x.n3 = x.m3; x.m0 = x.q0; x.m1 = x.q1; x.m2 = x.q2; x.m3 = x.q3;
        XLOAD(x.q0, x.q1, x.q2, x.q3, si + 3);
        float am = fmaxf(fmaxf(fmaxf(fabsf(v0.x), fabsf(v0.y)), fmaxf(fabsf(v0.z), fabsf(v0.w))), fmaxf(fmaxf(fabsf(v1.x), fabsf(v1.y)), fmaxf(fabsf(v1.z), fabsf(v1.w))));
        am = fmaxf(am, fmaxf(fmaxf(fmaxf(fabsf(v2.x), fabsf(v2.y)), fmaxf(fabsf(v2.z), fabsf(v2.w))), fmaxf(fmaxf(fabsf(v3.x), fabsf(v3.y)), fmaxf(fabsf(v3.z), fabsf(v3.w)))));
        am = wave_max(am);
        const int be = (int)((__builtin_bit_cast(unsigned, am) >> 23) & 255u);
        float sc = 1.f, sci = 1.f;
        if (be >= 8 && be <= 250) { sc = __builtin_bit_cast(float, (unsigned)(261 - be) << 23); sci = __builtin_bit_cast(float, (unsigned)(be - 7) << 23); }
        unsigned char* dst = P.ws + (isv ? WS_EV8 : WS_EU8) + ((size_t)(lane >> 5) * NEXP + e) * 128 + (lane & 31) * 4;
        *(unsigned*)(dst) = pk_fp8x4(v0.x * sc, v0.y * sc, v0.z * sc, v0.w * sc); *(unsigned*)(dst + (size_t)2 * NEXP * 128) = pk_fp8x4(v1.x * sc, v1.y * sc, v1.z * sc, v1.w * sc);
        *(unsigned*)(dst + (size_t)4 * NEXP * 128) = pk_fp8x4(v2.x * sc, v2.y * sc, v2.z * sc, v2.w * sc); *(unsigned*)(dst + (size_t)6 * NEXP * 128) = pk_fp8x4(v3.x * sc, v3.y * sc, v3.z * sc, v3.w * sc);
        if (lane == 0) ((float*)(P.ws + (isv ? WS_SVI : WS_SUI)))[e] = sci;
    }
}
#undef XLOAD
#undef XROW
constexpr int IT_WIN = 16 * 77, IT_WUQ = 4 * 24, IT_WUKV = 2 * 32, IT_WOUT = 16 * 32, IT_WQ = 16 * 64;
constexpr int IT_TOTAL = IT_WIN + IT_WUQ + IT_WUKV + IT_WOUT + IT_WQ;
__device__ __forceinline__ void p0_prologue(const Params& P, int gw, int nw, int lane, float* scr, XPre& xp) {
    unsigned char* ws = P.ws;
    for (int it = gw, rnd = 0; it < IT_TOTAL; it = (++rnd) * nw + (nw - 1 - gw)) {
        int r = it;
        if (r < IT_WIN) { const int kb = r / 77, nb = r % 77, n0 = nb * 32, k0 = kb * 64;
            bf16_t* w1t = (bf16_t*)(ws + WS_W1T); bf16_t* w1tt = (bf16_t*)(ws + WS_W1TT);
            if (n0 < 416) p0_transpose_block(P.w_in, IN_COLS, k0, n0, w1t, n0, D, nullptr, 1.f, scr, lane);
            else if (n0 < 928) p0_transpose_block(P.w_in, IN_COLS, k0, n0, w1t, PC_RQ + (n0 - 416), D, nullptr, 1.f, scr, lane);
            else if (n0 < 1440) p0_transpose_block(P.w_in, IN_COLS, k0, n0, w1t, PC_RK + (n0 - 928), D, nullptr, 1.f, scr, lane);
            else if (n0 < 1952) p0_transpose_block(P.w_in, IN_COLS, k0, n0, w1tt, PT_RV + (n0 - 1440), D, nullptr, 1.f, scr, lane);
            else p0_transpose_block(P.w_in, IN_COLS, k0, n0, w1t, PC_RG + (n0 - 1952), D, nullptr, 1.f, scr, lane);
            continue; } r -= IT_WIN;
        if (r < IT_WUQ) { const int kb = r / 24, nb = r % 24; p0_transpose_block(P.w_uq, 768, kb * 64, nb * 32, (bf16_t*)(ws + WS_WUQ), nb * 32, 256, P.g_q_norm, QSCALE, scr, lane); continue; } r -= IT_WUQ;
        if (r < IT_WUKV) { const int kb = r / 32, nb = r % 32, n0 = nb * 32, h = n0 >> 7, rr = n0 & 127;
            if (rr < 64) p0_transpose_block(P.w_ukv, 1024, kb * 64, n0, (bf16_t*)(ws + WS_WK), h * 64 + rr, 256, P.g_kv_norm, 1.f, scr, lane);
            else p0_transpose_block(P.w_ukv, 1024, kb * 64, n0, (bf16_t*)(ws + WS_WV), h * 64 + rr - 64, 256, P.g_kv_norm, 1.f, scr, lane);
            continue; } r -= IT_WUKV;
        if (r < IT_WOUT) { const int kb = r / 32, nb = r % 32; p0_transpose_block(P.w_out, 1024, kb * 64, nb * 32, (bf16_t*)(ws + WS_WOUT), nb * 32, 1024, nullptr, 1.f, scr, lane); continue; } r -= IT_WOUT;
        { const int kb = r / 64, nb = r % 64; p0_transpose_block(P.w_query, 2048, kb * 64, nb * 32, (bf16_t*)(ws + WS_WQ), nb * 32, 1024, nullptr, 1.f, scr, lane); }
    }
    const size_t gt = (size_t)gw * 64 + lane, nt = (size_t)nw * 64;
    { u32x4 z = {0u, 0u, 0u, 0u};
      for (size_t i = gt; i < 96 * 1024 / 8; i += nt) *(u32x4*)((bf16_t*)(ws + WS_W1T) + (size_t)416 * 1024 + i * 8) = z;
      for (size_t i = gt; i < 2 * 512 * 16; i += nt) { const size_t m = i / (512 * 16), rr = (i / 16) % 512, cc = i % 16; *(u32x4*)((bf16_t*)(ws + (m ? WS_WV : WS_WK)) + rr * 256 + 128 + cc * 8) = z; }
    }
    cvt8(P.sub_keys, (bf16_t*)(ws + WS_SK), 2 * 128 * 128 / 8, gt, nt);
    p0_expert_fp8(P, gw, nw, lane, xp);
}

template <bool FROM_PART, bool WRITE_Q, bool SRC_BF16> __device__ __forceinline__ void rownorm_pass(const Params& P, const void* srcv, const float* g, int seg_sh, int seg_sc, bf16_t* dst, int gw, int nw, int lane) {
    const float* src = (const float*)srcv; const bf16_t* srcb = (const bf16_t*)srcv;
    auto ldrow = [&](int row, f32x4 (&o)[4]) { if (SRC_BF16) { const u32x2* p = (const u32x2*)(srcb + (size_t)row * D) + lane;
#pragma unroll
            for (int j = 0; j < 4; ++j) { const u32x2 w = p[64 * j]; o[j] = (f32x4){bflo(w.x), bfhi(w.x), bflo(w.y), bfhi(w.y)}; } }
        else { const f32x4* p = (const f32x4*)(src + (size_t)row * D) + lane;
#pragma unroll
            for (int j = 0; j < 4; ++j) o[j] = __builtin_nontemporal_load(p + 64 * j); } };
    const float* mod = (const float*)(P.ws + WS_MOD);
    for (int r0 = gw * 16; r0 < T; r0 += nw * 16) {
        const int b = r0 / SEQ;
        f32x4 mul[4], add[4];
#pragma unroll
        for (int j = 0; j < 4; ++j) {
            const int col = lane * 4 + 256 * j;
            f32x4 sc, sh;
            { sc = *(const f32x4*)(mod + (size_t)b * 6144 + seg_sc * D + col); sh = *(const f32x4*)(mod + (size_t)b * 6144 + seg_sh * D + col); }
            const f32x4 gg = *(const f32x4*)(g + col);
            mul[j] = gg * (sc + 1.0f); add[j] = sh;
        }
        f32x4 vn[4];
        ldrow(r0, vn);
        for (int rr = 0; rr < 16; ++rr) {
            const int row = r0 + rr;
            f32x4 v[4]; float s = 0.f;
#pragma unroll
            for (int j = 0; j < 4; ++j) v[j] = vn[j];
            ldrow(rr < 15 ? row + 1 : row, vn);
#pragma unroll
            for (int j = 0; j < 4; ++j) s += (v[j].x * v[j].x + v[j].y * v[j].y) + (v[j].z * v[j].z + v[j].w * v[j].w);
            const float rstd = 1.0f / sqrtf(wave_sum(s) * (1.f / D) + EPS);
            u32x2* o = (u32x2*)(dst + (size_t)row * D) + lane;
#pragma unroll
            for (int j = 0; j < 4; ++j) { const f32x4 y = v[j] * rstd * mul[j] + add[j]; u32x2 w; w.x = pk2(y.x, y.y); w.y = pk2(y.z, y.w); o[64 * j] = w;
                if (WRITE_Q) { const unsigned hq = pk_fp8x4(y.x, y.y, y.z, y.w); const f32x2 f01 = __builtin_amdgcn_cvt_pk_f32_fp8((int)hq, false), f23 = __builtin_amdgcn_cvt_pk_f32_fp8((int)hq, true);
                    const unsigned lq = pk_fp8x4(16.f * (y.x - f01.x), 16.f * (y.y - f01.y), 16.f * (y.z - f23.x), 16.f * (y.w - f23.y));
                    unsigned* q = (unsigned*)(P.ws + WS_H2Q + (size_t)row * 2048) + (lane ^ ((lane >> 2) & 2)) + 64 * j; q[0] = hq; q[256] = lq; } }
        }
    }
}
__device__ __forceinline__ void kr_pass(const Params& P, size_t gt, size_t nt) {
    const bf16_t* proj = (const bf16_t*)(P.ws + WS_PROJ); bf16_t* kr = (bf16_t*)(P.ws + WS_KR);
    for (size_t i = gt; i < (size_t)T * 16; i += nt) {
        const int t = (int)(i >> 4), f = (int)(i & 15);
        const float x1 = bf2f(proj[(size_t)t * PLD + PC_KR + f]), x2 = bf2f(proj[(size_t)t * PLD + PC_KR + 16 + f]);
        float s, c; sincos_rad((float)P.positions[t] * INV64[2 * f], s, c);
        kr[(size_t)t * 32 + f] = (bf16_t)f2bf(x1 * c - x2 * s); kr[(size_t)t * 32 + 16 + f] = (bf16_t)f2bf(x1 * s + x2 * c);
    }
}

namespace pg8 {
#define PG8_LAS __attribute__((address_space(3)))
typedef unsigned short bf16_t;
typedef short bf16x8 __attribute__((ext_vector_type(8)));
typedef float f32x4 __attribute__((ext_vector_type(4)));
typedef unsigned u32x4 __attribute__((ext_vector_type(4)));
constexpr int BM = 256, BK = 64, HALF = 128, HTB = HALF * BK * 2  , STAGE_BYTES = 8 * HTB, NXCD = 8, WGM = 8;

__host__ __device__ __forceinline__ int lds_byte(int r, int c) { const int st = (r >> 4) * 2 + (c >> 5), rr = r & 15, cc = c & 31, ob = rr * 64 + cc * 2; return st * 1024 + (ob ^ (((ob >> 9) & 1) << 5)); }
__host__ __device__ __forceinline__ void stage_rc(int b, int& R, int& C) { const int st = b / 1024, sb = b % 1024, swz = sb ^ (((sb >> 9) & 1) << 5); R = (st >> 1) * 16 + swz / 64; C = (st & 1) * 32 + (swz % 64) / 2; }
__host__ __device__ __forceinline__ int perm32(int rho) { const int n = rho >> 4, i = rho & 15; return 8 * (i >> 2) + 4 * n + (i & 3); }

struct Unit { int pm, pn; };
struct Gemm { const bf16_t* A; const bf16_t* Bt; int M, N, K, lda, ldb; int split = 1 << 30; int acol2 = 0; };

struct StaticOrder {
    int nM, nN, nwg, G, c;
    __host__ __device__ void init(int M, int N, int G_, int c_) { nM = M / BM; nN = N / BM; nwg = nM * nN; G = G_; c = c_; }
    __host__ __device__ bool next(int i, Unit& u) const {
        const long L = (long)i * G + c; if (L >= nwg) return false;
        int wgid = (int)L; { const int q = nwg / NXCD, r = nwg % NXCD, xcd = wgid % NXCD, off = wgid / NXCD; wgid = (xcd < r ? xcd * (q + 1) : r * (q + 1) + (xcd - r) * q) + off; }
        const int nig = WGM * nN, gid = wgid / nig, fm = gid * WGM, gsz = (nM - fm) < WGM ? (nM - fm) : WGM;
        u.pm = fm + ((wgid % nig) % gsz); u.pn = (wgid % nig) / gsz; return true;
    }
    __device__ __forceinline__ void a_ready(const Unit&) const {}
    __device__ __forceinline__ void done(const Unit&) const {}
};


template <class Epi, class Sched, bool ALIGN_EPI = false, bool SP2 = false>
__device__ __forceinline__ void gemm_phase(PG8_LAS unsigned char* lds, const Gemm g, const Sched& S, const Epi& E) {
    int tid = tid_now(); asm volatile("" : "+v"(tid));
    const int wid = __builtin_amdgcn_readfirstlane(tid >> 6), lane = tid & 63, wr = wid >> 2, wc = wid & 3, fr = lane & 15, fq = lane >> 4;
    const int K = g.K, nt = K / BK;
    unsigned voffA[2], voffB[2];
#pragma unroll
    for (int i = 0; i < 2; ++i) { int R, C; stage_rc(tid * 16 + i * 8192, R, C); const int Rb = Epi::PERM ? ((R & ~31) + perm32(R & 31)) : R;
        voffA[i] = (unsigned)(R * g.lda + C) * 2u; voffB[i] = (unsigned)(Rb * g.ldb + C) * 2u; }
    const size_t kstep = (size_t)(BK * 2);
    const size_t hstepA = (size_t)HALF * g.lda * 2, hstepB = (size_t)HALF * g.ldb * 2;
    const size_t tstepA = 2 * hstepA, tstepB = 2 * hstepB;
    const unsigned ldsw = (unsigned)wid * 1024u;
    const int aoff = lds_byte(wr * 64 + fr, fq * 8), boff = lds_byte(wc * 32 + fr, fq * 8);
#define PG8_SA(b, h) (((b) * 2 + (h)) * HTB)
#define PG8_SB(b, h) ((4 + (b) * 2 + (h)) * HTB)
#define PG8_STAGE(bufoff, gbase, voff) do { _Pragma("unroll") for (int _i = 0; _i < 2; ++_i) \
        __builtin_amdgcn_global_load_lds((const unsigned*)((const char*)(gbase) + (voff)[_i]), (PG8_LAS unsigned*)(lds + (bufoff) + ldsw + _i * 8192), 16, 0, 0); } while (0)
#define PG8_LDA(dst, b, h) do { _Pragma("unroll") for (int m = 0; m < 4; ++m) _Pragma("unroll") for (int k = 0; k < 2; ++k) dst[m][k] = *(const PG8_LAS bf16x8*)(lds + PG8_SA(b, h) + aoff + m * 2048 + k * 1024); } while (0)
#define PG8_LDB(dst, b, h) do { _Pragma("unroll") for (int n = 0; n < 2; ++n) _Pragma("unroll") for (int k = 0; k < 2; ++k) dst[n][k] = *(const PG8_LAS bf16x8*)(lds + PG8_SB(b, h) + boff + n * 2048 + k * 1024); } while (0)
#define PG8_MMA(ai, bj, At, Bt) do { __builtin_amdgcn_s_setprio(1); _Pragma("unroll") for (int m = 0; m < 4; ++m) _Pragma("unroll") for (int n = 0; n < 2; ++n) _Pragma("unroll") for (int k = 0; k < 2; ++k) \
        acc[ai][bj][m][n] = __builtin_amdgcn_mfma_f32_16x16x32_bf16(Bt[n][k], At[m][k], acc[ai][bj][m][n], 0, 0, 0); __builtin_amdgcn_s_setprio(0); } while (0)
#define PG8_WAIT_V(n) asm volatile("s_waitcnt vmcnt(" #n ")" ::: "memory")
#define PG8_WAIT_L(n) asm volatile("s_waitcnt lgkmcnt(" #n ")" ::: "memory")
#define PG8_BAR __builtin_amdgcn_s_barrier()
#define PG8_SCHED __builtin_amdgcn_sched_barrier(0)
    Unit cur, nxt; int ui = 0;
    if (!S.next(0, cur)) return;
    f32x4 acc[2][2][4][2];
#pragma unroll
    for (int a = 0; a < 2; ++a)
#pragma unroll
        for (int b = 0; b < 2; ++b)
#pragma unroll
            for (int m = 0; m < 4; ++m)
#pragma unroll
                for (int n = 0; n < 2; ++n) acc[a][b][m][n] = (f32x4){0.f, 0.f, 0.f, 0.f};
    bf16x8 At[4][2], B0[2][2], B1[2][2];
    const char* cA = (const char*)g.A + (size_t)cur.pm * tstepA + (cur.pn >= g.split ? (size_t)g.acol2 * 2 : (size_t)0); const char* cB = (const char*)g.Bt + (size_t)cur.pn * tstepB;
    S.a_ready(cur);
    if constexpr (SP2) {
        PG8_STAGE(PG8_SB(0, 0), cB, voffB); PG8_STAGE(PG8_SB(0, 1), cB + hstepB, voffB); PG8_STAGE(PG8_SA(0, 0), cA, voffA); PG8_STAGE(PG8_SA(0, 1), cA + hstepA, voffA);
        if (wr == 1) PG8_BAR;
        PG8_WAIT_V(2); PG8_BAR;
        PG8_STAGE(PG8_SB(1, 0), cB + kstep, voffB); PG8_STAGE(PG8_SA(1, 0), cA + kstep, voffA); PG8_STAGE(PG8_SB(1, 1), cB + hstepB + kstep, voffB);
        PG8_WAIT_V(6); PG8_BAR;
    } else {
        PG8_STAGE(PG8_SB(0, 0), cB, voffB); PG8_STAGE(PG8_SA(0, 0), cA, voffA); PG8_STAGE(PG8_SB(0, 1), cB + hstepB, voffB); PG8_STAGE(PG8_SA(0, 1), cA + hstepA, voffA);
        if (wr == 1) PG8_BAR;
        PG8_WAIT_V(4); PG8_BAR;
        PG8_STAGE(PG8_SB(1, 0), cB + kstep, voffB); PG8_STAGE(PG8_SA(1, 0), cA + kstep, voffA); PG8_STAGE(PG8_SB(1, 1), cB + hstepB + kstep, voffB);
        PG8_WAIT_V(6); PG8_BAR;
    }
    for (;;) {
        const bool has_next = S.next(ui + 1, nxt);
        const char* nA = has_next ? (const char*)g.A + (size_t)nxt.pm * tstepA + (nxt.pn >= g.split ? (size_t)g.acol2 * 2 : (size_t)0) : cA; const char* nB = has_next ? (const char*)g.Bt + (size_t)nxt.pn * tstepB : cB;
        for (int t = 0; t < nt; t += 2) {
            const bool last = (t == nt - 2);
            const char* a1 = cA + (size_t)(t + 1) * kstep;
            const char* a2 = last ? nA : cA + (size_t)(t + 2) * kstep; const char* b2 = last ? nB : cB + (size_t)(t + 2) * kstep;
            const char* a3 = a2 + kstep; const char* b3 = b2 + kstep;
            if (last && has_next) S.a_ready(nxt);
            if constexpr (SP2) {
            PG8_LDB(B0, 0, 0); PG8_LDB(B1, 0, 1); PG8_SCHED; PG8_LDA(At, 0, 0); PG8_STAGE(PG8_SA(1, 1), a1 + hstepA, voffA);
            PG8_WAIT_V(8); PG8_WAIT_L(0); PG8_BAR; PG8_MMA(0, 0, At, B0); PG8_MMA(0, 1, At, B1); PG8_BAR; PG8_SCHED;
            PG8_LDA(At, 0, 1); PG8_STAGE(PG8_SB(0, 0), b2, voffB); PG8_STAGE(PG8_SB(0, 1), b2 + hstepB, voffB); PG8_STAGE(PG8_SA(0, 0), a2, voffA);
            PG8_WAIT_V(8); PG8_WAIT_L(0); PG8_BAR; PG8_MMA(1, 0, At, B0); PG8_MMA(1, 1, At, B1); PG8_BAR; PG8_SCHED;
            PG8_LDB(B0, 1, 0); PG8_LDB(B1, 1, 1); PG8_SCHED; PG8_LDA(At, 1, 0); PG8_STAGE(PG8_SA(0, 1), a2 + hstepA, voffA);
            PG8_WAIT_V(8); PG8_WAIT_L(0); PG8_BAR; PG8_MMA(0, 0, At, B0); PG8_MMA(0, 1, At, B1); PG8_BAR; PG8_SCHED;
            PG8_LDA(At, 1, 1); PG8_STAGE(PG8_SB(1, 0), b3, voffB); PG8_STAGE(PG8_SB(1, 1), b3 + hstepB, voffB); PG8_STAGE(PG8_SA(1, 0), a3, voffA);
            PG8_WAIT_V(8); PG8_WAIT_L(0); PG8_BAR; PG8_MMA(1, 0, At, B0); PG8_MMA(1, 1, At, B1); PG8_BAR; PG8_SCHED;
            } else {
            PG8_LDB(B0, 0, 0); PG8_SCHED; PG8_LDA(At, 0, 0); PG8_STAGE(PG8_SA(1, 1), a1 + hstepA, voffA);
            PG8_WAIT_L(8); PG8_BAR; PG8_WAIT_L(0); PG8_MMA(0, 0, At, B0); PG8_BAR; PG8_SCHED;
            PG8_LDB(B1, 0, 1); PG8_STAGE(PG8_SB(0, 0), b2, voffB);
            PG8_BAR; PG8_WAIT_L(0); PG8_MMA(0, 1, At, B1); PG8_BAR;
            PG8_LDA(At, 0, 1); PG8_STAGE(PG8_SA(0, 0), a2, voffA);
            PG8_BAR; PG8_WAIT_L(0); PG8_MMA(1, 0, At, B0); PG8_BAR; PG8_SCHED;
            PG8_STAGE(PG8_SB(0, 1), b2 + hstepB, voffB);
            PG8_WAIT_V(6); PG8_BAR; PG8_MMA(1, 1, At, B1); PG8_BAR;
            PG8_LDB(B0, 1, 0); PG8_SCHED; PG8_LDA(At, 1, 0); PG8_STAGE(PG8_SA(0, 1), a2 + hstepA, voffA);
            PG8_WAIT_L(8); PG8_BAR; PG8_WAIT_L(0); PG8_MMA(0, 0, At, B0); PG8_BAR; PG8_SCHED;
            PG8_LDB(B1, 1, 1); PG8_STAGE(PG8_SB(1, 0), b3, voffB);
            PG8_BAR; PG8_WAIT_L(0); PG8_MMA(0, 1, At, B1); PG8_BAR;
            PG8_LDA(At, 1, 1); PG8_STAGE(PG8_SA(1, 0), a3, voffA);
            PG8_BAR; PG8_WAIT_L(0); PG8_MMA(1, 0, At, B0); PG8_BAR; PG8_SCHED;
            PG8_STAGE(PG8_SB(1, 1), b3 + hstepB, voffB);
            PG8_WAIT_V(6); PG8_BAR; PG8_MMA(1, 1, At, B1); PG8_BAR;
            }
        }
        if constexpr (ALIGN_EPI) { if (wr == 0) PG8_BAR; }
        if constexpr (!Epi::AFTER_DRAIN) { E(acc, cur, wr, wc, fr, fq); S.done(cur); }
        if (!has_next) break;
#pragma unroll
        for (int a = 0; a < 2; ++a)
#pragma unroll
            for (int b = 0; b < 2; ++b)
#pragma unroll
                for (int m = 0; m < 4; ++m)
#pragma unroll
                    for (int n = 0; n < 2; ++n) acc[a][b][m][n] = (f32x4){0.f, 0.f, 0.f, 0.f};
        cur = nxt; cA = nA; cB = nB; ++ui;
        if constexpr (ALIGN_EPI) { if (wr == 1) PG8_BAR; }
    }
    PG8_WAIT_V(0);
    if constexpr (!ALIGN_EPI) { if (wr == 0) PG8_BAR; }
    PG8_BAR;
    if constexpr (Epi::AFTER_DRAIN) { E.fused(acc, cur, wr, wc, fr, fq, lds, wid, lane); S.done(cur); }
#undef PG8_SA
#undef PG8_SB
#undef PG8_STAGE
#undef PG8_LDA
#undef PG8_LDB
#undef PG8_MMA
#undef PG8_WAIT_V
#undef PG8_WAIT_L
#undef PG8_BAR
#undef PG8_SCHED
}
}

namespace epi {
using pg8::f32x4; using pg8::u32x4; using pg8::Unit; using pg8::HALF; using pg8::BM;
__device__ __forceinline__ unsigned cvt_pk_bf16(float lo, float hi) { typedef __bf16 b2 __attribute__((ext_vector_type(2))); const f32x2 v = {lo, hi}; const b2 b = __builtin_convertvector(v, b2); return __builtin_bit_cast(unsigned, b); }
template <int MODE> struct EpiStore {
    static constexpr bool PERM = true, AFTER_DRAIN = false;
    bf16_t* O; int ldc; float* ssq; int which; float inv_n;
    __device__ __forceinline__ void operator()(const f32x4 (&acc)[2][2][4][2], const Unit& u, int wr, int wc, int fr, int fq) const {
        int row0 = u.pm * BM + wr * 64 + fr, col0 = u.pn * BM + wc * 32 + 8 * fq;
        if (MODE == 2) {
#pragma unroll
            for (int bj = 0; bj < 2; ++bj) { float cs[8];
#pragma unroll
                for (int i = 0; i < 8; ++i) { const f32x4 pq = *(const f32x4*)(ssq + 8 * (col0 + bj * HALF + i) + 4 * which); cs[i] = __builtin_amdgcn_rsqf(((pq.x + pq.y) + (pq.z + pq.w)) * inv_n + EPS); }
#pragma unroll
                for (int ai = 0; ai < 2; ++ai)
#pragma unroll
                    for (int m = 0; m < 4; ++m) { bf16_t* rowp = O + (size_t)(row0 + ai * HALF + m * 16) * ldc + col0 + bj * HALF; const f32x4 v0 = acc[ai][bj][m][0], v1 = acc[ai][bj][m][1];
                        u32x4 w; w.x = cvt_pk_bf16(v0[0] * cs[0], v0[1] * cs[1]); w.y = cvt_pk_bf16(v0[2] * cs[2], v0[3] * cs[3]); w.z = cvt_pk_bf16(v1[0] * cs[4], v1[1] * cs[5]); w.w = cvt_pk_bf16(v1[2] * cs[6], v1[3] * cs[7]);
                        *(u32x4*)rowp = w; } }
            return;
        }
#pragma unroll
        for (int ai = 0; ai < 2; ++ai) {
            f32x4 pqv[4];
            if (MODE == 1) {
#pragma unroll
                for (int m = 0; m < 4; ++m) pqv[m] = *(const f32x4*)(ssq + 8 * (row0 + ai * HALF + m * 16) + 4 * which);
            }
#pragma unroll
            for (int m = 0; m < 4; ++m) { const int row = row0 + ai * HALF + m * 16; bf16_t* rowp = O + (size_t)row * ldc + col0;
                float rs = 1.f; if (MODE == 1) { const f32x4 pq = pqv[m]; rs = __builtin_amdgcn_rsqf(((pq.x + pq.y) + (pq.z + pq.w)) * inv_n + EPS); }
                float sq = 0.f;
#pragma unroll
                for (int bj = 0; bj < 2; ++bj) { f32x4 v0 = acc[ai][bj][m][0], v1 = acc[ai][bj][m][1];
                    if (MODE == 1) { v0 = v0 * rs; v1 = v1 * rs; }
                    if (MODE == 3 && (u.pn == 0 || (u.pn == 1 && bj == 0))) sq += (v0.x * v0.x + v0.y * v0.y) + (v0.z * v0.z + v0.w * v0.w) + (v1.x * v1.x + v1.y * v1.y) + (v1.z * v1.z + v1.w * v1.w);
                    u32x4 w; w.x = cvt_pk_bf16(v0[0], v0[1]); w.y = cvt_pk_bf16(v0[2], v0[3]); w.z = cvt_pk_bf16(v1[0], v1[1]); w.w = cvt_pk_bf16(v1[2], v1[3]);
                    *(u32x4*)(rowp + bj * HALF) = w; }
                if (MODE == 3 && u.pn < 2) { sq += __shfl_xor(sq, 16); sq += __shfl_xor(sq, 32); if (fq == 0) ssq[8 * row + 4 * u.pn + wc] = sq; }
            }
        }
    }
};
struct EpiStoreSplit {
    static constexpr bool PERM = true, AFTER_DRAIN = false;
    bf16_t* O0; int ldc0; int which0; float inv0; int e0; bf16_t* O1; int ldc1; int which1; float inv1; int e1; bf16_t* O2; int ldc2; int which2; float inv2; float* ssq;
    __device__ __forceinline__ void operator()(const f32x4 (&acc)[2][2][4][2], const Unit& u, int wr, int wc, int fr, int fq) const {
        if (u.pn < e0) { const EpiStore<1> E{O0, ldc0, ssq, which0, inv0}; E(acc, u, wr, wc, fr, fq); }
        else if (u.pn < e1) { const Unit u2 = {u.pm, u.pn - e0}; const EpiStore<1> E{O1, ldc1, ssq, which1, inv1}; E(acc, u2, wr, wc, fr, fq); }
        else { const Unit u2 = {u.pm, u.pn - e1}; const EpiStore<1> E{O2, ldc2, ssq, which2, inv2}; E(acc, u2, wr, wc, fr, fq); }
    }
};
struct EpiResid {
    static constexpr bool PERM = true, AFTER_DRAIN = false;
    const float* x; const float* mod; bf16_t* out;
    __device__ __forceinline__ void operator()(const f32x4 (&acc)[2][2][4][2], const Unit& u, int wr, int wc, int fr, int fq) const {
        int row0 = u.pm * BM + wr * 64 + fr, col0 = u.pn * BM + wc * 32 + 8 * fq; const int b = (u.pm * BM) / SEQ;
        f32x4 gv[2][2];
#pragma unroll
        for (int bj = 0; bj < 2; ++bj)
#pragma unroll
            for (int n = 0; n < 2; ++n) gv[bj][n] = *(const f32x4*)(mod + (size_t)b * 6144 + 2 * D + col0 + bj * HALF + n * 4);
#pragma unroll
        for (int am = 0; am < 4; ++am) { const int ai = am >> 1, m0 = 2 * (am & 1);
            f32x4 xv[2][2][2];
#pragma unroll
            for (int mm = 0; mm < 2; ++mm) { const size_t off = (size_t)(row0 + ai * HALF + (m0 + mm) * 16) * D + col0;
#pragma unroll
                for (int bj = 0; bj < 2; ++bj) { xv[mm][bj][0] = __builtin_nontemporal_load((const f32x4*)(x + off + bj * HALF)); xv[mm][bj][1] = __builtin_nontemporal_load((const f32x4*)(x + off + bj * HALF + 4)); } }
            __builtin_amdgcn_sched_barrier(0);
#pragma unroll
            for (int mm = 0; mm < 2; ++mm) { const int m = m0 + mm; const size_t off = (size_t)(row0 + ai * HALF + m * 16) * D + col0;
#pragma unroll
                for (int bj = 0; bj < 2; ++bj) {
                    const f32x4 v0 = xv[mm][bj][0] + gv[bj][0] * acc[ai][bj][m][0], v1 = xv[mm][bj][1] + gv[bj][1] * acc[ai][bj][m][1];
                    u32x4 w; w.x = cvt_pk_bf16(v0[0], v0[1]); w.y = cvt_pk_bf16(v0[2], v0[3]); w.z = cvt_pk_bf16(v1[0], v1[1]); w.w = cvt_pk_bf16(v1[2], v1[3]);
                    *(u32x4*)(out + off + bj * HALF) = w; } }
        }
    }
};
}

#define LAS __attribute__((address_space(3)))
#define LDSW() asm volatile("s_waitcnt lgkmcnt(0)" ::: "memory")
#define PSEC_WORD ((__attribute__((address_space(3))) volatile unsigned long long*)(unsigned)(131072 + 8192 + 64 + 8 * 16))
#define PSEC_BEGIN(id) unsigned long long psec_t0_##id = 0; do { if (PROBE_SEC == (id) && blockIdx.x == 0 && threadIdx.x == 0) { __builtin_amdgcn_sched_barrier(0); psec_t0_##id = __builtin_amdgcn_s_memrealtime(); __builtin_amdgcn_sched_barrier(0); } } while (0)
#define PSEC_END(id) do { if (PROBE_SEC == (id) && blockIdx.x == 0 && threadIdx.x == 0) { __builtin_amdgcn_sched_barrier(0); *PSEC_WORD += __builtin_amdgcn_s_memrealtime() - psec_t0_##id; __builtin_amdgcn_sched_barrier(0); } } while (0)

typedef short bf16x8 __attribute__((ext_vector_type(8)));
typedef short s16x4 __attribute__((ext_vector_type(4)));
typedef float f32x16 __attribute__((ext_vector_type(16)));
__device__ __forceinline__ int crow(int r, int hi) { return (r & 3) + 8 * (r >> 2) + 4 * hi; }
typedef __bf16 bf16x2_t __attribute__((ext_vector_type(2)));
__device__ __forceinline__ unsigned cvtpk(float lo, float hi) { const f32x2 v = {lo, hi}; const bf16x2_t b = __builtin_convertvector(v, bf16x2_t); return __builtin_bit_cast(unsigned, b); }
__device__ __forceinline__ float bfe(const u32x4& w, int e) { const unsigned d = w[e >> 1]; return (e & 1) ? bfhi(d) : bflo(d); }
__device__ __forceinline__ bf16x8 as_frag(const u32x4& w) { return __builtin_bit_cast(bf16x8, w); }
__device__ __forceinline__ void rope_pair(const u32x4& c1, const u32x4& c2, float pos, const float (&inv)[8], float sc, u32x4& o1, u32x4& o2) {
    float a[8], b[8];
#pragma unroll
    for (int e = 0; e < 8; ++e) { float sn, cs; sincos_rad(pos * inv[e], sn, cs); const float x1 = bfe(c1, e), x2 = bfe(c2, e); a[e] = (x1 * cs - x2 * sn) * sc; b[e] = (x1 * sn + x2 * cs) * sc; }
    o1 = (u32x4){cvtpk(a[0], a[1]), cvtpk(a[2], a[3]), cvtpk(a[4], a[5]), cvtpk(a[6], a[7])};
    o2 = (u32x4){cvtpk(b[0], b[1]), cvtpk(b[2], b[3]), cvtpk(b[4], b[5]), cvtpk(b[6], b[7])};
}
template <int S2> __device__ __forceinline__ void rope_pair_h(const u32x4& c1, const u32x4& c2, float pos, int hi, float sc, u32x4& o1, u32x4& o2) {
    float a[8], b[8];
#pragma unroll
    for (int e = 0; e < 8; ++e) { const float inv = hi ? INV64[16 * S2 + 8 + e] : INV64[16 * S2 + e]; float sn, cs; sincos_rad(pos * inv, sn, cs); const float x1 = bfe(c1, e), x2 = bfe(c2, e); a[e] = (x1 * cs - x2 * sn) * sc; b[e] = (x1 * sn + x2 * cs) * sc; }
    o1 = (u32x4){cvtpk(a[0], a[1]), cvtpk(a[2], a[3]), cvtpk(a[4], a[5]), cvtpk(a[6], a[7])};
    o2 = (u32x4){cvtpk(b[0], b[1]), cvtpk(b[2], b[3]), cvtpk(b[4], b[5]), cvtpk(b[6], b[7])};
}
__device__ __forceinline__ void swap_halves(u32x2& a, u32x2& b) {
    const auto r0 = __builtin_amdgcn_permlane32_swap(a.x, b.x, false, false), r1 = __builtin_amdgcn_permlane32_swap(a.y, b.y, false, false);
    a = (u32x2){r0[0], r1[0]}; b = (u32x2){r0[1], r1[1]};
}
__device__ __forceinline__ void ret_kvc_item(const Params& P, int item, int lane) {
    const bf16_t* proj = (const bf16_t*)(P.ws + WS_PROJ); const bf16_t* projt = (const bf16_t*)(P.ws + WS_PROJT); float* kvc = (float*)(P.ws + WS_KVC) + (size_t)item * 4096;
    const int h = item & 7, n = (item >> 3) & 63, b = item >> 9;
    const size_t t0 = (size_t)b * SEQ + n * 128;
    const float gamma = 1.0f - exp2f(-5.0f - (float)h), lg = log2f(gamma);
    const int r32 = lane & 31, hi = lane >> 5, f = r32;
    bf16x8 idb[2];
#pragma unroll
    for (int sp = 0; sp < 2; ++sp) { u32x4 w = {0u, 0u, 0u, 0u};
        if ((r32 >> 4) == sp && ((r32 >> 3) & 1) == hi) { const unsigned one = (r32 & 1) ? 0x3f800000u : 0x00003f80u; const int q = (r32 & 7) >> 1; w.x = q == 0 ? one : 0u; w.y = q == 1 ? one : 0u; w.z = q == 2 ? one : 0u; w.w = q == 3 ? one : 0u; }
        idb[sp] = as_frag(w); }
    const unsigned rowoff = (unsigned)(r32 * PLD + 8 * hi) * 2u, voff = (unsigned)(r32 * T + 8 * hi) * 2u, poff = (unsigned)r32 * 4u;
    const char* kbase = (const char*)(proj + t0 * PLD + PC_RK + h * 64); const char* pbase = (const char*)(P.positions + t0); const char* vbase = (const char*)(projt + (size_t)(PT_RV + h * 64) * T + t0);
#define RA_ROW(jb_, c_) (*(const u32x4*)(kbase + (size_t)(jb_) * (32 * PLD * 2) + (c_) * 32 + rowoff))
#define RA_POS(jb_) ((float)*(const int*)(pbase + (size_t)(jb_) * 128 + poff))
#define RA_LOADV(jb_) do { _Pragma("unroll") for (int blk_ = 0; blk_ < 2; ++blk_) _Pragma("unroll") for (int sp_ = 0; sp_ < 2; ++sp_) { const char* vp_ = vbase + (size_t)(32 * blk_) * T * 2 + (32 * (jb_) + 16 * sp_) * 2 + voff; \
        const u32x4 w_ = *(const u32x4*)vp_; vlo[(jb_) & 1][blk_][sp_] = (u32x2){w_.x, w_.y}; vhh[(jb_) & 1][blk_][sp_] = (u32x2){w_.z, w_.w}; } } while (0)
    u32x4 kn[2][4]; float kpos[2]; u32x2 vlo[2][2][2], vhh[2][2][2];
    kn[0][0] = RA_ROW(0, 0); kn[0][1] = RA_ROW(0, 1); kn[0][2] = RA_ROW(0, 2); kn[0][3] = RA_ROW(0, 3); kpos[0] = RA_POS(0); RA_LOADV(0);
    f32x16 acc[2][2];
#pragma unroll
    for (int i = 0; i < 2; ++i)
#pragma unroll
        for (int j = 0; j < 2; ++j)
#pragma unroll
            for (int r = 0; r < 16; ++r) acc[i][j][r] = 0.f;
#pragma unroll
    for (int jb = 0; jb < 4; ++jb) {
        __builtin_amdgcn_sched_barrier(0);
        if (jb < 3) { kn[(jb + 1) & 1][0] = RA_ROW(jb + 1, 0); kn[(jb + 1) & 1][1] = RA_ROW(jb + 1, 1); kn[(jb + 1) & 1][2] = RA_ROW(jb + 1, 2); kn[(jb + 1) & 1][3] = RA_ROW(jb + 1, 3); kpos[(jb + 1) & 1] = RA_POS(jb + 1);
            if (jb == 0) RA_LOADV(1); else if (jb == 1) RA_LOADV(2); else RA_LOADV(3); }
        __builtin_amdgcn_sched_barrier(0);
        const float scj = 0.125f * __builtin_amdgcn_exp2f(-(float)(32 * jb + r32) * lg);
        u32x4 o[4]; rope_pair_h<0>(kn[jb & 1][0], kn[jb & 1][2], kpos[jb & 1], hi, scj, o[0], o[2]); rope_pair_h<1>(kn[jb & 1][1], kn[jb & 1][3], kpos[jb & 1], hi, scj, o[1], o[3]);
#pragma unroll
        for (int blk = 0; blk < 2; ++blk)
#pragma unroll
            for (int sp = 0; sp < 2; ++sp) swap_halves(vlo[jb & 1][blk][sp], vhh[jb & 1][blk][sp]);
#pragma unroll
        for (int c = 0; c < 2; ++c) {
            f32x16 kc;
#pragma unroll
            for (int r = 0; r < 16; ++r) kc[r] = 0.f;
            kc = __builtin_amdgcn_mfma_f32_32x32x16_bf16(as_frag(o[2 * c]), idb[0], kc, 0, 0, 0);
            kc = __builtin_amdgcn_mfma_f32_32x32x16_bf16(as_frag(o[2 * c + 1]), idb[1], kc, 0, 0, 0);
#pragma unroll
            for (int sp = 0; sp < 2; ++sp) {
                const bf16x8 pb = as_frag((u32x4){cvtpk(kc[8 * sp], kc[8 * sp + 1]), cvtpk(kc[8 * sp + 2], kc[8 * sp + 3]), cvtpk(kc[8 * sp + 4], kc[8 * sp + 5]), cvtpk(kc[8 * sp + 6], kc[8 * sp + 7])});
#pragma unroll
                for (int blk = 0; blk < 2; ++blk)
                    acc[blk][c] = __builtin_amdgcn_mfma_f32_32x32x16_bf16(pb, as_frag((u32x4){vlo[jb & 1][blk][sp].x, vlo[jb & 1][blk][sp].y, vhh[jb & 1][blk][sp].x, vhh[jb & 1][blk][sp].y}), acc[blk][c], 0, 0, 0);
            }
        }
    }
#undef RA_ROW
#undef RA_POS
#undef RA_LOADV
    const float g127 = __builtin_amdgcn_exp2f(127.0f * lg);
#pragma unroll
    for (int blk = 0; blk < 2; ++blk)
#pragma unroll
        for (int c = 0; c < 2; ++c)
#pragma unroll
            for (int g = 0; g < 4; ++g) *(f32x4*)(kvc + (32 * blk + f) * 64 + 32 * c + 8 * g + 4 * hi) = (f32x4){acc[blk][c][4 * g], acc[blk][c][4 * g + 1], acc[blk][c][4 * g + 2], acc[blk][c][4 * g + 3]} * g127;
}
__device__ __forceinline__ void ret_scan(const Params& P, size_t gt, size_t nt) {
    const float* kvc = (const float*)(P.ws + WS_KVC); bf16_t* prevb = (bf16_t*)(P.ws + WS_PREVB);
    for (size_t i = gt; i < (size_t)NB * NH * 4096; i += nt) {
        const int e = (int)(i & 4095), h = (int)((i >> 12) & 7), b = (int)(i >> 15);
        const float gamma = 1.0f - exp2f(-5.0f - (float)h), decay = exp2f(128.0f * log2f(gamma));
        float st = 0.f, vv[64];
#pragma unroll
        for (int n = 0; n < 64; ++n) vv[n] = kvc[((size_t)((b * 64 + n) * 8 + h)) * 4096 + e];
#pragma unroll
        for (int n = 0; n < 64; ++n) { const size_t o = ((size_t)((b * 64 + n) * 8 + h)) * 4096 + e; prevb[o] = (bf16_t)f2bf(st * gamma); st = st * decay + vv[n]; }
    }
}
__device__ __forceinline__ void ret_out_item(const Params& P, int item, int lane, LAS u32x4* wl, const LAS unsigned char* grl) {
    asm volatile("" : "+v"(lane));
    const bf16_t* proj = (const bf16_t*)(P.ws + WS_PROJ); const bf16_t* projt = (const bf16_t*)(P.ws + WS_PROJT); const bf16_t* prevb = (const bf16_t*)(P.ws + WS_PREVB) + (size_t)item * 4096;
    bf16_t* Y = (bf16_t*)(P.ws + WS_XN);
    const int h = item & 7, n = (item >> 3) & 63, b = item >> 9;
    const size_t t0 = (size_t)b * SEQ + n * 128;
    const float gamma = 1.0f - exp2f(-5.0f - (float)h), lg = log2f(gamma);
    const int r32 = lane & 31, hi = lane >> 5;
    const unsigned rowoff = (unsigned)(r32 * PLD + 8 * hi) * 2u, gateoff = (unsigned)(r32 * PLD + 8 * hi) * 2u, voff = (unsigned)(r32 * T + 8 * hi) * 2u, poff = (unsigned)r32 * 4u;
    const unsigned pfoff = (unsigned)(r32 * 64 + 8 * hi) * 2u, yoff = (unsigned)(r32 * D + 8 * hi) * 2u;
    const char* kbase = (const char*)(proj + t0 * PLD + PC_RK + h * 64); const char* qbase = (const char*)(proj + t0 * PLD + PC_RQ + h * 64); const char* gbase = (const char*)(proj + t0 * PLD + PC_RG + h * 64);
    const char* pbase = (const char*)(P.positions + t0); const char* vbase = (const char*)(projt + (size_t)(PT_RV + h * 64) * T + t0); const char* fbase = (const char*)prevb; char* ybase = (char*)(Y + t0 * D + 512 + h * 64);
#define RC_ROW(base_, jb_, c_) (*(const u32x4*)((base_) + (size_t)(jb_) * (32 * PLD * 2) + (c_) * 32 + rowoff))
#define RC_POS(jb_) ((float)*(const int*)(pbase + (size_t)(jb_) * 128 + poff))
    u32x4 kn0 = RC_ROW(kbase, 0, 0), kn1 = RC_ROW(kbase, 0, 1), kn2 = RC_ROW(kbase, 0, 2), kn3 = RC_ROW(kbase, 0, 3); float kposn = RC_POS(0);
    u32x4 qn0 = RC_ROW(qbase, 0, 0), qn1 = RC_ROW(qbase, 0, 1), qn2 = RC_ROW(qbase, 0, 2), qn3 = RC_ROW(qbase, 0, 3); float qposn = kposn;
    u32x2 vlo[4][2][2], vhh[4][2][2];
#define RC_LOADV(jb_) do { _Pragma("unroll") for (int blk_ = 0; blk_ < 2; ++blk_) _Pragma("unroll") for (int sp_ = 0; sp_ < 2; ++sp_) { const char* vp_ = vbase + (size_t)(32 * blk_) * T * 2 + (32 * (jb_) + 16 * sp_) * 2 + voff; \
        const u32x4 w_ = *(const u32x4*)vp_; vlo[jb_][blk_][sp_] = (u32x2){w_.x, w_.y}; vhh[jb_][blk_][sp_] = (u32x2){w_.z, w_.w}; } } while (0)
    RC_LOADV(0);
#pragma unroll 1
    for (int jb = 0; jb < 4; ++jb) {
        const u32x4 c0 = kn0, c1 = kn1, c2 = kn2, c3 = kn3; const float pos = kposn; const float scj = 0.125f * __builtin_amdgcn_exp2f(-(float)(32 * jb + r32) * lg);
        { const int jn = jb < 3 ? jb + 1 : 3; kn0 = RC_ROW(kbase, jn, 0); kn1 = RC_ROW(kbase, jn, 1); kn2 = RC_ROW(kbase, jn, 2); kn3 = RC_ROW(kbase, jn, 3); kposn = RC_POS(jn); }
        __builtin_amdgcn_sched_barrier(0);
        u32x4 o0, o1, o2, o3; rope_pair_h<0>(c0, c2, pos, hi, scj, o0, o2); rope_pair_h<1>(c1, c3, pos, hi, scj, o1, o3);
        wl[(jb * 4 + 0) * 64 + lane] = o0; wl[(jb * 4 + 1) * 64 + lane] = o1; wl[(jb * 4 + 2) * 64 + lane] = o2; wl[(jb * 4 + 3) * 64 + lane] = o3;
    }
#pragma unroll
    for (int ib = 0; ib < 4; ++ib) {
        __builtin_amdgcn_sched_barrier(0);
        const float sci = __builtin_amdgcn_exp2f((float)(32 * ib + r32) * lg);
        const u32x4 c0 = qn0, c1 = qn1, c2 = qn2, c3 = qn3; const float pos = qposn;
        { const int in = ib < 3 ? ib + 1 : 3; qn0 = RC_ROW(qbase, in, 0); qn1 = RC_ROW(qbase, in, 1); qn2 = RC_ROW(qbase, in, 2); qn3 = RC_ROW(qbase, in, 3); qposn = RC_POS(in); }
        if (ib == 0) RC_LOADV(1); else if (ib == 1) RC_LOADV(2); else if (ib == 2) RC_LOADV(3);
        __builtin_amdgcn_sched_barrier(0);
        bf16x8 qf[4];
        { u32x4 o0, o1, o2, o3; rope_pair_h<0>(c0, c2, pos, hi, sci, o0, o2); rope_pair_h<1>(c1, c3, pos, hi, sci, o1, o3);
          qf[0] = as_frag(o0); qf[1] = as_frag(o1); qf[2] = as_frag(o2); qf[3] = as_frag(o3); }
        __builtin_amdgcn_sched_barrier(0);
        bf16x8 pf[2][4];
#pragma unroll
        for (int blk = 0; blk < 2; ++blk)
#pragma unroll
            for (int s = 0; s < 4; ++s) pf[blk][s] = *(const bf16x8*)(fbase + (size_t)(32 * blk * 64 + 16 * s) * 2 + pfoff);
        u32x2 gt2[2][4];
#pragma unroll
        for (int blk = 0; blk < 2; ++blk)
#pragma unroll
            for (int ga = 0; ga < 2; ++ga) { const u32x4 w = *(const u32x4*)(gbase + (size_t)ib * (32 * PLD * 2) + (32 * blk + 16 * ga) * 2 + gateoff); gt2[blk][2 * ga] = (u32x2){w.x, w.y}; gt2[blk][2 * ga + 1] = (u32x2){w.z, w.w}; }
        __builtin_amdgcn_sched_barrier(0);
        if (ib == 0) { _Pragma("unroll") for (int blk = 0; blk < 2; ++blk) _Pragma("unroll") for (int sp = 0; sp < 2; ++sp) swap_halves(vlo[0][blk][sp], vhh[0][blk][sp]); }
        else if (ib == 1) { _Pragma("unroll") for (int blk = 0; blk < 2; ++blk) _Pragma("unroll") for (int sp = 0; sp < 2; ++sp) swap_halves(vlo[1][blk][sp], vhh[1][blk][sp]); }
        else if (ib == 2) { _Pragma("unroll") for (int blk = 0; blk < 2; ++blk) _Pragma("unroll") for (int sp = 0; sp < 2; ++sp) swap_halves(vlo[2][blk][sp], vhh[2][blk][sp]); }
        else { _Pragma("unroll") for (int blk = 0; blk < 2; ++blk) _Pragma("unroll") for (int sp = 0; sp < 2; ++sp) swap_halves(vlo[3][blk][sp], vhh[3][blk][sp]); }
        f32x16 y[2];
#pragma unroll
        for (int blk = 0; blk < 2; ++blk)
#pragma unroll
            for (int r = 0; r < 16; ++r) y[blk][r] = 0.f;
#pragma unroll
        for (int jb = 0; jb < 4; ++jb) if (jb <= ib) {
            f32x16 st;
#pragma unroll
            for (int r = 0; r < 16; ++r) st[r] = 0.f;
#pragma unroll
            for (int s = 0; s < 4; ++s) { const u32x4 kf = wl[(jb * 4 + s) * 64 + lane]; st = __builtin_amdgcn_mfma_f32_32x32x16_bf16(as_frag(kf), qf[s], st, 0, 0, 0); }
            if (jb == ib) {
#pragma unroll
                for (int r = 0; r < 16; ++r) if (crow(r, hi) > r32) st[r] = 0.f;
            }
#pragma unroll
            for (int sp = 0; sp < 2; ++sp) {
                const bf16x8 pb = as_frag((u32x4){cvtpk(st[8 * sp], st[8 * sp + 1]), cvtpk(st[8 * sp + 2], st[8 * sp + 3]), cvtpk(st[8 * sp + 4], st[8 * sp + 5]), cvtpk(st[8 * sp + 6], st[8 * sp + 7])});
#pragma unroll
                for (int blk = 0; blk < 2; ++blk)
                    y[blk] = __builtin_amdgcn_mfma_f32_32x32x16_bf16(as_frag((u32x4){vlo[jb][blk][sp].x, vlo[jb][blk][sp].y, vhh[jb][blk][sp].x, vhh[jb][blk][sp].y}), pb, y[blk], 0, 0, 0);
            }
        }
#pragma unroll
        for (int blk = 0; blk < 2; ++blk)
#pragma unroll
            for (int s = 0; s < 4; ++s) y[blk] = __builtin_amdgcn_mfma_f32_32x32x16_bf16(pf[blk][s], qf[s], y[blk], 0, 0, 0);
        float sum = 0.f;
#pragma unroll
        for (int blk = 0; blk < 2; ++blk)
#pragma unroll
            for (int r = 0; r < 16; ++r) sum += y[blk][r];
        sum += __shfl_xor(sum, 32); const float mu = sum * (1.f / 64.f);
        float var = 0.f;
#pragma unroll
        for (int blk = 0; blk < 2; ++blk)
#pragma unroll
            for (int r = 0; r < 16; ++r) { const float d = y[blk][r] - mu; var += d * d; }
        var += __shfl_xor(var, 32); const float rstd = __builtin_amdgcn_rsqf(var * (1.f / 64.f) + EPS);
#pragma unroll
        for (int blk = 0; blk < 2; ++blk)
#pragma unroll
            for (int ga = 0; ga < 2; ++ga) {
                swap_halves(gt2[blk][2 * ga], gt2[blk][2 * ga + 1]);
                u32x2 ov[2];
#pragma unroll
                for (int gg = 0; gg < 2; ++gg) { const int g4 = 2 * ga + gg;
                    const u32x2 g2 = gt2[blk][g4]; const f32x4 gr = *(const LAS f32x4*)(grl + (h * 64 + 32 * blk + 8 * g4 + 4 * hi) * 4);
                    const float o0 = silu_fast(bflo(g2.x)) * (y[blk][4 * g4] - mu) * rstd * gr.x, o1 = silu_fast(bfhi(g2.x)) * (y[blk][4 * g4 + 1] - mu) * rstd * gr.y;
                    const float o2 = silu_fast(bflo(g2.y)) * (y[blk][4 * g4 + 2] - mu) * rstd * gr.z, o3 = silu_fast(bfhi(g2.y)) * (y[blk][4 * g4 + 3] - mu) * rstd * gr.w;
                    ov[gg] = (u32x2){cvtpk(o0, o1), cvtpk(o2, o3)}; }
                swap_halves(ov[0], ov[1]);
                *(u32x4*)(ybase + (size_t)ib * (32 * D * 2) + (32 * blk + 16 * ga) * 2 + yoff) = (u32x4){ov[0].x, ov[0].y, ov[1].x, ov[1].y}; }
    }
#undef RC_LOADV
#undef RC_ROW
#undef RC_POS
}
constexpr int AT_KSTR = 104, AT_VROW = 192;
constexpr int AT_KBYTES = 64 * AT_KSTR * 2, AT_VBYTES = 64 * AT_VROW, AT_BUF = AT_KBYTES + AT_VBYTES;
__device__ __forceinline__ void attn_unit(const Params& P, int b, int h, int qb, LAS unsigned char* lds, int tid) {
    const bf16_t* Q = (const bf16_t*)(P.ws + WS_Q); const bf16_t* KN = (const bf16_t*)(P.ws + WS_KN); const bf16_t* KR = (const bf16_t*)(P.ws + WS_KR);
    const bf16_t* VT = (const bf16_t*)(P.ws + WS_VT); bf16_t* Y = (bf16_t*)(P.ws + WS_XN);
    const int lane = tid & 63, wave = __builtin_amdgcn_readfirstlane(tid >> 6), r32 = lane & 31, hi = lane >> 5;
    const int qfirst = qb * 256 + wave * 32, qrow = qfirst + r32; const size_t tq = (size_t)b * SEQ + qrow;
    const int ntiles = 4 * qb + 4;
    const int kr = tid >> 3, kc = tid & 7, rr = tid >> 2, rc = tid & 3;
    const bf16_t* ksrc = KN + ((size_t)b * SEQ + kr) * 512 + h * 64 + kc * 8;
    const bf16_t* rsrc = KR + ((size_t)b * SEQ + rr) * 32 + rc * 8;
    const bf16_t* vsrc = VT + ((size_t)b * SEQ + kr) * 512 + h * 64 + kc * 8;
    const int kdst = (kr * AT_KSTR + kc * 8) * 2, rdst = (rr * AT_KSTR + 64 + rc * 8) * 2, vdst = AT_KBYTES + kr * AT_VROW + kc * 16;
    const int vrd0 = (4 * (lane >> 5) + ((lane >> 2) & 3)) * AT_VROW + (16 * ((lane >> 4) & 1) + 4 * (lane & 3)) * 2;
    u32x4 sk, sr, sv;
    sk = *(const u32x4*)ksrc; if (tid < 256) sr = *(const u32x4*)rsrc; sv = *(const u32x4*)vsrc;
    __builtin_amdgcn_sched_barrier(0);
    bf16x8 qf[6];
    { const bf16_t* qp = Q + tq * 768 + h * 96 + 8 * hi;
#pragma unroll
      for (int s = 0; s < 4; ++s) qf[s] = *(const bf16x8*)(qp + 16 * s);
      const u32x4 c4 = *(const u32x4*)(qp + 64), c5 = *(const u32x4*)(qp + 80);
      float inv[8];
#pragma unroll
      for (int e = 0; e < 8; ++e) inv[e] = INV64[2 * (8 * hi + e)];
      u32x4 o4, o5; rope_pair(c4, c5, (float)P.positions[tq], inv, 1.0f, o4, o5); qf[4] = as_frag(o4); qf[5] = as_frag(o5); }
    f32x16 o[2];
#pragma unroll
    for (int r = 0; r < 16; ++r) { o[0][r] = 0.f; o[1][r] = 0.f; }
    float l_part = 0.f;
    f32x16 negm;
#pragma unroll
    for (int r = 0; r < 16; ++r) negm[r] = 0.f;
    *(LAS u32x4*)(lds + kdst) = sk; if (tid < 256) *(LAS u32x4*)(lds + rdst) = sr;
    *(LAS u32x4*)(lds + vdst) = sv;
    __syncthreads();
    for (int t = 0; t < ntiles; ++t) {
        const bool more = (t + 1 < ntiles);
        if (more) { sk = *(const u32x4*)(ksrc + (size_t)(t + 1) * 64 * 512); if (tid < 256) sr = *(const u32x4*)(rsrc + (size_t)(t + 1) * 64 * 32); sv = *(const u32x4*)(vsrc + (size_t)(t + 1) * 64 * 512); }
        if (64 * t <= qfirst + 31) {
            LAS unsigned char* Kb = lds + (t & 1) * AT_BUF; LAS unsigned char* Vb = Kb + AT_KBYTES;
            f32x16 st[2];
#define AT_QK() do { _Pragma("unroll") for (int blk = 0; blk < 2; ++blk) { bf16x8 kf_[6];        \
                    _Pragma("unroll") for (int s = 0; s < 6; ++s) kf_[s] = *(const LAS bf16x8*)(Kb + ((32 * blk + r32) * AT_KSTR + 16 * s + 8 * hi) * 2); \
                    _Pragma("unroll") for (int s = 0; s < 6; ++s) st[blk] = __builtin_amdgcn_mfma_f32_32x32x16_bf16(kf_[s], qf[s], s == 0 ? negm : st[blk], 0, 0, 0); } \
                if (64 * t + 63 > qfirst) { _Pragma("unroll") for (int blk = 0; blk < 2; ++blk) _Pragma("unroll") for (int r = 0; r < 16; ++r) if (64 * t + 32 * blk + crow(r, hi) > qrow) st[blk][r] = -INFINITY; } } while (0)
            AT_QK();
            float ps = 0.f;
#pragma unroll
            for (int blk = 0; blk < 2; ++blk)
#pragma unroll
                for (int r = 0; r < 16; ++r) { const float p = __builtin_amdgcn_exp2f(st[blk][r]); st[blk][r] = p; ps += p; }
            if (t == 0 || __any(!(ps <= 4096.0f))) {
                AT_QK();
                float mx = fmaxf(st[0][0], st[1][0]);
#pragma unroll
                for (int r = 1; r < 16; ++r) mx = fmaxf(mx, fmaxf(st[0][r], st[1][r]));
                mx = fmaxf(mx, __shfl_xor(mx, 32));
                const float dl = (t == 0) ? mx : fmaxf(mx, 0.f), f = (t == 0) ? 1.f : __builtin_amdgcn_exp2f(-dl); l_part *= f; const float nm = negm[0] - dl;
#pragma unroll
                for (int r = 0; r < 16; ++r) { o[0][r] *= f; o[1][r] *= f; st[0][r] -= dl; st[1][r] -= dl; negm[r] = nm; }
                ps = 0.f;
#pragma unroll
                for (int blk = 0; blk < 2; ++blk)
#pragma unroll
                    for (int r = 0; r < 16; ++r) { const float p = __builtin_amdgcn_exp2f(st[blk][r]); st[blk][r] = p; ps += p; }
            }
#undef AT_QK
            l_part += ps;
#pragma unroll
            for (int jb = 0; jb < 2; ++jb)
#pragma unroll
                for (int sp = 0; sp < 2; ++sp) {
                    const bf16x8 pb = as_frag((u32x4){cvtpk(st[jb][8 * sp], st[jb][8 * sp + 1]), cvtpk(st[jb][8 * sp + 2], st[jb][8 * sp + 3]), cvtpk(st[jb][8 * sp + 4], st[jb][8 * sp + 5]), cvtpk(st[jb][8 * sp + 6], st[jb][8 * sp + 7])});
#pragma unroll
                    for (int dblk = 0; dblk < 2; ++dblk) {
                        const LAS unsigned char* vp = Vb + vrd0 + (32 * jb + 16 * sp) * AT_VROW + 64 * dblk;
                        const s16x4 lo = __builtin_amdgcn_ds_read_tr16_b64_v4i16((LAS s16x4*)vp), hh = __builtin_amdgcn_ds_read_tr16_b64_v4i16((LAS s16x4*)(vp + 8 * AT_VROW));
                        o[dblk] = __builtin_amdgcn_mfma_f32_32x32x16_bf16((bf16x8){lo.x, lo.y, lo.z, lo.w, hh.x, hh.y, hh.z, hh.w}, pb, o[dblk], 0, 0, 0); }
                }
        }
        if (more) { LAS unsigned char* nb = lds + ((t + 1) & 1) * AT_BUF;
            *(LAS u32x4*)(nb + kdst) = sk; if (tid < 256) *(LAS u32x4*)(nb + rdst) = sr;
            *(LAS u32x4*)(nb + vdst) = sv; }
        __syncthreads();
    }
    const float l = l_part + __shfl_xor(l_part, 32), il = 1.0f / l;
#pragma unroll
    for (int dblk = 0; dblk < 2; ++dblk)
#pragma unroll
        for (int g4 = 0; g4 < 4; ++g4) { const int dv0 = 32 * dblk + 8 * g4 + 4 * hi;
            *(u32x2*)(Y + tq * D + h * 64 + dv0) = (u32x2){cvtpk(o[dblk][4 * g4] * il, o[dblk][4 * g4 + 1] * il), cvtpk(o[dblk][4 * g4 + 2] * il, o[dblk][4 * g4 + 3] * il)}; }
}
__device__ __forceinline__ void attn_phase(const Params& P, LAS unsigned char* lds, int tid) {
    const int G = gridDim.x, bx = blockIdx.x;
    if (G == 256) { const int vcu = (bx & 7) * 32 + (bx >> 3), bh = vcu >> 3, s = vcu & 7;
#pragma unroll 1
        for (int i = 0; i < 4; ++i) { const int qb = (i == 0) ? s : (i == 1) ? 15 - s : (i == 2) ? 16 + s : 31 - s; attn_unit(P, bh >> 3, bh & 7, qb, lds, tid); }
    } else {
#pragma unroll 1
        for (int u = bx; u < 1024; u += G) attn_unit(P, u >> 8, (u >> 5) & 7, 31 - (u & 31), lds, tid);
    }
}
struct UE { u32x4 e0, e1; };
struct UB { u32x4 b0, b1; int t; };
__device__ __forceinline__ unsigned u_load_raw(const Params& P, int t, int half, int lane) { return ((const unsigned*)(P.ws + WS_EIDX))[(size_t)t * 128 + 64 * half + lane]; }
__device__ __forceinline__ void u_expand(int lane, unsigned r, UE& E) {
    const int gl = lane >> 3, base = (16 * (gl >> 2) + (gl & 3)) * 4;
#pragma unroll
    for (int i = 0; i < 4; ++i) { E.e0[i] = (unsigned)__builtin_amdgcn_ds_bpermute(base + (32 * (i & 1) + 4 * (i >> 1)) * 4, (int)r); E.e1[i] = (unsigned)__builtin_amdgcn_ds_bpermute(base + (32 * (i & 1) + 4 * ((i + 4) >> 1)) * 4, (int)r); }
}
__device__ __forceinline__ void u_load_b(const Params& P, int t, int x, int lane, UB& I) {
    const int c = lane & 15, g = lane >> 4;
    I.b0 = (u32x4){0u, 0u, 0u, 0u}; I.b1 = I.b0; I.t = t;
    if (c < 2) { const unsigned char* hp = P.ws + WS_H2Q + (size_t)t * 2048 + c * 1024 + x * 128 + 32 * g; I.b0 = *(const u32x4*)hp; I.b1 = *(const u32x4*)(hp + 16); }
}
constexpr int TQ_NS = 96, TQ_C = 8;
#define TQ_CTR(ph, x) (8192 + 64 * (8 * (ph) + (x)))
struct TokQ { int p, j, stride, td, base, left; bool done; unsigned nbv; unsigned* ctr; };
__device__ __forceinline__ void tq_init(TokQ& q, unsigned* ctr, int vw, int nw) { q.p = 0; q.j = vw >> 3; q.stride = nw >> 3; q.td = T - TQ_NS * (nw >> 3); q.base = 0; q.left = 0; q.done = false; q.nbv = 0u; q.ctr = ctr; }
__device__ __forceinline__ int tq_next(TokQ& q, int lane) {
    const int remaining = q.p < TQ_NS ? TQ_NS - q.p : q.left;
    if (remaining == 3 && !q.done) { unsigned b = 0u; if (lane == 0) b = __hip_atomic_fetch_add(q.ctr, (unsigned)TQ_C, __ATOMIC_RELAXED, __HIP_MEMORY_SCOPE_AGENT); q.nbv = b; }
    if (q.p < TQ_NS) { const int t = q.j + q.p * q.stride; ++q.p; return t; }
    if (q.left == 0) { if (q.done) return -1; q.base = __builtin_amdgcn_readfirstlane((int)q.nbv); q.left = TQ_C; if (q.base >= q.td) { q.done = true; q.left = 0; return -1; } }
    const int t = TQ_NS * q.stride + q.base + (TQ_C - q.left); --q.left; return t;
}
#define TQ_TC(t) ((t) < 0 ? 0 : (t))
struct URing { u32x4 rv[8]; };
template <bool WRITE> __device__ __forceinline__ void u_step(const unsigned char* eu8, int lane, URing& R, const UE& En, LAS unsigned char* img) {
    const unsigned r8 = (unsigned)lane >> 3, p = (unsigned)lane & 7u;
#pragma unroll
    for (int i = 0; i < 8; ++i) { const unsigned e = (i < 4) ? En.e0[i] : En.e1[i - 4]; const unsigned swz = 4u * (unsigned)(i & 1) + (r8 >> 1);
        if (WRITE) *(LAS u32x4*)(img + 1024 * i + lane * 16) = R.rv[i];
        R.rv[i] = *(const u32x4*)(eu8 + (e * 128u + 16u * (p ^ swz)));
        __builtin_amdgcn_sched_barrier(0); }
}
__device__ __forceinline__ float quad_swap1(float v) { return __builtin_bit_cast(float, __builtin_amdgcn_update_dpp(0, __builtin_bit_cast(int, v), 0xB1, 0xf, 0xf, true)); }
__device__ __forceinline__ long mk64(unsigned lo, unsigned hi) { return (long)(((unsigned long long)hi << 32) | lo); }
__device__ __forceinline__ void u_compute(const Params& P, int x, int half, int lane, const UB& I, const LAS unsigned char* const (&ra)[4]) {
    unsigned short* ap = (unsigned short*)(P.ws + WS_APART) + ((size_t)x * T + I.t) * 128 + 64 * half; const int c = lane & 15, g = lane >> 4;
    const long B0 = mk64(I.b0.x, I.b0.y), B1 = mk64(I.b0.z, I.b0.w), B2 = mk64(I.b1.x, I.b1.y), B3 = mk64(I.b1.z, I.b1.w);
    f32x4 acc[4];
#pragma unroll
    for (int rb = 0; rb < 4; ++rb) {
        const long A0 = *(const LAS long*)(ra[0] + rb * 2048), A1 = *(const LAS long*)(ra[1] + rb * 2048), A2 = *(const LAS long*)(ra[2] + rb * 2048), A3 = *(const LAS long*)(ra[3] + rb * 2048);
        f32x4 a = {0.f, 0.f, 0.f, 0.f};
        a = __builtin_amdgcn_mfma_f32_16x16x32_fp8_fp8(A0, B0, a, 0, 0, 0);
        a = __builtin_amdgcn_mfma_f32_16x16x32_fp8_fp8(A1, B1, a, 0, 0, 0);
        a = __builtin_amdgcn_mfma_f32_16x16x32_fp8_fp8(A2, B2, a, 0, 0, 0);
        a = __builtin_amdgcn_mfma_f32_16x16x32_fp8_fp8(A3, B3, a, 0, 0, 0);
        acc[rb] = a;
    }
    float lo[4][4];
#pragma unroll
    for (int rb = 0; rb < 4; ++rb) { lo[rb][0] = quad_swap1(acc[rb].x); lo[rb][1] = quad_swap1(acc[rb].y); lo[rb][2] = quad_swap1(acc[rb].z); lo[rb][3] = quad_swap1(acc[rb].w); }
    if (c == 0) {
        unsigned w[8];
#pragma unroll
        for (int rb = 0; rb < 4; ++rb) {
            const h2_t p0 = {(_Float16)((acc[rb].x + lo[rb][0] * 0.0625f) * 0.0625f), (_Float16)((acc[rb].y + lo[rb][1] * 0.0625f) * 0.0625f)}, p1 = {(_Float16)((acc[rb].z + lo[rb][2] * 0.0625f) * 0.0625f), (_Float16)((acc[rb].w + lo[rb][3] * 0.0625f) * 0.0625f)};
            w[2 * rb] = __builtin_bit_cast(unsigned, p0); w[2 * rb + 1] = __builtin_bit_cast(unsigned, p1); }
        *(u32x4*)(ap + 16 * g) = (u32x4){w[0], w[1], w[2], w[3]}; *(u32x4*)(ap + 16 * g + 8) = (u32x4){w[4], w[5], w[6], w[7]};
    }
}
__device__ __forceinline__ void peer_u_phase(const Params& P, int vw, int nw, int lane, LAS unsigned char* wl) {
    const int x = vw & 7;
    const unsigned char* eu8 = P.ws + WS_EU8 + (size_t)x * NEXP * 128;
    TokQ q; tq_init(q, (unsigned*)(P.ws + WS_CTL) + TQ_CTR(0, x), vw, nw);
    int t0 = tq_next(q, lane), t1 = tq_next(q, lane);
    const LAS unsigned char* ra[4];
    { const unsigned c = (unsigned)lane & 15u, g = (unsigned)lane >> 4, swz = (c >> 1) & 7u, hf0 = g & 1u; const LAS unsigned char* rowp = wl + c * 128;
      ra[0] = rowp + (((2u * g) ^ swz) * 16u + hf0 * 8u); ra[1] = rowp + (((2u * g) ^ swz) * 16u + (hf0 ^ 1u) * 8u); ra[2] = rowp + (((2u * g + 1u) ^ swz) * 16u + hf0 * 8u); ra[3] = rowp + (((2u * g + 1u) ^ swz) * 16u + (hf0 ^ 1u) * 8u); }
    UE E0, E1; UB B0, B1; URing R; unsigned r0, r1;
    r0 = u_load_raw(P, t0, 0, lane); r1 = u_load_raw(P, t0, 1, lane); u_load_b(P, t0, x, lane, B0);
    u_expand(lane, r0, E0); u_expand(lane, r1, E1);
    r0 = u_load_raw(P, TQ_TC(t1), 0, lane); r1 = u_load_raw(P, TQ_TC(t1), 1, lane);
    u_step<false>(eu8, lane, R, E0, wl);
    while (t0 >= 0) {
        const int t2 = tq_next(q, lane);
        u_load_b(P, t0, x, lane, B1);
        u_expand(lane, r0, E0); r0 = u_load_raw(P, TQ_TC(t2), 0, lane);
        u_step<true>(eu8, lane, R, E1, wl);
        u_compute(P, x, 0, lane, B0, ra);
        u_load_b(P, TQ_TC(t1), x, lane, B0);
        u_expand(lane, r1, E1); r1 = u_load_raw(P, TQ_TC(t2), 1, lane);
        u_step<true>(eu8, lane, R, E0, wl);
        u_compute(P, x, 1, lane, B1, ra);
        t0 = t1; t1 = t2;
    }
}
__device__ __forceinline__ void peer_w_phase(const Params& P, size_t gt, size_t nt) {
    unsigned* eidx = (unsigned*)(P.ws + WS_EIDX); unsigned* gate = (unsigned*)(P.ws + WS_GATE); const unsigned short* ap = (const unsigned short*)(P.ws + WS_APART);
    const float* sui = (const float*)(P.ws + WS_SUI); const float* svi = (const float*)(P.ws + WS_SVI);
    const size_t N = (size_t)T * 32;
    u32x2 wa[8], wb[8]; u32x4 ea, ga, eb, gb; float sua[4], sva[4];
#define W_LOAD(W_, E_, G_, i_) do { _Pragma("unroll") for (int xx_ = 0; xx_ < 8; ++xx_) W_[xx_] = *(const u32x2*)(ap + (size_t)xx_ * T * 128 + (i_) * 4); E_ = *(const u32x4*)(eidx + (i_) * 4); G_ = *(const u32x4*)(gate + (i_) * 4); } while (0)
#define W_CLAMP(i_) ((i_) < N ? (i_) : gt)
    W_LOAD(wa, ea, ga, W_CLAMP(gt));
    W_LOAD(wb, eb, gb, W_CLAMP(gt + nt));
#pragma unroll
    for (int k = 0; k < 4; ++k) { sua[k] = sui[ea[k] & 0x3fffu]; sva[k] = svi[ea[k] & 0x3fffu]; }
    for (size_t i = gt; i < N; i += nt) {
        f32x4 a = {0.f, 0.f, 0.f, 0.f};
#pragma unroll
        for (int xx = 0; xx < 8; ++xx) { const unsigned wx = wa[xx].x, wy = wa[xx].y;
            const h2_t f0 = __builtin_bit_cast(h2_t, wx), f1 = __builtin_bit_cast(h2_t, wy);
            a.x += (float)f0.x; a.y += (float)f0.y; a.z += (float)f1.x; a.w += (float)f1.y; }
        const u32x4 e = ea, g = ga; float su[4], sv[4];
#pragma unroll
        for (int k = 0; k < 4; ++k) { su[k] = sua[k]; sv[k] = sva[k]; }
#pragma unroll
        for (int xx = 0; xx < 8; ++xx) wa[xx] = wb[xx];
        ea = eb; ga = gb;
#pragma unroll
        for (int k = 0; k < 4; ++k) { sua[k] = sui[ea[k] & 0x3fffu]; sva[k] = svi[ea[k] & 0x3fffu]; }
        W_LOAD(wb, eb, gb, W_CLAMP(i + 2 * nt));
        a = a * 16.0f;
        u32x4 wo, eo;
#pragma unroll
        for (int k = 0; k < 4; ++k) { const unsigned gk = g[k]; const float w = __builtin_bit_cast(float, gk) * gelu_exact(a[k] * su[k]);
            const unsigned h = (unsigned)__builtin_bit_cast(unsigned short, (_Float16)w); wo[k] = h | (h << 16);
            eo[k] = ((unsigned)e[k] << 7) | __builtin_bit_cast(unsigned, sv[k]); }
        *(u32x4*)(gate + i * 4) = wo; *(u32x4*)(eidx + i * 4) = eo; }
#undef W_LOAD
#undef W_CLAMP
}
#ifndef V_SCALE_MASK
#define V_SCALE_MASK 0
#endif
struct VHalf { u32x4 e0, e1, w0, w1; };
struct VRaw { unsigned e, w; };
struct VRing { u32x4 rv[8]; };
__device__ __forceinline__ void v_load_raw(const Params& P, int t, int half, int lane, VRaw& r) {
    r.e = ((const unsigned*)(P.ws + WS_EIDX))[(size_t)t * 128 + 64 * half + lane]; r.w = ((const unsigned*)(P.ws + WS_GATE))[(size_t)t * 128 + 64 * half + lane];
}
__device__ __forceinline__ void v_expand(int lane, const VRaw& r, VHalf& H) {
    const int base = (lane & 56) * 4;
#pragma unroll
    for (int i = 0; i < 4; ++i) { H.e0[i] = (unsigned)__builtin_amdgcn_ds_bpermute(base + 4 * i, (int)r.e); H.e1[i] = (unsigned)__builtin_amdgcn_ds_bpermute(base + 16 + 4 * i, (int)r.e);
        H.w0[i] = (unsigned)__builtin_amdgcn_ds_bpermute(base + 4 * i, (int)r.w); H.w1[i] = (unsigned)__builtin_amdgcn_ds_bpermute(base + 16 + 4 * i, (int)r.w); }
}
template <bool COMPUTE> __device__ __forceinline__ void v_step(const unsigned char* ev8, int lane, VRing& R, const VHalf& Hc, const VHalf& Hn, h2_t (&acc)[8]) {
    const unsigned sub16 = (unsigned)(lane & 7) * 16u;
#pragma unroll
    for (int i = 0; i < 8; ++i) {
        if (COMPUTE) { const unsigned ec = i < 4 ? Hc.e0[i & 3] : Hc.e1[i & 3], wc = i < 4 ? Hc.w0[i & 3] : Hc.w1[i & 3]; const h2_t w2 = __builtin_bit_cast(h2_t, wc);
            const float sc = __builtin_bit_cast(float, V_SCALE_MASK ? (ec & 0x7f800000u) : ec);
#pragma unroll
            for (int q = 0; q < 4; ++q) { const h2_t lo = __builtin_amdgcn_cvt_scalef32_pk_f16_fp8((int)R.rv[i][q], sc, false), hi = __builtin_amdgcn_cvt_scalef32_pk_f16_fp8((int)R.rv[i][q], sc, true);
                acc[2 * q] = __builtin_elementwise_fma(lo, w2, acc[2 * q]); acc[2 * q + 1] = __builtin_elementwise_fma(hi, w2, acc[2 * q + 1]); } }
        const unsigned en = i < 4 ? Hn.e0[i & 3] : Hn.e1[i & 3];
        R.rv[i] = *(const u32x4*)(ev8 + ((en & 0x1fff80u) | sub16));
        __builtin_amdgcn_sched_barrier(0);
    }
}
__device__ __forceinline__ h2_t h2_xor8(h2_t v) { return v + __builtin_bit_cast(h2_t, __builtin_amdgcn_update_dpp(0, __builtin_bit_cast(int, v), 0x128, 0xf, 0xf, false)); }
__device__ __forceinline__ h2_t h2_xor16(h2_t v) { return v + __builtin_bit_cast(h2_t, __builtin_amdgcn_ds_swizzle(__builtin_bit_cast(int, v), 0x401F)); }
__device__ __forceinline__ h2_t h2_xor32(h2_t v) { return v + __builtin_bit_cast(h2_t, __builtin_amdgcn_ds_bpermute((lane_now() ^ 32) * 4, __builtin_bit_cast(int, v))); }
__device__ __forceinline__ void v_finish(const Params& P, int x, int lane, int t, h2_t (&acc)[8]) {
    const int sub = lane & 7, gl = lane >> 3;
    unsigned w[8];
#pragma unroll
    for (int k = 0; k < 8; ++k) { const h2_t v = h2_xor32(h2_xor16(h2_xor8(acc[k]))); w[k] = __builtin_bit_cast(unsigned, v); acc[k] = (h2_t){(_Float16)0.f, (_Float16)0.f}; }
    if (gl == 0) { unsigned short* op = (unsigned short*)(P.ws + WS_PEER) + (size_t)t * D + x * 128 + sub * 16;
        *(u32x4*)op = (u32x4){w[0], w[1], w[2], w[3]}; *(u32x4*)(op + 8) = (u32x4){w[4], w[5], w[6], w[7]}; }
}
__device__ __forceinline__ void peer_v_phase(const Params& P, int vw, int nw, int lane) {
    const int x = vw & 7;
    const unsigned char* ev8 = P.ws + WS_EV8 + (size_t)x * NEXP * 128;
    TokQ q; tq_init(q, (unsigned*)(P.ws + WS_CTL) + TQ_CTR(1, x), vw, nw);
    int t0 = tq_next(q, lane), t1 = tq_next(q, lane), t2 = tq_next(q, lane);
    VHalf A0, A1, B0, B1; VRaw ra, rb; VRing R0, R1; h2_t acc[8];
#pragma unroll
    for (int k = 0; k < 8; ++k) acc[k] = (h2_t){(_Float16)0.f, (_Float16)0.f};
    v_load_raw(P, t0, 0, lane, ra); v_load_raw(P, t0, 1, lane, rb); v_expand(lane, ra, A0); v_expand(lane, rb, B0);
    v_load_raw(P, TQ_TC(t1), 0, lane, ra); v_load_raw(P, TQ_TC(t1), 1, lane, rb);
    v_step<false>(ev8, lane, R0, A0, A0, acc); v_step<false>(ev8, lane, R1, B0, B0, acc);
    v_expand(lane, ra, A1); v_expand(lane, rb, B1);
    v_load_raw(P, TQ_TC(t2), 0, lane, ra); v_load_raw(P, TQ_TC(t2), 1, lane, rb);
#define V_PAIR(Ac, An, Bc, Bn) do { const int t3 = tq_next(q, lane); \
        v_step<true>(ev8, lane, R0, Ac, An, acc); v_expand(lane, ra, Ac); v_load_raw(P, TQ_TC(t3), 0, lane, ra); __builtin_amdgcn_sched_barrier(0); \
        v_step<true>(ev8, lane, R1, Bc, Bn, acc); v_expand(lane, rb, Bc); v_load_raw(P, TQ_TC(t3), 1, lane, rb); __builtin_amdgcn_sched_barrier(0); \
        v_finish(P, x, lane, t0, acc); t0 = t1; t1 = t2; t2 = t3; } while (0)
    for (;;) { if (t0 < 0) break; V_PAIR(A0, A1, B0, B1); if (t0 < 0) break; V_PAIR(A1, A0, B1, B0); }
#undef V_PAIR
}
__device__ __forceinline__ void final_norm(const Params& P, int gw, int nw, int lane) {
    const unsigned short* peer = (const unsigned short*)(P.ws + WS_PEER); const float* mod = (const float*)(P.ws + WS_MOD);
    f32x4 gf[4];
#pragma unroll
    for (int j = 0; j < 4; ++j) gf[j] = *(const f32x4*)(P.g_final + lane * 4 + 256 * j);
    const bf16_t* x2b = (const bf16_t*)(P.ws + WS_X2B);
    f32x4 gn[4]; u32x2 xn[4], pn[4];
    auto load_row = [&](int row) { const u32x2* xr = (const u32x2*)(x2b + (size_t)row * D) + lane; const u32x2* pr = (const u32x2*)(peer + (size_t)row * D) + lane; const f32x4* gr = (const f32x4*)(mod + (size_t)(row / SEQ) * 6144 + 5 * D) + lane;
#pragma unroll
        for (int j = 0; j < 4; ++j) { xn[j] = xr[64 * j]; pn[j] = pr[64 * j]; gn[j] = gr[64 * j]; } };
    if (gw < T) load_row(gw);
    for (int row = gw; row < T; row += nw) { f32x4 v[4]; float ss = 0.f;
#pragma unroll
        for (int j = 0; j < 4; ++j) { const unsigned px = pn[j].x, py = pn[j].y; const h2_t p01 = __builtin_bit_cast(h2_t, px), p23 = __builtin_bit_cast(h2_t, py);
            v[j].x = bflo(xn[j].x) + gn[j].x * (float)p01.x; v[j].y = bfhi(xn[j].x) + gn[j].y * (float)p01.y; v[j].z = bflo(xn[j].y) + gn[j].z * (float)p23.x; v[j].w = bfhi(xn[j].y) + gn[j].w * (float)p23.y; }
        load_row(row + nw < T ? row + nw : row);
#pragma unroll
        for (int j = 0; j < 4; ++j) ss += (v[j].x * v[j].x + v[j].y * v[j].y) + (v[j].z * v[j].z + v[j].w * v[j].w);
        const float rstd = 1.0f / sqrtf(wave_sum(ss) * (1.f / D) + EPS);
        f32x4* xo = (f32x4*)(P.out + (size_t)row * D) + lane;
#pragma unroll
        for (int j = 0; j < 4; ++j) __builtin_nontemporal_store(v[j] * rstd * gf[j], xo + 64 * j); }
}

constexpr int RT_SKSTR = 136;
constexpr int RT_LDS = 2 * 128 * RT_SKSTR * 2;
__device__ __forceinline__ void ce_desc(float& a, float& b) { const float hi = fmaxf(a, b), lo = fminf(a, b); a = hi; b = lo; }
template <int K, int J> __device__ __forceinline__ void bstep(float (&a)[16]) {
#pragma unroll
    for (int i = 0; i < 16; ++i) { const int l = i ^ J; if (l > i) { if ((i & K) == 0) ce_desc(a[i], a[l]); else ce_desc(a[l], a[i]); } }
}
__device__ __forceinline__ void sort16_desc(float (&a)[16]) {
    ce_desc(a[0], a[13]); ce_desc(a[1], a[12]); ce_desc(a[2], a[15]); ce_desc(a[3], a[14]); ce_desc(a[4], a[8]); ce_desc(a[5], a[6]); ce_desc(a[7], a[11]); ce_desc(a[9], a[10]);
    ce_desc(a[0], a[5]); ce_desc(a[1], a[7]); ce_desc(a[2], a[9]); ce_desc(a[3], a[4]); ce_desc(a[6], a[13]); ce_desc(a[8], a[14]); ce_desc(a[10], a[15]); ce_desc(a[11], a[12]);
    ce_desc(a[0], a[1]); ce_desc(a[2], a[3]); ce_desc(a[4], a[5]); ce_desc(a[6], a[8]); ce_desc(a[7], a[9]); ce_desc(a[10], a[11]); ce_desc(a[12], a[13]); ce_desc(a[14], a[15]);
    ce_desc(a[0], a[2]); ce_desc(a[1], a[3]); ce_desc(a[4], a[10]); ce_desc(a[5], a[11]); ce_desc(a[6], a[7]); ce_desc(a[8], a[9]); ce_desc(a[12], a[14]); ce_desc(a[13], a[15]);
    ce_desc(a[1], a[2]); ce_desc(a[3], a[12]); ce_desc(a[4], a[6]); ce_desc(a[5], a[7]); ce_desc(a[8], a[10]); ce_desc(a[9], a[11]); ce_desc(a[13], a[14]);
    ce_desc(a[1], a[4]); ce_desc(a[2], a[6]); ce_desc(a[5], a[8]); ce_desc(a[7], a[10]); ce_desc(a[9], a[13]); ce_desc(a[11], a[14]);
    ce_desc(a[2], a[4]); ce_desc(a[3], a[6]); ce_desc(a[9], a[12]); ce_desc(a[11], a[13]);
    ce_desc(a[3], a[5]); ce_desc(a[6], a[8]); ce_desc(a[7], a[9]); ce_desc(a[10], a[12]);
    ce_desc(a[3], a[4]); ce_desc(a[5], a[6]); ce_desc(a[7], a[8]); ce_desc(a[9], a[10]); ce_desc(a[11], a[12]);
    ce_desc(a[6], a[7]); ce_desc(a[8], a[9]);
}
__device__ __forceinline__ void bitonic_merge16_desc(float (&a)[16]) { bstep<16, 8>(a); bstep<16, 4>(a); bstep<16, 2>(a); bstep<16, 1>(a); }
__device__ __forceinline__ void merge_top16(float (&a)[16], const float (&b)[16]) {
#pragma unroll
    for (int i = 0; i < 16; ++i) a[i] = fmaxf(a[i], b[15 - i]);
    bitonic_merge16_desc(a);
}
__device__ __forceinline__ float pack_key1(float v, unsigned cst) { return __builtin_bit_cast(float, (__builtin_bit_cast(unsigned, v) & 0xffffff80u) | cst); }
__device__ __forceinline__ void route_side(const bf16_t* qrow, const LAS unsigned char* sk, int lane, float (&top)[16]) {
    const int r32 = lane & 31, hi = lane >> 5;
    bf16x8 qf[8];
#pragma unroll
    for (int s = 0; s < 8; ++s) qf[s] = *(const bf16x8*)(qrow + 16 * s + 8 * hi);
    const unsigned hi4 = 4u * (unsigned)hi;
    float run[16];
#pragma unroll
    for (int kb = 0; kb < 4; ++kb) { f32x16 acc; float g[16];
#pragma unroll
        for (int r = 0; r < 16; ++r) acc[r] = 0.f;
#pragma unroll
        for (int s = 0; s < 8; ++s) { const bf16x8 kf = *(const LAS bf16x8*)(sk + ((32 * kb + r32) * RT_SKSTR + 16 * s + 8 * hi) * 2); acc = __builtin_amdgcn_mfma_f32_32x32x16_bf16(kf, qf[s], acc, 0, 0, 0); }
#pragma unroll
        for (int r = 0; r < 16; ++r) g[r] = pack_key1(acc[r], (unsigned)(32 * kb + crow(r, 0)));
        sort16_desc(g);
        if (kb == 0) {
#pragma unroll
            for (int r = 0; r < 16; ++r) run[r] = g[r];
        } else merge_top16(run, g);
        __builtin_amdgcn_sched_barrier(0);
    }
#pragma unroll
    for (int i = 0; i < 16; ++i) run[i] = __builtin_bit_cast(float, __builtin_bit_cast(unsigned, run[i]) | hi4);
    float pb[16]; const int pa = (lane ^ 32) * 4;
#pragma unroll
    for (int i = 0; i < 16; ++i) pb[i] = __builtin_bit_cast(float, __builtin_amdgcn_ds_bpermute(pa, __builtin_bit_cast(int, run[i])));
#pragma unroll
    for (int i = 0; i < 16; ++i) top[i] = run[i];
    merge_top16(top, pb);
}
__device__ __forceinline__ void route_unit(const Params& P, int unit, int lane, const LAS unsigned char* sklds, LAS unsigned char* keylds) {
    const bf16_t* QP = (const bf16_t*)(P.ws + WS_PROJ); int* eidx = (int*)(P.ws + WS_EIDX); float* gate = (float*)(P.ws + WS_GATE);
    const int tile = unit >> 2, hp = unit & 3, r32 = lane & 31, hi = lane >> 5;
    const size_t t = (size_t)tile * 32 + r32; const bf16_t* qt = QP + t * 2048;
    float A0[16], A1[16], B0[16], B1[16];
    PSEC_BEGIN(1);
    route_side(qt + (2 * hp) * 256, sklds, lane, A0); __builtin_amdgcn_sched_barrier(0); route_side(qt + (2 * hp) * 256 + 128, sklds + 128 * RT_SKSTR * 2, lane, A1); __builtin_amdgcn_sched_barrier(0);
    route_side(qt + (2 * hp + 1) * 256, sklds, lane, B0); __builtin_amdgcn_sched_barrier(0); route_side(qt + (2 * hp + 1) * 256 + 128, sklds + 128 * RT_SKSTR * 2, lane, B1); __builtin_amdgcn_sched_barrier(0);
    PSEC_END(1);
    PSEC_BEGIN(2);
    float L0[16], L1[16];
#pragma unroll
    for (int i = 0; i < 16; ++i) { L0[i] = hi ? B0[i] : A0[i]; L1[i] = hi ? B1[i] : A1[i]; }
    const int h = 2 * hp + hi;
#define RT_CAND(i_, j_) __builtin_bit_cast(float, (__builtin_bit_cast(unsigned, L0[i_] + L1[j_]) & 0xffffff00u) | (unsigned)(255 - ((i_) * 16 + (j_))))
    float best[16], x1[16], x2[16], x3[16];
#pragma unroll
    for (int j = 0; j < 16; ++j) best[j] = RT_CAND(0, j);
#pragma unroll
    for (int j = 0; j < 8; ++j) { x1[j] = RT_CAND(1, j); x1[15 - j] = RT_CAND(8 + j, 0); }
    bitonic_merge16_desc(x1);
    x2[0] = RT_CAND(2, 0); x2[1] = RT_CAND(2, 1); x2[2] = RT_CAND(2, 2); x2[3] = RT_CAND(2, 3); x2[4] = RT_CAND(2, 4); x2[5] = RT_CAND(3, 0); x2[6] = RT_CAND(3, 1); x2[7] = RT_CAND(3, 2);
    x2[8] = RT_CAND(3, 3); x2[9] = RT_CAND(4, 0); x2[10] = RT_CAND(4, 1); x2[11] = RT_CAND(4, 2); x2[12] = RT_CAND(5, 0); x2[13] = RT_CAND(5, 1); x2[14] = RT_CAND(6, 0); x2[15] = RT_CAND(6, 1);
    sort16_desc(x2);
    x3[0] = RT_CAND(7, 0); x3[1] = RT_CAND(7, 1);
#pragma unroll
    for (int j = 2; j < 16; ++j) x3[j] = -INFINITY;
    merge_top16(best, x1); merge_top16(best, x2); merge_top16(best, x3);
#undef RT_CAND
    { unsigned w[8];
#pragma unroll
      for (int q = 0; q < 4; ++q) { w[q] = (__builtin_bit_cast(unsigned, L0[4 * q]) & 0x7fu) | ((__builtin_bit_cast(unsigned, L0[4 * q + 1]) & 0x7fu) << 8) | ((__builtin_bit_cast(unsigned, L0[4 * q + 2]) & 0x7fu) << 16) | ((__builtin_bit_cast(unsigned, L0[4 * q + 3]) & 0x7fu) << 24);
          w[4 + q] = (__builtin_bit_cast(unsigned, L1[4 * q]) & 0x7fu) | ((__builtin_bit_cast(unsigned, L1[4 * q + 1]) & 0x7fu) << 8) | ((__builtin_bit_cast(unsigned, L1[4 * q + 2]) & 0x7fu) << 16) | ((__builtin_bit_cast(unsigned, L1[4 * q + 3]) & 0x7fu) << 24); }
      *(LAS u32x4*)(keylds) = (u32x4){w[0], w[1], w[2], w[3]}; *(LAS u32x4*)(keylds + 16) = (u32x4){w[4], w[5], w[6], w[7]}; }
    float e[16]; int ids[16]; float ssum = 0.f;
#pragma unroll
    for (int r = 0; r < 16; ++r) { const unsigned code = 255u - (__builtin_bit_cast(unsigned, best[r]) & 0xffu);
        ids[r] = (int)((unsigned)keylds[code >> 4] * 128u + (unsigned)keylds[16 + (code & 15u)]);
        e[r] = __expf(best[r] - best[0]); ssum += e[r]; }
    const float inv = 1.f / ssum;
#pragma unroll
    for (int r4 = 0; r4 < 4; ++r4) {
        *(u32x4*)(eidx + t * 128 + 16 * h + 4 * r4) = (u32x4){(unsigned)ids[4 * r4], (unsigned)ids[4 * r4 + 1], (unsigned)ids[4 * r4 + 2], (unsigned)ids[4 * r4 + 3]};
        *(f32x4*)(gate + t * 128 + 16 * h + 4 * r4) = (f32x4){e[4 * r4] * inv, e[4 * r4 + 1] * inv, e[4 * r4 + 2] * inv, e[4 * r4 + 3] * inv}; }
    PSEC_END(2);
}
__device__ __forceinline__ void route_phase(const Params& P, LAS unsigned char* lds, int tid, int gw, int nw) {
    const bf16_t* SK = (const bf16_t*)(P.ws + WS_SK);
    for (int i = tid; i < 2 * 128 * 16; i += 512) { const int row = i >> 4, ch = i & 15; *(LAS u32x4*)(lds + (row * RT_SKSTR + ch * 8) * 2) = *(const u32x4*)(SK + row * 128 + ch * 8); }
    __syncthreads();
    for (int u = gw; u < (T / 32) * 4; u += nw) route_unit(P, u, tid & 63, lds, lds + RT_LDS + (tid >> 6) * 2048 + (tid & 63) * 32);
}

#define XB_TMO      128
#define XB_XCNT(j)  (256  + 64 * (j))
#define XB_XSUB(j)  (1280 + 64 * (j))
#define XB_XGEN(j)  (2304 + 64 * (j))
#define XB_TOP      3328
#define XB_TOPGEN   3392
#define XCD_BAR_WORDS 3456
#define XB_SPIN_CAP (1u << 18)

__device__ __forceinline__ unsigned xb_ld(unsigned* p)              { return __hip_atomic_load(p, __ATOMIC_RELAXED, __HIP_MEMORY_SCOPE_AGENT); }
__device__ __forceinline__ unsigned xb_add(unsigned* p, unsigned v) { return __hip_atomic_fetch_add(p, v, __ATOMIC_RELAXED, __HIP_MEMORY_SCOPE_AGENT); }
__device__ __forceinline__ unsigned xb_xcc_id() { return (unsigned)__builtin_amdgcn_s_getreg((3 << 11) | 20) & 0xFu; }
#define XB_SPIN(cond, bar) do { unsigned _sp = 0; while (cond) { __builtin_amdgcn_s_sleep(1); \
    if ((++_sp & 255u) == 0u) { if (xb_ld(&(bar)[XB_TMO])) break; if (_sp > XB_SPIN_CAP) { atomicAdd(&(bar)[XB_TMO], 1u); break; } } } } while (0)

struct XcdBarrier {
    unsigned* bar; unsigned x;
    volatile PG8_LAS unsigned* st;
};

__device__ __forceinline__ XcdBarrier xcd_barrier_post(unsigned* bar, volatile PG8_LAS unsigned* st) {
    XcdBarrier b; b.bar = bar; b.x = xb_xcc_id(); b.st = st;
    if (threadIdx.x == 0) st[2] = xb_add(&bar[XB_XCNT(b.x)], 1u);
    return b;
}
__device__ __forceinline__ void xcd_barrier_complete(unsigned* bar, unsigned x, unsigned& nloc, unsigned& nx) {
    const unsigned G = gridDim.x * gridDim.y * gridDim.z;
    unsigned sum, cnt, mine, sp = 0u;
    for (;;) {
        sum = 0u; cnt = 0u; mine = 0u;
#pragma unroll
        for (unsigned j = 0; j < 16; ++j) { const unsigned c = xb_ld(&bar[XB_XCNT(j)]); sum += c; cnt += (c > 0u) ? 1u : 0u; mine = (j == x) ? c : mine; }
        if (sum == G) break;
        __builtin_amdgcn_s_sleep(1);
        if ((++sp & 255u) == 0u) { if (xb_ld(&bar[XB_TMO])) break; if (sp > XB_SPIN_CAP) { atomicAdd(&bar[XB_TMO], 1u); break; } }
    }
    nloc = mine > 0u ? mine : 1u; nx = cnt > 0u ? cnt : 1u;
}

__device__ __forceinline__ void xcd_barrier(const XcdBarrier& b) {
    asm volatile("s_waitcnt vmcnt(0)" ::: "memory");
    __syncthreads();
    if (tid_now() == 0) {
        unsigned* bar = b.bar;
        __builtin_amdgcn_s_waitcnt(0);
        unsigned nloc = b.st[0], nx = b.st[1];
        if (nloc == 0u) { xcd_barrier_complete(bar, b.x, nloc, nx); b.st[0] = nloc; b.st[1] = nx; }
        const unsigned old = xb_add(&bar[XB_XSUB(b.x)], 1u);
        const unsigned gen = old / nloc;
        if (old + 1u == (gen + 1u) * nloc) {
            __builtin_amdgcn_fence(__ATOMIC_RELEASE, "agent");
            asm volatile("s_waitcnt vmcnt(0)" ::: "memory");
            const unsigned og = xb_add(&bar[XB_TOP], 1u);
            const unsigned tg = og / nx;
            if (og + 1u == (tg + 1u) * nx) xb_add(&bar[XB_TOPGEN], 1u);
            else XB_SPIN(xb_ld(&bar[XB_TOPGEN]) == tg, bar);
            __builtin_amdgcn_fence(__ATOMIC_ACQUIRE, "agent");
            asm volatile("s_waitcnt vmcnt(0)" ::: "memory");
        } else {
            XB_SPIN(xb_ld(&bar[XB_TOPGEN]) == gen, bar);
            __builtin_amdgcn_fence(__ATOMIC_ACQUIRE, "agent");
            asm volatile("s_waitcnt vmcnt(0)" ::: "memory");
        }
    }
    __syncthreads();
}

namespace cg = cooperative_groups;
constexpr int LDS_BYTES = 147456;
constexpr int CENSUS_OFF = 131072 + 8192;
struct KArgs { Params P; int ph_lo, ph_hi; };
__global__ void __launch_bounds__(512, 2) mk_fwd(KArgs ka) {
    extern __shared__ __attribute__((aligned(16))) unsigned char lds[];
    const Params& P = ka.P;
    cg::grid_group grid = cg::this_grid();
    PG8_LAS unsigned char* glds = (PG8_LAS unsigned char*)lds;
    if (threadIdx.x < 16) ((PG8_LAS volatile unsigned*)(glds + CENSUS_OFF))[threadIdx.x] = 0u;
    if ((threadIdx.x & 63u) == 0u) ((PG8_LAS volatile unsigned*)(glds + WAVE_TAB_OFF))[hw_slot()] = threadIdx.x >> 6;
    if (PROBE_SEC != 0 && threadIdx.x == 0) *PSEC_WORD = 0ull;
    __syncthreads();
    const XcdBarrier xbar = xcd_barrier_post((unsigned*)(ka.P.ws + WS_CTL), (PG8_LAS volatile unsigned*)(glds + CENSUS_OFF));
#define IDS() int tid_ = tid_now(); asm volatile("" : "+v"(tid_)); const int lane = tid_ & 63, wave = __builtin_amdgcn_readfirstlane(tid_ >> 6); \
    const int G = gridDim.x, gw = blockIdx.x * 8 + wave, nw = G * 8; const size_t gt = (size_t)blockIdx.x * 512 + tid_, nt = (size_t)G * 512; (void)lane; (void)gw; (void)nw; (void)gt; (void)nt;
#define IN(k) (ka.ph_lo <= (k) && (k) < ka.ph_hi)
#define STAMP(k) do { if (PROBE_MASK != 0u && blockIdx.x == 0 && threadIdx.x == 0) ((PG8_LAS volatile unsigned long long*)(glds + CENSUS_OFF + 64))[k] = PROBE_CLK ? __builtin_amdgcn_s_memtime() : __builtin_amdgcn_s_memrealtime(); } while (0)
    STAMP(0);
#define SYNC(k) do { if (IN(k) && IN((k) + 1)) { if ((k) == 0) grid.sync(); else xcd_barrier(xbar); } STAMP((k) + 1); } while (0)
#define WSP(T_, off) ((T_*)(P.ws + (off)))
    if (IN(0)) { IDS(); XPre xp; p0_expert_preload(P, wave * G + (int)blockIdx.x, nw, lane, xp);
        if (G >= MOD_CHUNKS) { if ((int)blockIdx.x < MOD_CHUNKS) p0_mod_partial(P, (int)blockIdx.x, wave, lane, (float*)(lds + MOD_SCR_OFF)); }
        else for (int nc = (int)blockIdx.x; nc < MOD_CHUNKS; nc += G) p0_mod_block(P, nc, wave, lane, tid_, (float*)lds);
        p0_prologue(P, wave * G + (int)blockIdx.x, nw, lane, (float*)(lds + wave * 8448), xp);
        if (G >= MOD_CHUNKS) { __syncthreads(); if ((int)blockIdx.x < MOD_CHUNKS) p0_mod_final(P, (int)blockIdx.x, tid_, (const float*)(lds + MOD_SCR_OFF)); } }
    SYNC(0);
    if (IN(1)) { IDS(); rownorm_pass<false, false, false>(P, P.x, P.g_norm1, 0, 1, WSP(bf16_t, WS_XN), gw, nw, lane); }
    SYNC(1);
    if (IN(2)) {
        { pg8::Gemm g{WSP(const bf16_t, WS_XN), WSP(const bf16_t, WS_W1T), T, 2048, D, D, D}; pg8::StaticOrder S; S.init(T, 2048, gridDim.x, (int)blockIdx.x);
          epi::EpiStore<3> E{WSP(bf16_t, WS_PROJ), PLD, WSP(float, WS_SSQ), 0, 0.f}; pg8::gemm_phase<epi::EpiStore<3>, pg8::StaticOrder, true, true>(glds, g, S, E); }
        { pg8::Gemm g{WSP(const bf16_t, WS_W1TT), WSP(const bf16_t, WS_XN), 512, T, D, D, D}; pg8::StaticOrder S; S.init(512, T, gridDim.x, (int)blockIdx.x);
          epi::EpiStore<0> E{WSP(bf16_t, WS_PROJT), T, nullptr, 0, 0.f}; pg8::gemm_phase<epi::EpiStore<0>, pg8::StaticOrder, true, true>(glds, g, S, E); }
    }
    SYNC(2);
    if (IN(3)) {
        { pg8::Gemm g{WSP(const bf16_t, WS_PROJ) + PC_QL, WSP(const bf16_t, WS_WUQ), T, 1792, 256, PLD, 256, 3, PC_KVL - PC_QL}; pg8::StaticOrder S; S.init(T, 1792, gridDim.x, (int)blockIdx.x);
          epi::EpiStoreSplit E{WSP(bf16_t, WS_Q), 768, 0, 1.f / 256.f, 3, WSP(bf16_t, WS_KN), 512, 1, 1.f / 128.f, 5, WSP(bf16_t, WS_VT), 512, 1, 1.f / 128.f, WSP(float, WS_SSQ)}; pg8::gemm_phase<epi::EpiStoreSplit, pg8::StaticOrder, true, true>(glds, g, S, E); }
        { IDS(); kr_pass(P, gt, nt); for (int i = gw; i < NB * 64 * NH; i += nw) ret_kvc_item(P, i, lane); }
    }
    SYNC(3);
    if (IN(4)) { IDS();
        ret_scan(P, gt, nt);
        __syncthreads();
        attn_phase(P, glds, tid_);
    }
    SYNC(4);
    if (IN(5)) { IDS(); ((LAS float*)(glds + 131072))[tid_] = P.g_ret_norm[tid_]; __syncthreads();
        for (int i = gw; i < NB * 64 * NH; i += nw) ret_out_item(P, i, lane, (LAS u32x4*)(glds + wave * 16384), glds + 131072); }
    SYNC(5);
    if (IN(6)) { pg8::Gemm g{WSP(const bf16_t, WS_XN), WSP(const bf16_t, WS_WOUT), T, D, D, D, D}; pg8::StaticOrder S; S.init(T, D, gridDim.x, (int)blockIdx.x);
        epi::EpiResid E{P.x, WSP(const float, WS_MOD), WSP(bf16_t, WS_X2B)}; pg8::gemm_phase<epi::EpiResid, pg8::StaticOrder, true, true>(glds, g, S, E); }
    SYNC(6);
    if (IN(7)) { IDS(); rownorm_pass<false, true, true>(P, WSP(const bf16_t, WS_X2B), P.g_norm2, 3, 4, WSP(bf16_t, WS_XN), gw, nw, lane); }
    SYNC(7);
    if (IN(8)) { pg8::Gemm g{WSP(const bf16_t, WS_XN), WSP(const bf16_t, WS_WQ), T, 2048, D, D, D}; pg8::StaticOrder S; S.init(T, 2048, gridDim.x, (int)blockIdx.x);
        epi::EpiStore<0> E{WSP(bf16_t, WS_PROJ), 2048, nullptr, 0, 0.f}; pg8::gemm_phase<epi::EpiStore<0>, pg8::StaticOrder, true, true>(glds, g, S, E); }
    SYNC(8);
    if (IN(9)) { IDS(); route_phase(P, glds, tid_, gw, nw); }
    SYNC(9);
#define SLICE_MAP() int vb = (int)blockIdx.x; { bool even = (G % 8) == 0; for (int j = 0; j < 8; ++j) even = even && (xb_ld((unsigned*)(P.ws + WS_CTL) + XB_XCNT(j)) == (unsigned)(G / 8)); \
        if (even) vb = (int)(((PG8_LAS volatile unsigned*)(glds + CENSUS_OFF))[2] * 8u + (xbar.x & 7u)); } const int vw = wave * G + vb;
    if (IN(10)) { IDS(); SLICE_MAP(); peer_u_phase(P, vw, nw, lane, glds + wave * 8192); }
    SYNC(10);
    if (IN(11)) { IDS(); peer_w_phase(P, gt, nt); }
    SYNC(11);
    if (IN(12)) { IDS(); SLICE_MAP(); peer_v_phase(P, vw, nw, lane); }
    SYNC(12);
    if (IN(13)) { IDS(); final_norm(P, gw, nw, lane); }
    if (PROBE_MASK != 0u && blockIdx.x == 0 && threadIdx.x == 0) {
        const unsigned long long tend = __builtin_amdgcn_s_memrealtime(); ((PG8_LAS volatile unsigned long long*)(glds + CENSUS_OFF + 64))[14] = PROBE_CLK ? __builtin_amdgcn_s_memtime() : tend;
        unsigned long long extra = 0;
        for (int k = 0; k < 14; ++k) if ((PROBE_MASK >> k) & 1u) extra += ((PG8_LAS volatile unsigned long long*)(glds + CENSUS_OFF + 64))[k + 1] - ((PG8_LAS volatile unsigned long long*)(glds + CENSUS_OFF + 64))[k];
        extra = PROBE_CLK ? extra * PROBE_MULT / 100 : extra * PROBE_MULT;
        if (PROBE_SEC != 0) extra = *PSEC_WORD * PROBE_MULT;
        while (__builtin_amdgcn_s_memrealtime() - tend < extra) __builtin_amdgcn_s_sleep(8);
    }
#undef IN
#undef SYNC
#undef IDS
#undef WSP
}

extern "C" void kernel_launch(void* const* d_in, const int* in_sizes, int n_in, void* d_out, int out_size, void* d_ws, size_t ws_size, hipStream_t stream) {
    if (n_in != 19 || out_size != T * D || ws_size < WS_END) { fprintf(stderr, "kernel_launch: unexpected shapes (n_in %d out %d ws %zu)\n", n_in, out_size, ws_size); return; }
    static int grid = 0;
    if (grid == 0) {
        int dev = 0, cus = 0, per_cu = 0;
        if (hipGetDevice(&dev) != hipSuccess || hipDeviceGetAttribute(&cus, hipDeviceAttributeMultiprocessorCount, dev) != hipSuccess) { fprintf(stderr, "kernel_launch: device query failed\n"); grid = -1; return; }
        if (hipFuncSetAttribute((const void*)mk_fwd, hipFuncAttributeMaxDynamicSharedMemorySize, LDS_BYTES) != hipSuccess) { fprintf(stderr, "kernel_launch: hipFuncSetAttribute failed\n"); grid = -1; return; }
        if (hipOccupancyMaxActiveBlocksPerMultiprocessor(&per_cu, (const void*)mk_fwd, 512, LDS_BYTES) != hipSuccess || per_cu < 1) { fprintf(stderr, "kernel_launch: occupancy query failed (%d)\n", per_cu); (void)hipGetLastError(); per_cu = 1; }
        grid = cus * (per_cu > 1 ? 1 : per_cu);
    }
    if (grid < 0) return;
    KArgs ka{};
    Params& P = ka.P;
    P.x = (const float*)d_in[0]; P.c = (const float*)d_in[1]; P.positions = (const int*)d_in[2]; P.w_ada = (const float*)d_in[3]; P.b_ada = (const float*)d_in[4];
    P.g_norm1 = (const float*)d_in[5]; P.w_in = (const float*)d_in[6]; P.g_q_norm = (const float*)d_in[7]; P.w_uq = (const float*)d_in[8]; P.g_kv_norm = (const float*)d_in[9];
    P.w_ukv = (const float*)d_in[10]; P.g_ret_norm = (const float*)d_in[11]; P.w_out = (const float*)d_in[12]; P.g_norm2 = (const float*)d_in[13]; P.w_query = (const float*)d_in[14];
    P.sub_keys = (const float*)d_in[15]; P.expert_u = (const float*)d_in[16]; P.expert_v = (const float*)d_in[17]; P.g_final = (const float*)d_in[18];
    P.out = (float*)d_out; P.ws = (unsigned char*)d_ws;
    ka.ph_lo = 0; ka.ph_hi = 14;
    if (hipMemsetAsync((char*)d_ws + WS_CTL, 0, 65536, stream) != hipSuccess) { fprintf(stderr, "kernel_launch: memset failed\n"); return; }
    void* args[] = {&ka};
    const hipError_t e = hipLaunchCooperativeKernel((const void*)mk_fwd, dim3(grid), dim3(512), args, LDS_BYTES, stream);
    if (e != hipSuccess) fprintf(stderr, "kernel_launch: cooperative launch failed: %s (grid %d)\n", hipGetErrorString(e), grid);
}
```
